# Optimizing an MI355X kernel written in HIP

```python
import jax, jax.numpy as jnp
from jax import lax
import numpy as np

D_MODEL = 4096
BATCH = 2
SEQ = 8192
DEPTH = 2

MLA_HEADS = 16
MLA_Q_RANK = 768
MLA_KV_RANK = 512
MLA_NOPE = 128
MLA_ROPE = 64
MLA_V = 128
ROPE_THETA = 10000.0
GLA_HEADS = 4
GLA_DK = 128
GLA_DV = 256
GLA_GATE_RANK = 16
GLA_GATE_NORM = 16.0
GLA_CHUNK = 64
DSA_HEADS = 8
DSA_KV_HEADS = 2
DSA_DH = 128
IDX_HEADS = 32
IDX_DH = 64
IDX_TOPK = 256
Q_BLOCK = 128
NORM_EPS = 1e-6
NEG = -1e30

MLA_WIDTH = MLA_HEADS * MLA_V
GLA_WIDTH = GLA_HEADS * GLA_DV
DSA_WIDTH = DSA_HEADS * DSA_DH
N_BRANCH = 3

IN_SPLITS = (
    MLA_Q_RANK, MLA_KV_RANK, MLA_ROPE,
    GLA_HEADS * GLA_DK, GLA_HEADS * GLA_DK, GLA_WIDTH, GLA_GATE_RANK,
    DSA_WIDTH, DSA_KV_HEADS * DSA_DH, DSA_KV_HEADS * DSA_DH,
    IDX_HEADS * IDX_DH, IDX_DH, IDX_HEADS,
    MLA_WIDTH, GLA_WIDTH, DSA_WIDTH,
)
IN_WIDTH = sum(IN_SPLITS)

kernel_name = "hybrid_mla_gla_dsa_gated_merge"


def rms_norm(x, g):
    xf = x.astype(jnp.float32)
    y = xf * lax.rsqrt(jnp.mean(xf * xf, axis=-1, keepdims=True) + NORM_EPS)
    return (y * g.astype(jnp.float32)).astype(x.dtype)


def rope_tables(positions, dim):
    inv = ROPE_THETA ** (-jnp.arange(0, dim, 2, dtype=jnp.float32) / dim)
    ang = positions.astype(jnp.float32)[..., None] * inv
    return jnp.cos(ang), jnp.sin(ang)


def apply_rope(x, cos, sin):
    xf = x.astype(jnp.float32)
    x1, x2 = jnp.split(xf, 2, axis=-1)
    c = cos[:, :, None, :]
    s = sin[:, :, None, :]
    return jnp.concatenate([x1 * c - x2 * s, x1 * s + x2 * c], axis=-1).astype(x.dtype)


def causal_block_attention(q, k, v, scale):
    B, S, H, _ = q.shape
    key_idx = jnp.arange(S)
    qs = q * scale

    def block(i):
        start = i * Q_BLOCK
        qb = lax.dynamic_slice_in_dim(qs, start, Q_BLOCK, axis=1)
        s = jnp.einsum('bqhd,bkhd->bhqk', qb, k, preferred_element_type=jnp.float32)
        q_idx = start + jnp.arange(Q_BLOCK)
        mask = key_idx[None, :] <= q_idx[:, None]
        p = jax.nn.softmax(jnp.where(mask[None, None], s, NEG), axis=-1)
        return jnp.einsum('bhqk,bkhd->bqhd', p.astype(v.dtype), v)

    out = lax.map(block, jnp.arange(S // Q_BLOCK))
    return out.transpose(1, 0, 2, 3, 4).reshape(B, S, H * v.shape[-1])


def mla_mixer(cq, ckv, krope, cos, sin, g_q, w_uq, g_kv, w_ukv):
    B, S, _ = cq.shape
    q = (rms_norm(cq, g_q) @ w_uq).reshape(B, S, MLA_HEADS, MLA_NOPE + MLA_ROPE)
    q = jnp.concatenate([q[..., :MLA_NOPE], apply_rope(q[..., MLA_NOPE:], cos, sin)], axis=-1)
    kv = (rms_norm(ckv, g_kv) @ w_ukv).reshape(B, S, MLA_HEADS, MLA_NOPE + MLA_V)
    k_nope, v = kv[..., :MLA_NOPE], kv[..., MLA_NOPE:]
    k_r = apply_rope(krope[:, :, None, :], cos, sin)
    k = jnp.concatenate([k_nope, jnp.broadcast_to(k_r, (B, S, MLA_HEADS, MLA_ROPE))], axis=-1)
    return causal_block_attention(q, k, v, (MLA_NOPE + MLA_ROPE) ** -0.5)


def gla_mixer(q, k, v, g_low, w_g2, b_g, g_out):
    B, S, _ = q.shape
    H, DK, DV, C = GLA_HEADS, GLA_DK, GLA_DV, GLA_CHUNK
    N = S // C
    f32 = jnp.float32

    def chunks(t, d):
        return t.astype(f32).reshape(B, N, C, H, d).transpose(1, 0, 3, 2, 4)

    qc = chunks(q, DK) * DK ** -0.5
    kc = chunks(k, DK)
    vc = chunks(v, DV)
    glog = jax.nn.log_sigmoid((g_low @ w_g2 + b_g).astype(f32)) / GLA_GATE_NORM
    bc = jnp.cumsum(chunks(glog, DK), axis=3)
    b_last = bc[:, :, :, -1:, :]
    q_dec = qc * jnp.exp(bc)
    k_inv = kc * jnp.exp(-bc)
    k_end = kc * jnp.exp(b_last - bc)
    decay = jnp.exp(b_last[:, :, :, 0, :])
    tril = jnp.arange(C)[:, None] >= jnp.arange(C)[None, :]
    attn = jnp.where(tril, jnp.einsum('nbhcd,nbhsd->nbhcs', q_dec, k_inv), 0.0)
    o_intra = jnp.einsum('nbhcs,nbhse->nbhce', attn, vc)

    def step(state, inp):
        qd, ke, vv, dec = inp
        o = jnp.einsum('bhcd,bhde->bhce', qd, state)
        state = dec[..., None] * state + jnp.einsum('bhcd,bhce->bhde', ke, vv)
        return state, o

    state0 = jnp.zeros((B, H, DK, DV), f32)
    _, o_inter = lax.scan(step, state0, (q_dec, k_end, vc, decay))
    o = (o_intra + o_inter).transpose(1, 0, 3, 2, 4).reshape(B, S, H, DV)
    o = rms_norm(o, g_out)
    return o.reshape(B, S, H * DV).astype(q.dtype)


def dsa_mixer(q, k, v, iq, ik, iw):
    B, S, _ = q.shape
    REP = DSA_HEADS // DSA_KV_HEADS
    top_k = min(IDX_TOPK, S // 4)
    q = q.reshape(B, S, DSA_KV_HEADS, REP, DSA_DH) * DSA_DH ** -0.5
    k = k.reshape(B, S, DSA_KV_HEADS, DSA_DH)
    v = v.reshape(B, S, DSA_KV_HEADS, DSA_DH)
    iq = iq.reshape(B, S, IDX_HEADS, IDX_DH) * IDX_DH ** -0.5
    iw = iw.astype(jnp.float32) * IDX_HEADS ** -0.5
    key_idx = jnp.arange(S)
    gather = jax.vmap(lambda tb, ib: jnp.take(tb, ib, axis=0))

    def block(i):
        start = i * Q_BLOCK
        q_idx = start + jnp.arange(Q_BLOCK)
        iqb = lax.dynamic_slice_in_dim(iq, start, Q_BLOCK, axis=1)
        iwb = lax.dynamic_slice_in_dim(iw, start, Q_BLOCK, axis=1)
        qb = lax.dynamic_slice_in_dim(q, start, Q_BLOCK, axis=1)
        rel = jax.nn.relu(jnp.einsum('bqhd,bkd->bqhk', iqb, ik, preferred_element_type=jnp.float32))
        score = jnp.einsum('bqhk,bqh->bqk', rel, iwb)
        causal = key_idx[None, :] <= q_idx[:, None]
        score = jnp.where(causal[None], score, NEG)
        _, idx = lax.top_k(score, top_k)
        valid = idx <= q_idx[None, :, None]
        ksel = gather(k, idx)
        vsel = gather(v, idx)
        s = jnp.einsum('bqgrd,bqkgd->bqgrk', qb, ksel, preferred_element_type=jnp.float32)
        p = jax.nn.softmax(jnp.where(valid[:, :, None, None, :], s, NEG), axis=-1)
        o = jnp.einsum('bqgrk,bqkgd->bqgrd', p.astype(vsel.dtype), vsel)
        return o.reshape(B, Q_BLOCK, DSA_WIDTH)

    out = lax.map(block, jnp.arange(S // Q_BLOCK))
    return out.transpose(1, 0, 2, 3).reshape(B, S, DSA_WIDTH)


def hybrid_layer(x, c, cos, sin, norm_g, w_ada, b_ada, w_in, mla_gq, mla_wuq, mla_gkv,
                 mla_wukv, gla_wg2, gla_bg, gla_gout, w_mg, b_mg, w_bm, w_bg, w_bd, w_o):
    mod = jax.nn.silu(c) @ w_ada + b_ada
    shift, scale, gate = jnp.split(mod, 3, axis=-1)
    h = rms_norm(x, norm_g) * (1.0 + scale[:, None, :]) + shift[:, None, :]

    proj = h @ w_in
    (cq, ckv, krope, gq, gk, gv, glow, dq, dk, dv, iq, ik, iw,
     z_mla, z_gla, z_dsa) = jnp.split(proj, list(np.cumsum(IN_SPLITS)[:-1]), axis=-1)

    y_mla = mla_mixer(cq, ckv, krope, cos, sin, mla_gq, mla_wuq, mla_gkv, mla_wukv) * jax.nn.silu(z_mla)
    y_gla = gla_mixer(gq, gk, gv, glow, gla_wg2, gla_bg, gla_gout) * jax.nn.silu(z_gla)
    y_dsa = dsa_mixer(dq, dk, dv, iq, ik, iw) * jax.nn.silu(z_dsa)

    g_a, g_b, g_c = jnp.split(jax.nn.sigmoid(h @ w_mg + b_mg), N_BRANCH, axis=-1)
    merged = g_a * (y_mla @ w_bm) + g_b * (y_gla @ w_bg) + g_c * (y_dsa @ w_bd)
    return x + gate[:, None, :] * (merged @ w_o)


def setup_inputs(seed: int = 0) -> dict:
    key = jax.random.key(seed)
    ks = jax.random.split(key, 24)
    f32 = jnp.float32
    D, L = D_MODEL, DEPTH

    def nrm(k, shape, fan_in):
        return jax.random.normal(k, shape, f32) * fan_in ** -0.5

    def gain(k, shape):
        return 1.0 + 0.1 * jax.random.normal(k, shape, f32)

    offset = jax.random.randint(ks[2], (BATCH, 1), 0, 1024, dtype=jnp.int32)
    positions = offset + jnp.arange(SEQ, dtype=jnp.int32)[None, :]
    return {
        "x": jax.random.normal(ks[0], (BATCH, SEQ, D), f32),
        "c": jax.random.normal(ks[1], (BATCH, D), f32),
        "positions": positions,
        "norm_g": gain(ks[3], (L, D)),
        "w_ada": nrm(ks[4], (L, D, 3 * D), D),
        "b_ada": 0.02 * jax.random.normal(ks[5], (L, 3 * D), f32),
        "w_in": nrm(ks[6], (L, D, IN_WIDTH), D),
        "mla_gq": gain(ks[7], (L, MLA_Q_RANK)),
        "mla_wuq": nrm(ks[8], (L, MLA_Q_RANK, MLA_HEADS * (MLA_NOPE + MLA_ROPE)), MLA_Q_RANK),
        "mla_gkv": gain(ks[9], (L, MLA_KV_RANK)),
        "mla_wukv": nrm(ks[10], (L, MLA_KV_RANK, MLA_HEADS * (MLA_NOPE + MLA_V)), MLA_KV_RANK),
        "gla_wg2": nrm(ks[11], (L, GLA_GATE_RANK, GLA_HEADS * GLA_DK), GLA_GATE_RANK),
        "gla_bg": 0.02 * jax.random.normal(ks[12], (L, GLA_HEADS * GLA_DK), f32),
        "gla_gout": gain(ks[13], (L, GLA_DV)),
        "w_mg": nrm(ks[14], (L, D, N_BRANCH * D), D),
        "b_mg": 0.02 * jax.random.normal(ks[15], (L, N_BRANCH * D), f32),
        "w_bm": nrm(ks[16], (L, MLA_WIDTH, D), MLA_WIDTH),
        "w_bg": nrm(ks[17], (L, GLA_WIDTH, D), GLA_WIDTH),
        "w_bd": nrm(ks[18], (L, DSA_WIDTH, D), DSA_WIDTH),
        "w_o": nrm(ks[19], (L, D, D), D),
        "final_g": gain(ks[20], (D,)),
    }


def reference(x, c, positions, norm_g, w_ada, b_ada, w_in, mla_gq, mla_wuq, mla_gkv, mla_wukv,
              gla_wg2, gla_bg, gla_gout, w_mg, b_mg, w_bm, w_bg, w_bd, w_o, final_g):
    cos, sin = rope_tables(positions, MLA_ROPE)
    for l in range(DEPTH):
        x = hybrid_layer(x, c, cos, sin, norm_g[l], w_ada[l], b_ada[l], w_in[l],
                         mla_gq[l], mla_wuq[l], mla_gkv[l], mla_wukv[l],
                         gla_wg2[l], gla_bg[l], gla_gout[l], w_mg[l], b_mg[l],
                         w_bm[l], w_bg[l], w_bd[l], w_o[l])
    return rms_norm(x, final_g)
```

```cpp
#include <hip/hip_runtime.h>
#include <cstdio>
#include <cstdint>
#ifndef MK_PER_PHASE
#define MK_PER_PHASE 0
#endif
#ifndef OUT_SCALE_V
#define OUT_SCALE_V 1.0f
#endif
constexpr float OUT_SCALE = OUT_SCALE_V;

constexpr int DM = 4096, NBATCH = 2, SEQ = 8192, T = NBATCH * SEQ, DEPTH = 2;
constexpr int MLA_H = 16, MLA_QR = 768, MLA_KVR = 512, MLA_NOPE = 128, MLA_ROPE = 64, MLA_DV = 128, MLA_DQK = 192;
constexpr int GLA_H = 4, GLA_DK = 128, GLA_DV = 256, GLA_R = 16, GLA_C = 64, GLA_NCH = SEQ / GLA_C;
constexpr int DSA_H = 8, DSA_KVH = 2, DSA_DH = 128, IDX_H = 32, IDX_DH = 64, TOPK = 256;
constexpr int IN_W = 11184;
constexpr float NORM_EPS = 1e-6f;
constexpr int SC_CQ = 0, SC_CKV = 768, SC_KROPE = 1280, SC_GQ = 1344, SC_GK = 1856, SC_GV = 2368, SC_GLOW = 3392, SC_DQ = 3408, SC_DK = 4432, SC_DV = 4688,
              SC_IQ = 4944, SC_IK = 6992, SC_IW = 7056, SC_ZMLA = 7088, SC_ZGLA = 9136, SC_ZDSA = 10160;
static_assert(SC_ZDSA + 1024 == IN_W, "splits");
constexpr int NP = 11264;
constexpr int PC_CQ = 0, PC_CKV = 768, PC_KROPE = 1280, PC_IK = 1344, PC_IW = 1408, PC_GLOW = 1440, PC_GQ = 1536, PC_GK = 2048, PC_GV = 2560, PC_DQ = 3584, PC_DK = 4608,
              PC_DV = 4864, PC_IQ = 5120, PC_ZMLA = 7168, PC_ZGLA = 9216, PC_ZDSA = 10240;
constexpr int NG = 3 * DM;
constexpr int N1 = NP + NG;
constexpr int NQ = MLA_H * MLA_DQK;
constexpr int NKV = MLA_H * (MLA_NOPE + MLA_DV);
constexpr int YC_MLA = 0, YC_GLA = 2048, YC_DSA = 3072;

constexpr size_t MiB = 1u << 20;
constexpr size_t WS_CTL = 0, CTL_ZERO_BYTES = 1 * MiB;
constexpr size_t WS_MOD = 1 * MiB;
constexpr size_t WS_COS = WS_MOD + 256 * 1024;
constexpr size_t WS_SIN = WS_COS + 2 * MiB;
constexpr size_t WS_SSQ = WS_SIN + 2 * MiB;
constexpr size_t WS_DEC = WS_SSQ + 2 * MiB;
constexpr size_t WS_W = 16 * MiB;
constexpr size_t WO_W1 = 0;
constexpr size_t WO_WG8 = WO_W1 + (size_t)NP * DM * 2;
constexpr size_t WO_WUQ = WO_WG8 + (size_t)NG * DM;
constexpr size_t WO_WUKV = WO_WUQ + (size_t)NQ * MLA_QR * 2;
constexpr size_t WO_WBM = WO_WUKV + (size_t)NKV * MLA_KVR * 2;
constexpr size_t WO_WBG = WO_WBM + (size_t)DM * 2048 * 2;
constexpr size_t WO_WBD = WO_WBG + (size_t)DM * 1024 * 2;
constexpr size_t WO_WO = WO_WBD + (size_t)DM * 1024 * 2;
constexpr size_t W_BYTES = WO_WO + (size_t)DM * DM * 2;
constexpr size_t WS_H = WS_W + ((W_BYTES + MiB - 1) / MiB) * MiB;
constexpr size_t WS_UT = WS_H;
constexpr size_t WS_IDX = WS_H + 64 * MiB;
constexpr size_t WS_P = WS_H + (size_t)T * DM * 2;
constexpr size_t WS_G = WS_P + (size_t)T * NP * 2;
constexpr size_t WS_Q = WS_G + (size_t)T * NG * 2;
constexpr size_t WS_K = WS_Q + (size_t)T * NQ * 2;
constexpr size_t WS_V = WS_K + (size_t)T * NQ * 2;
constexpr size_t WS_MG = WS_Q;
constexpr size_t WS_Y = WS_V + (size_t)T * 2048 * 2;
constexpr size_t WS_H8 = WS_Y;
constexpr size_t WS_DKV = WS_Y + (size_t)T * DM * 2;
constexpr size_t WS_IKC = WS_DKV + (size_t)T * 512 * 2;
constexpr size_t WS_BCG = WS_IKC + (size_t)T * 64 * 2;
constexpr size_t WS_END = WS_BCG + 32 * MiB;
static_assert(WS_END <= 1536ull * MiB, "workspace map must stay below the guaranteed size (4 x the largest tensor)");

constexpr int CW_BAR = 4096;

constexpr int RING_OFF = 0, RING_BYTES = 131072;
constexpr int KBUF_OFF = 131072;
constexpr int MISC_OFF = 147456;
constexpr int LDS_BYTES = 148480;
constexpr int NWAVES = 8;

#define GAS __attribute__((address_space(1)))
#define LAS __attribute__((address_space(3)))
typedef unsigned short bf16;
typedef unsigned v4u __attribute__((ext_vector_type(4)));
typedef unsigned v2u __attribute__((ext_vector_type(2)));
typedef float f32x4 __attribute__((ext_vector_type(4)));
typedef float f32x2 __attribute__((ext_vector_type(2)));
typedef float f32x16 __attribute__((ext_vector_type(16)));
typedef short bf16x8 __attribute__((ext_vector_type(8)));
typedef short s16x4 __attribute__((ext_vector_type(4)));
#define LDS_WAIT() asm volatile("s_waitcnt lgkmcnt(0)" ::: "memory")
#define VM_WAIT() asm volatile("s_waitcnt vmcnt(0)" ::: "memory")
__device__ __forceinline__ unsigned f2bf(float f) { unsigned u = __builtin_bit_cast(unsigned, f); return (u + 0x7fffu + ((u >> 16) & 1u)) >> 16; }
__device__ __forceinline__ unsigned pk2(float lo, float hi) { return f2bf(lo) | (f2bf(hi) << 16); }
__device__ __forceinline__ float bf2f(unsigned b) { return __builtin_bit_cast(float, b << 16); }
__device__ __forceinline__ float bflo(unsigned w) { return __builtin_bit_cast(float, w << 16); }
__device__ __forceinline__ float bfhi(unsigned w) { return __builtin_bit_cast(float, w & 0xffff0000u); }
__device__ __forceinline__ unsigned cvtpk(float lo, float hi) { unsigned r; asm volatile("v_cvt_pk_bf16_f32 %0, %1, %2" : "=v"(r) : "v"(lo), "v"(hi)); return r; }
__device__ __forceinline__ float fast_exp(float x) { return __builtin_amdgcn_exp2f(x * 1.4426950408889634f); }
__device__ __forceinline__ float sigmoidf_(float x) { return __builtin_amdgcn_rcpf(1.0f + fast_exp(-x)); }
__device__ __forceinline__ float siluf_(float x) { return x * sigmoidf_(x); }
__device__ __forceinline__ float wave_sum(float v) {
#pragma unroll
    for (int o = 1; o < 64; o <<= 1) v += __shfl_xor(v, o);
    return v;
}
__device__ __forceinline__ float wave_sum_dpp(float v) {
    v += __builtin_bit_cast(float, __builtin_amdgcn_update_dpp(0, __builtin_bit_cast(int, v), 0xB1, 0xF, 0xF, true));
    v += __builtin_bit_cast(float, __builtin_amdgcn_update_dpp(0, __builtin_bit_cast(int, v), 0x4E, 0xF, 0xF, true));
    v += __builtin_bit_cast(float, __builtin_amdgcn_update_dpp(0, __builtin_bit_cast(int, v), 0x141, 0xF, 0xF, true));
    v += __builtin_bit_cast(float, __builtin_amdgcn_update_dpp(0, __builtin_bit_cast(int, v), 0x140, 0xF, 0xF, true));
    const int vi = __builtin_bit_cast(int, v);
    return (__builtin_bit_cast(float, __builtin_amdgcn_readlane(vi, 0)) + __builtin_bit_cast(float, __builtin_amdgcn_readlane(vi, 16))) +
           (__builtin_bit_cast(float, __builtin_amdgcn_readlane(vi, 32)) + __builtin_bit_cast(float, __builtin_amdgcn_readlane(vi, 48)));
}
__device__ __forceinline__ int crow(int r, int hi) { return (r & 3) + 8 * (r >> 2) + 4 * hi; }

namespace pg8 {
#define PG8_LAS __attribute__((address_space(3)))
typedef unsigned short bf16_t;
typedef short bf16x8 __attribute__((ext_vector_type(8)));
typedef float f32x4 __attribute__((ext_vector_type(4)));
typedef unsigned u32x4 __attribute__((ext_vector_type(4)));
constexpr int BM = 256, BK = 64, HALF = 128, HTB = HALF * BK * 2  , STAGE_BYTES = 8 * HTB, NXCD = 8, WGM = 8;

__host__ __device__ __forceinline__ int lds_byte(int r, int c) { const int st = (r >> 4) * 2 + (c >> 5), rr = r & 15, cc = c & 31, ob = rr * 64 + cc * 2; return st * 1024 + (ob ^ (((ob >> 9) & 1) << 5)); }
__host__ __device__ __forceinline__ void stage_rc(int b, int& R, int& C) { const int st = b / 1024, sb = b % 1024, swz = sb ^ (((sb >> 9) & 1) << 5); R = (st >> 1) * 16 + swz / 64; C = (st & 1) * 32 + (swz % 64) / 2; }
__host__ __device__ __forceinline__ int perm32(int rho) { const int n = rho >> 4, i = rho & 15; return 8 * (i >> 2) + 4 * n + (i & 3); }

struct Unit { int pm, pn; };
struct Gemm { const bf16_t* A; const bf16_t* Bt; int M, N, K, lda, ldb; };

struct StaticOrder {
    int nM, nN, nwg, G, c;
    __host__ __device__ void init(int M, int N, int G_, int c_) { nM = M / BM; nN = N / BM; nwg = nM * nN; G = G_; c = c_; }
    __host__ __device__ bool next(int i, Unit& u) const {
        const long L = (long)i * G + c; if (L >= nwg) return false;
        int wgid = (int)L; { const int q = nwg / NXCD, r = nwg % NXCD, xcd = wgid % NXCD, off = wgid / NXCD; wgid = (xcd < r ? xcd * (q + 1) : r * (q + 1) + (xcd - r) * q) + off; }
        const int nig = WGM * nN, gid = wgid / nig, fm = gid * WGM, gsz = (nM - fm) < WGM ? (nM - fm) : WGM;
        u.pm = fm + ((wgid % nig) % gsz); u.pn = (wgid % nig) / gsz; return true;
    }
    __device__ __forceinline__ void a_ready(const Unit&) const {}
    __device__ __forceinline__ void done(const Unit&) const {}
};

__device__ __forceinline__ unsigned cvt_pk_bf16(float lo, float hi) { unsigned r; asm volatile("v_cvt_pk_bf16_f32 %0, %1, %2" : "=v"(r) : "v"(lo), "v"(hi)); return r; }
__device__ __forceinline__ float fexp(float x) { return __builtin_amdgcn_exp2f(x * 1.4426950408889634f); }
__device__ __forceinline__ float fsig(float x) { return __builtin_amdgcn_rcpf(1.0f + fexp(-x)); }
__device__ __forceinline__ float blo(unsigned w) { return __builtin_bit_cast(float, w << 16); }
__device__ __forceinline__ float bhi(unsigned w) { return __builtin_bit_cast(float, w & 0xffff0000u); }
__device__ __forceinline__ u32x4 pack8(const f32x4 v0, const f32x4 v1) { u32x4 w; w.x = cvt_pk_bf16(v0[0], v0[1]); w.y = cvt_pk_bf16(v0[2], v0[3]); w.z = cvt_pk_bf16(v1[0], v1[1]); w.w = cvt_pk_bf16(v1[2], v1[3]); return w; }

#ifndef G_CONST
#define G_CONST 0
#endif
#ifndef NT_STORE
#define NT_STORE 0
#endif
#ifndef NOBIAS
#define NOBIAS 0
#endif
struct EpiG1 {
    static constexpr bool PERM = true, AFTER_DRAIN = false, HAS_MID = false;
    bf16_t* P; bf16_t* G; const float* bmg; float* ssq; int pn0; float gsc; bf16_t* DKV; bf16_t* IKC;
    __device__ __forceinline__ void operator()(const f32x4 (&acc)[2][2][4][2], const Unit& uu, int wr, int wc, int fr, int fq) const {
        const int pn = uu.pn + pn0;
        const int row0 = uu.pm * BM + wr * 64 + fr;
        const bool isG = pn >= 44, stat = pn < 5;
        const int mode = isG ? 2 : (pn >= 28 ? 1 : 0);
        const bool isKV = (pn == 18) || (pn == 19);
        const ptrdiff_t dsel = (isG ? (G - P) : (ptrdiff_t)0) + (isKV ? (DKV - P) : (ptrdiff_t)0);
        bf16_t* base = P + dsel; const int pitch = isG ? 12288 : (isKV ? 512 : 11264);
        const int col0 = (isG ? (pn - 44) : (isKV ? (pn - 18) : pn)) * BM + wc * 32 + 8 * fq;
        const bool isIK = (pn == 5) && (wc >= 2);
#pragma unroll
        for (int ai = 0; ai < 2; ++ai)
#pragma unroll
            for (int m = 0; m < 4; ++m) { const int row = row0 + ai * HALF + m * 16; bf16_t* rowp = base + (size_t)row * pitch + col0; float ss = 0.f;
#pragma unroll
                for (int bj = 0; bj < 2; ++bj) { f32x4 v0 = acc[ai][bj][m][0], v1 = acc[ai][bj][m][1];
                    if (stat) ss += (v0[0] * v0[0] + v0[1] * v0[1]) + (v0[2] * v0[2] + v0[3] * v0[3]) + (v1[0] * v1[0] + v1[1] * v1[1]) + (v1[2] * v1[2] + v1[3] * v1[3]);
                    if (mode == 1) {
#pragma unroll
                        for (int j = 0; j < 4; ++j) { v0[j] = v0[j] * fsig(v0[j]); v1[j] = v1[j] * fsig(v1[j]); } }
                    if (mode == 2) { const f32x4 b0 = *(const f32x4*)(bmg + col0 + bj * HALF), b1 = *(const f32x4*)(bmg + col0 + bj * HALF + 4);
#pragma unroll
                        for (int j = 0; j < 4; ++j) { v0[j] = fsig(v0[j] * gsc + b0[j]); v1[j] = fsig(v1[j] * gsc + b1[j]); } }
                    const u32x4 pk_ = pack8(v0, v1); if (NT_STORE) __builtin_nontemporal_store(pk_, (u32x4*)(rowp + bj * HALF)); else *(u32x4*)(rowp + bj * HALF) = pk_;
                    if (isIK && bj == 0) *(u32x4*)(IKC + (size_t)row * 64 + (wc - 2) * 32 + 8 * fq) = pk_; }
                if (stat) { ss += __shfl_xor(ss, 16); ss += __shfl_xor(ss, 32); if (fq == 0) ssq[(size_t)row * 20 + pn * 4 + wc] = ss; } }
    }
};
struct EpiQ {
    static constexpr bool PERM = true, AFTER_DRAIN = false, HAS_MID = false;
    bf16_t* Q; const float* ssq; const float* cosT; const float* sinT; float qscale;
    __device__ __forceinline__ void operator()(const f32x4 (&acc)[2][2][4][2], const Unit& u, int wr, int wc, int fr, int fq) const {
        const int row0 = u.pm * BM + wr * 64 + fr, col0 = u.pn * BM + wc * 32 + 8 * fq;
#pragma unroll
        for (int ai = 0; ai < 2; ++ai)
#pragma unroll
            for (int m = 0; m < 4; ++m) { const int row = row0 + ai * HALF + m * 16, b = row >> 13, s = row & 8191;
                const f32x4* sp = (const f32x4*)(ssq + (size_t)row * 20); const f32x4 s0 = sp[0], s1 = sp[1], s2 = sp[2];
                const float tot = ((s0[0] + s0[1]) + (s0[2] + s0[3])) + ((s1[0] + s1[1]) + (s1[2] + s1[3])) + ((s2[0] + s2[1]) + (s2[2] + s2[3]));
                const float rq = __builtin_amdgcn_rsqf(tot * (1.0f / 768.0f) + 1e-6f) * qscale;
#pragma unroll
                for (int bj = 0; bj < 2; ++bj) { const int col = col0 + bj * HALF, h = col / 192, d = col - h * 192;
                    f32x4 v0 = acc[ai][bj][m][0] * rq, v1 = acc[ai][bj][m][1] * rq;
                    if (d >= 128) { const int j0 = (d - 128) >> 1; const f32x4 c = *(const f32x4*)(cosT + (size_t)row * 32 + j0), sn = *(const f32x4*)(sinT + (size_t)row * 32 + j0);
                        float x1, x2;
                        x1 = v0[0]; x2 = v0[1]; v0[0] = x1 * c[0] - x2 * sn[0]; v0[1] = x1 * sn[0] + x2 * c[0];
                        x1 = v0[2]; x2 = v0[3]; v0[2] = x1 * c[1] - x2 * sn[1]; v0[3] = x1 * sn[1] + x2 * c[1];
                        x1 = v1[0]; x2 = v1[1]; v1[0] = x1 * c[2] - x2 * sn[2]; v1[1] = x1 * sn[2] + x2 * c[2];
                        x1 = v1[2]; x2 = v1[3]; v1[2] = x1 * c[3] - x2 * sn[3]; v1[3] = x1 * sn[3] + x2 * c[3]; }
                    *(u32x4*)(Q + (((size_t)(b * 16 + h) * 8192 + s) * 192 + d)) = pack8(v0, v1); } }
    }
};
struct EpiKV {
    static constexpr bool PERM = true, AFTER_DRAIN = false, HAS_MID = false;
    bf16_t* Kb; bf16_t* Vb; const float* ssq;
    __device__ __forceinline__ void operator()(const f32x4 (&acc)[2][2][4][2], const Unit& u, int wr, int wc, int fr, int fq) const {
        const int row0 = u.pm * BM + wr * 64 + fr, col0 = u.pn * BM + wc * 32 + 8 * fq;
#pragma unroll
        for (int ai = 0; ai < 2; ++ai)
#pragma unroll
            for (int m = 0; m < 4; ++m) { const int row = row0 + ai * HALF + m * 16, b = row >> 13, s = row & 8191;
                const f32x4* sp = (const f32x4*)(ssq + (size_t)row * 20 + 12); const f32x4 s0 = sp[0], s1 = sp[1];
                const float tot = ((s0[0] + s0[1]) + (s0[2] + s0[3])) + ((s1[0] + s1[1]) + (s1[2] + s1[3]));
                const float rk = __builtin_amdgcn_rsqf(tot * (1.0f / 512.0f) + 1e-6f);
#pragma unroll
                for (int bj = 0; bj < 2; ++bj) { const int col = col0 + bj * HALF;
                    const f32x4 v0 = acc[ai][bj][m][0] * rk, v1 = acc[ai][bj][m][1] * rk;
                    bf16_t* dst;
                    if (col < 2048) { const int h = col >> 7, d = col & 127; dst = Kb + (((size_t)(b * 16 + h) * 8192 + s) * 192 + d); }
                    else { const int c2 = col - 2048, h = c2 >> 7, d = c2 & 127; dst = Vb + (((size_t)(b * 16 + h) * 8192 + s) * 128 + d); }
                    *(u32x4*)dst = pack8(v0, v1); } }
    }
};
template <int STEP> struct EpiMerge {
    static constexpr bool PERM = true, AFTER_DRAIN = false, HAS_MID = false;
    bf16_t* MG; const bf16_t* G;
    __device__ __forceinline__ void operator()(const f32x4 (&acc)[2][2][4][2], const Unit& u, int wr, int wc, int fr, int fq) const {
        const int row0 = u.pm * BM + wr * 64 + fr, col0 = u.pn * BM + wc * 32 + 8 * fq;
#pragma unroll
        for (int ai = 0; ai < 2; ++ai)
#pragma unroll
            for (int m = 0; m < 4; ++m) { const int row = row0 + ai * HALF + m * 16;
#pragma unroll
                for (int bj = 0; bj < 2; ++bj) { const int col = col0 + bj * HALF;
                    const u32x4 gw = *(const u32x4*)(G + (size_t)row * 12288 + STEP * 4096 + col);
                    f32x4 v0 = acc[ai][bj][m][0], v1 = acc[ai][bj][m][1];
                    v0[0] *= blo(gw.x); v0[1] *= bhi(gw.x); v0[2] *= blo(gw.y); v0[3] *= bhi(gw.y); v1[0] *= blo(gw.z); v1[1] *= bhi(gw.z); v1[2] *= blo(gw.w); v1[3] *= bhi(gw.w);
                    bf16_t* dst = MG + (size_t)row * 4096 + col;
                    if (STEP > 0) { const u32x4 pw = *(const u32x4*)dst;
                        v0[0] += blo(pw.x); v0[1] += bhi(pw.x); v0[2] += blo(pw.y); v0[3] += bhi(pw.y); v1[0] += blo(pw.z); v1[1] += bhi(pw.z); v1[2] += blo(pw.w); v1[3] += bhi(pw.w); }
                    *(u32x4*)dst = pack8(v0, v1); } }
    }
};
struct EpiMergeCat {
    static constexpr bool PERM = true, AFTER_DRAIN = false, HAS_MID = true;
    bf16_t* MG; const bf16_t* G;
    __device__ __forceinline__ bool is_mid(int t) const { return t == 32 || t == 48; }
    __device__ __forceinline__ void mid(f32x4 (&acc)[2][2][4][2], const Unit& u, int wr, int wc, int fr, int fq, int t) const {
        int fr_ = fr, fq_ = fq; asm volatile("" : "+v"(fr_), "+v"(fq_));
        const int row0 = u.pm * BM + wr * 64 + fr_, col0 = u.pn * BM + wc * 32 + 8 * fq_, x = (t == 32) ? 0 : 1;
#pragma unroll
        for (int ai = 0; ai < 2; ++ai)
#pragma unroll
            for (int m = 0; m < 4; ++m) { const int row = row0 + ai * HALF + m * 16;
#pragma unroll
                for (int bj = 0; bj < 2; ++bj) { const int col = col0 + bj * HALF;
                    const u32x4 gn = *(const u32x4*)(G + (size_t)row * 12288 + x * 4096 + col), gd = *(const u32x4*)(G + (size_t)row * 12288 + (x + 1) * 4096 + col);
                    const unsigned nw[4] = {gn.x, gn.y, gn.z, gn.w}, dw[4] = {gd.x, gd.y, gd.z, gd.w};
#pragma unroll
                    for (int j = 0; j < 4; ++j) { const float n0 = fmaxf(blo(nw[j]), 1e-20f), n1 = fmaxf(bhi(nw[j]), 1e-20f), d0 = fmaxf(blo(dw[j]), 1e-20f), d1 = fmaxf(bhi(dw[j]), 1e-20f);
                        f32x4& a = acc[ai][bj][m][j >> 1]; a[(j & 1) * 2] *= n0 * __builtin_amdgcn_rcpf(d0); a[(j & 1) * 2 + 1] *= n1 * __builtin_amdgcn_rcpf(d1); } }
                asm volatile("" ::: "memory"); }
    }
    __device__ __forceinline__ void operator()(const f32x4 (&acc)[2][2][4][2], const Unit& u, int wr, int wc, int fr, int fq) const {
        const int row0 = u.pm * BM + wr * 64 + fr, col0 = u.pn * BM + wc * 32 + 8 * fq;
#pragma unroll
        for (int ai = 0; ai < 2; ++ai)
#pragma unroll
            for (int m = 0; m < 4; ++m) { const int row = row0 + ai * HALF + m * 16;
#pragma unroll
                for (int bj = 0; bj < 2; ++bj) { const int col = col0 + bj * HALF;
                    const u32x4 gw = *(const u32x4*)(G + (size_t)row * 12288 + 2 * 4096 + col);
                    f32x4 v0 = acc[ai][bj][m][0], v1 = acc[ai][bj][m][1];
                    v0[0] *= fmaxf(blo(gw.x), 1e-20f); v0[1] *= fmaxf(bhi(gw.x), 1e-20f); v0[2] *= fmaxf(blo(gw.y), 1e-20f); v0[3] *= fmaxf(bhi(gw.y), 1e-20f);
                    v1[0] *= fmaxf(blo(gw.z), 1e-20f); v1[1] *= fmaxf(bhi(gw.z), 1e-20f); v1[2] *= fmaxf(blo(gw.w), 1e-20f); v1[3] *= fmaxf(bhi(gw.w), 1e-20f);
                    *(u32x4*)(MG + (size_t)row * 4096 + col) = pack8(v0, v1); } }
    }
};
struct EpiOut {
    static constexpr bool PERM = false, AFTER_DRAIN = false, HAS_MID = false;
    const float* xin; float* out; const float* gate;
    __device__ __forceinline__ void operator()(const f32x4 (&acc)[2][2][4][2], const Unit& u, int wr, int wc, int fr, int fq) const {
        const int row0 = u.pm * BM + wr * 64 + fr, col0 = u.pn * BM + wc * 32 + 4 * fq;
#pragma unroll
        for (int ai = 0; ai < 2; ++ai)
#pragma unroll
            for (int m = 0; m < 4; ++m) { const int row = row0 + ai * HALF + m * 16, b = row >> 13;
#pragma unroll
                for (int bj = 0; bj < 2; ++bj)
#pragma unroll
                    for (int n = 0; n < 2; ++n) { const int col = col0 + bj * HALF + n * 16;
                        const f32x4 gv = *(const f32x4*)(gate + (size_t)b * 12288 + col); const f32x4 xv = *(const f32x4*)(xin + (size_t)row * 4096 + col);
                        *(f32x4*)(out + (size_t)row * 4096 + col) = xv + gv * acc[ai][bj][m][n]; } }
    }
};


typedef int v8i_t __attribute__((ext_vector_type(8)));
__device__ __forceinline__ v8i_t cat16(const bf16x8 lo, const bf16x8 hi) { v8i_t r; bf16x8* p = reinterpret_cast<bf16x8*>(&r); p[0] = lo; p[1] = hi; return r; }
template <class Epi, class Sched, bool ALIGN_EPI = false, bool SP2 = false, bool FP8 = false>
__device__ __forceinline__ void gemm_phase(PG8_LAS unsigned char* lds, const Gemm g, const Sched& S, const Epi& E) {
    int tid_ = threadIdx.x; asm volatile("" : "+v"(tid_));
    const int tid = tid_, wid = __builtin_amdgcn_readfirstlane(tid >> 6), lane = tid & 63, wr = wid >> 2, wc = wid & 3, fr = lane & 15, fq = lane >> 4;
    const int K = g.K, nt = K / BK;
    unsigned voffA[2], voffB[2];
#pragma unroll
    for (int i = 0; i < 2; ++i) { int R, C; stage_rc(tid * 16 + i * 8192, R, C); const int Rb = Epi::PERM ? ((R & ~31) + perm32(R & 31)) : R;
        voffA[i] = (unsigned)(R * g.lda + C) * 2u; voffB[i] = (unsigned)(Rb * g.ldb + C) * 2u; }
    const size_t kstep = (size_t)(BK * 2);
    const size_t hstepA = (size_t)HALF * g.lda * 2, hstepB = (size_t)HALF * g.ldb * 2;
    const size_t tstepA = 2 * hstepA, tstepB = 2 * hstepB;
    const unsigned ldsw = (unsigned)wid * 1024u;
    const int aoff = lds_byte(wr * 64 + fr, fq * 8), boff = lds_byte(wc * 32 + fr, fq * 8);
#define PG8_SA(b, h) (((b) * 2 + (h)) * HTB)
#define PG8_SB(b, h) ((4 + (b) * 2 + (h)) * HTB)
#define PG8_STAGE(bufoff, gbase, voff) do { _Pragma("unroll") for (int _i = 0; _i < 2; ++_i) \
        __builtin_amdgcn_global_load_lds((const unsigned*)((const char*)(gbase) + (voff)[_i]), (PG8_LAS unsigned*)(lds + (bufoff) + ldsw + _i * 8192), 16, 0, 0); } while (0)
#define PG8_LDA(dst, b, h) do { _Pragma("unroll") for (int m = 0; m < 4; ++m) _Pragma("unroll") for (int k = 0; k < 2; ++k) dst[m][k] = *(const PG8_LAS bf16x8*)(lds + PG8_SA(b, h) + aoff + m * 2048 + k * 1024); } while (0)
#define PG8_LDB(dst, b, h) do { _Pragma("unroll") for (int n = 0; n < 2; ++n) _Pragma("unroll") for (int k = 0; k < 2; ++k) dst[n][k] = *(const PG8_LAS bf16x8*)(lds + PG8_SB(b, h) + boff + n * 2048 + k * 1024); } while (0)
#define PG8_MMA(ai, bj, At, Bt) do { __builtin_amdgcn_s_setprio(1); \
        if constexpr (FP8) { _Pragma("unroll") for (int m = 0; m < 4; ++m) _Pragma("unroll") for (int n = 0; n < 2; ++n) \
            asm volatile("v_mfma_scale_f32_16x16x128_f8f6f4 %0, %1, %2, %0, %3, %3 op_sel_hi:[0,0,0]" : "+v"(acc[ai][bj][m][n]) : "v"(cat16(Bt[n][0], Bt[n][1])), "v"(cat16(At[m][0], At[m][1])), "v"(0x7F7F7F7F)); } \
        else { _Pragma("unroll") for (int m = 0; m < 4; ++m) _Pragma("unroll") for (int n = 0; n < 2; ++n) _Pragma("unroll") for (int k = 0; k < 2; ++k) \
            acc[ai][bj][m][n] = __builtin_amdgcn_mfma_f32_16x16x32_bf16(Bt[n][k], At[m][k], acc[ai][bj][m][n], 0, 0, 0); } \
        __builtin_amdgcn_s_setprio(0); } while (0)
#define PG8_WAIT_V(n) asm volatile("s_waitcnt vmcnt(" #n ")" ::: "memory")
#define PG8_WAIT_L(n) asm volatile("s_waitcnt lgkmcnt(" #n ")" ::: "memory")
#define PG8_BAR __builtin_amdgcn_s_barrier()
#define PG8_SCHED __builtin_amdgcn_sched_barrier(0)
    Unit cur, nxt; int ui = 0;
    if (!S.next(0, cur)) return;
    f32x4 acc[2][2][4][2];
#pragma unroll
    for (int a = 0; a < 2; ++a)
#pragma unroll
        for (int b = 0; b < 2; ++b)
#pragma unroll
            for (int m = 0; m < 4; ++m)
#pragma unroll
                for (int n = 0; n < 2; ++n) acc[a][b][m][n] = (f32x4){0.f, 0.f, 0.f, 0.f};
    bf16x8 At[4][2], B0[2][2], B1[2][2];
    const char* cA = (const char*)g.A + (size_t)cur.pm * tstepA; const char* cB = (const char*)g.Bt + (size_t)cur.pn * tstepB;
    S.a_ready(cur);
    if constexpr (SP2) {
        PG8_STAGE(PG8_SB(0, 0), cB, voffB); PG8_STAGE(PG8_SB(0, 1), cB + hstepB, voffB); PG8_STAGE(PG8_SA(0, 0), cA, voffA); PG8_STAGE(PG8_SA(0, 1), cA + hstepA, voffA);
        if (wr == 1) PG8_BAR;
        PG8_WAIT_V(2); PG8_BAR;
        PG8_STAGE(PG8_SB(1, 0), cB + kstep, voffB); PG8_STAGE(PG8_SA(1, 0), cA + kstep, voffA); PG8_STAGE(PG8_SB(1, 1), cB + hstepB + kstep, voffB);
        PG8_WAIT_V(6); PG8_BAR;
    } else {
        PG8_STAGE(PG8_SB(0, 0), cB, voffB); PG8_STAGE(PG8_SA(0, 0), cA, voffA); PG8_STAGE(PG8_SB(0, 1), cB + hstepB, voffB); PG8_STAGE(PG8_SA(0, 1), cA + hstepA, voffA);
        if (wr == 1) PG8_BAR;
        PG8_WAIT_V(4); PG8_BAR;
        PG8_STAGE(PG8_SB(1, 0), cB + kstep, voffB); PG8_STAGE(PG8_SA(1, 0), cA + kstep, voffA); PG8_STAGE(PG8_SB(1, 1), cB + hstepB + kstep, voffB);
        PG8_WAIT_V(6); PG8_BAR;
    }
    for (;;) {
        const bool has_next = S.next(ui + 1, nxt);
        const char* nA = has_next ? (const char*)g.A + (size_t)nxt.pm * tstepA : cA; const char* nB = has_next ? (const char*)g.Bt + (size_t)nxt.pn * tstepB : cB;
        for (int t = 0; t < nt; t += 2) {
            if constexpr (Epi::HAS_MID) { if (E.is_mid(t)) E.mid(acc, cur, wr, wc, fr, fq, t); }
            const bool last = (t == nt - 2);
            const char* a1 = cA + (size_t)(t + 1) * kstep;
            const char* a2 = last ? nA : cA + (size_t)(t + 2) * kstep; const char* b2 = last ? nB : cB + (size_t)(t + 2) * kstep;
            const char* a3 = a2 + kstep; const char* b3 = b2 + kstep;
            if (last && has_next) S.a_ready(nxt);
            if constexpr (SP2) {
            PG8_LDB(B0, 0, 0); PG8_LDB(B1, 0, 1); PG8_SCHED; PG8_LDA(At, 0, 0); PG8_STAGE(PG8_SA(1, 1), a1 + hstepA, voffA);
            PG8_WAIT_V(8); PG8_WAIT_L(0); PG8_BAR; PG8_MMA(0, 0, At, B0); PG8_MMA(0, 1, At, B1); PG8_BAR; PG8_SCHED;
            PG8_LDA(At, 0, 1); PG8_STAGE(PG8_SB(0, 0), b2, voffB); PG8_STAGE(PG8_SB(0, 1), b2 + hstepB, voffB); PG8_STAGE(PG8_SA(0, 0), a2, voffA);
            PG8_WAIT_V(8); PG8_WAIT_L(0); PG8_BAR; PG8_MMA(1, 0, At, B0); PG8_MMA(1, 1, At, B1); PG8_BAR; PG8_SCHED;
            PG8_LDB(B0, 1, 0); PG8_LDB(B1, 1, 1); PG8_SCHED; PG8_LDA(At, 1, 0); PG8_STAGE(PG8_SA(0, 1), a2 + hstepA, voffA);
            PG8_WAIT_V(8); PG8_WAIT_L(0); PG8_BAR; PG8_MMA(0, 0, At, B0); PG8_MMA(0, 1, At, B1); PG8_BAR; PG8_SCHED;
            PG8_LDA(At, 1, 1); PG8_STAGE(PG8_SB(1, 0), b3, voffB); PG8_STAGE(PG8_SB(1, 1), b3 + hstepB, voffB); PG8_STAGE(PG8_SA(1, 0), a3, voffA);
            PG8_WAIT_V(8); PG8_WAIT_L(0); PG8_BAR; PG8_MMA(1, 0, At, B0); PG8_MMA(1, 1, At, B1); PG8_BAR; PG8_SCHED;
            } else {
            PG8_LDB(B0, 0, 0); PG8_SCHED; PG8_LDA(At, 0, 0); PG8_STAGE(PG8_SA(1, 1), a1 + hstepA, voffA);
            PG8_WAIT_L(8); PG8_BAR; PG8_WAIT_L(0); PG8_MMA(0, 0, At, B0); PG8_BAR; PG8_SCHED;
            PG8_LDB(B1, 0, 1); PG8_STAGE(PG8_SB(0, 0), b2, voffB);
            PG8_BAR; PG8_WAIT_L(0); PG8_MMA(0, 1, At, B1); PG8_BAR;
            PG8_LDA(At, 0, 1); PG8_STAGE(PG8_SA(0, 0), a2, voffA);
            PG8_BAR; PG8_WAIT_L(0); PG8_MMA(1, 0, At, B0); PG8_BAR; PG8_SCHED;
            PG8_STAGE(PG8_SB(0, 1), b2 + hstepB, voffB);
            PG8_WAIT_V(6); PG8_BAR; PG8_MMA(1, 1, At, B1); PG8_BAR;
            PG8_LDB(B0, 1, 0); PG8_SCHED; PG8_LDA(At, 1, 0); PG8_STAGE(PG8_SA(0, 1), a2 + hstepA, voffA);
            PG8_WAIT_L(8); PG8_BAR; PG8_WAIT_L(0); PG8_MMA(0, 0, At, B0); PG8_BAR; PG8_SCHED;
            PG8_LDB(B1, 1, 1); PG8_STAGE(PG8_SB(1, 0), b3, voffB);
            PG8_BAR; PG8_WAIT_L(0); PG8_MMA(0, 1, At, B1); PG8_BAR;
            PG8_LDA(At, 1, 1); PG8_STAGE(PG8_SA(1, 0), a3, voffA);
            PG8_BAR; PG8_WAIT_L(0); PG8_MMA(1, 0, At, B0); PG8_BAR; PG8_SCHED;
            PG8_STAGE(PG8_SB(1, 1), b3 + hstepB, voffB);
            PG8_WAIT_V(6); PG8_BAR; PG8_MMA(1, 1, At, B1); PG8_BAR;
            }
        }
        if constexpr (ALIGN_EPI) { if (wr == 0) PG8_BAR; }
        if constexpr (!Epi::AFTER_DRAIN) { E(acc, cur, wr, wc, fr, fq); S.done(cur); }
        if (!has_next) break;
#pragma unroll
        for (int a = 0; a < 2; ++a)
#pragma unroll
            for (int b = 0; b < 2; ++b)
#pragma unroll
                for (int m = 0; m < 4; ++m)
#pragma unroll
                    for (int n = 0; n < 2; ++n) acc[a][b][m][n] = (f32x4){0.f, 0.f, 0.f, 0.f};
        cur = nxt; cA = nA; cB = nB; ++ui;
        if constexpr (ALIGN_EPI) { if (wr == 1) PG8_BAR; }
    }
    PG8_WAIT_V(0);
    if constexpr (!ALIGN_EPI) { if (wr == 0) PG8_BAR; }
    PG8_BAR;
    if constexpr (Epi::AFTER_DRAIN) { E.fused(acc, cur, wr, wc, fr, fq, lds, wid, lane); S.done(cur); }
#undef PG8_SA
#undef PG8_SB
#undef PG8_STAGE
#undef PG8_LDA
#undef PG8_LDB
#undef PG8_MMA
#undef PG8_WAIT_V
#undef PG8_WAIT_L
#undef PG8_BAR
#undef PG8_SCHED
}
}

#define XB_TMO      128
#define XB_XCNT(j)  (256  + 64 * (j))
#define XB_XSUB(j)  (1280 + 64 * (j))
#define XB_XGEN(j)  (2304 + 64 * (j))
#define XB_TOP      3328
#define XB_TOPGEN   3392
#define XCD_BAR_WORDS 3456
#define XB_SPIN_CAP (1u << 24)

__device__ __forceinline__ unsigned xb_ld(unsigned* p)              { return __hip_atomic_load(p, __ATOMIC_RELAXED, __HIP_MEMORY_SCOPE_AGENT); }
__device__ __forceinline__ unsigned xb_add(unsigned* p, unsigned v) { return __hip_atomic_fetch_add(p, v, __ATOMIC_RELAXED, __HIP_MEMORY_SCOPE_AGENT); }
__device__ __forceinline__ unsigned xb_xcc_id() { return (unsigned)__builtin_amdgcn_s_getreg((3 << 11) | 20) & 0xFu; }
#define XB_SPIN(cond, bar) do { unsigned _sp = 0; while (cond) { __builtin_amdgcn_s_sleep(1); \
    if ((++_sp & 255u) == 0u) { if (xb_ld(&(bar)[XB_TMO])) break; if (_sp > XB_SPIN_CAP) { atomicAdd(&(bar)[XB_TMO], 1u); break; } } } } while (0)

struct XcdBarrier {
    unsigned* bar; unsigned x;
    volatile LAS unsigned* st;
};

__device__ __forceinline__ XcdBarrier xcd_barrier_post(unsigned* bar, volatile LAS unsigned* st) {
    XcdBarrier b; b.bar = bar; b.x = xb_xcc_id(); b.st = st;
    if (threadIdx.x == 0) (void)xb_add(&bar[XB_XCNT(b.x)], 1u);
    return b;
}
__device__ __forceinline__ void xcd_barrier_complete(unsigned* bar, unsigned x, unsigned& nloc, unsigned& nx) {
    const unsigned G = gridDim.x * gridDim.y * gridDim.z;
    unsigned sum, cnt, mine, sp = 0u;
    for (;;) {
        sum = 0u; cnt = 0u; mine = 0u;
#pragma unroll
        for (unsigned j = 0; j < 16; ++j) { const unsigned c = xb_ld(&bar[XB_XCNT(j)]); sum += c; cnt += (c > 0u) ? 1u : 0u; mine = (j == x) ? c : mine; }
        if (sum == G) break;
        __builtin_amdgcn_s_sleep(1);
        if ((++sp & 255u) == 0u) { if (xb_ld(&bar[XB_TMO])) break; if (sp > XB_SPIN_CAP) { atomicAdd(&bar[XB_TMO], 1u); break; } }
    }
    nloc = mine > 0u ? mine : 1u; nx = cnt > 0u ? cnt : 1u;
}

__device__ __forceinline__ void xcd_barrier(const XcdBarrier& b) {
    asm volatile("s_waitcnt vmcnt(0)" ::: "memory");
    __syncthreads();
    if (threadIdx.x == 0) {
        unsigned* bar = b.bar;
        __builtin_amdgcn_s_waitcnt(0);
        unsigned nloc = b.st[0], nx = b.st[1];
        if (nloc == 0u) { xcd_barrier_complete(bar, b.x, nloc, nx); b.st[0] = nloc; b.st[1] = nx; }
        const unsigned old = xb_add(&bar[XB_XSUB(b.x)], 1u);
        const unsigned gen = old / nloc;
        if (old + 1u == (gen + 1u) * nloc) {
            __builtin_amdgcn_fence(__ATOMIC_RELEASE, "agent");
            asm volatile("s_waitcnt vmcnt(0)" ::: "memory");
            const unsigned og = xb_add(&bar[XB_TOP], 1u);
            const unsigned tg = og / nx;
            if (og + 1u == (tg + 1u) * nx) xb_add(&bar[XB_TOPGEN], 1u);
            else XB_SPIN(xb_ld(&bar[XB_TOPGEN]) == tg, bar);
            __builtin_amdgcn_fence(__ATOMIC_ACQUIRE, "agent");
            xb_add(&bar[XB_XGEN(b.x)], 1u);
            asm volatile("s_waitcnt vmcnt(0)" ::: "memory");
        } else {
            XB_SPIN(xb_ld(&bar[XB_XGEN(b.x)]) == gen, bar);
            __builtin_amdgcn_fence(__ATOMIC_ACQUIRE, "agent");
            asm volatile("s_waitcnt vmcnt(0)" ::: "memory");
        }
    }
    __syncthreads();
}

#ifndef MLA_OUT_SCALE
#define MLA_OUT_SCALE 1.0f
#endif
namespace mla {
constexpr int DQK = 192, DV = 128, KVBLK = 64, QB = 256;
constexpr int SHM_K = KVBLK * DQK * 2, SHM_V = KVBLK * DV * 2;
constexpr int LDS_V = 0, LDS_K = 2 * SHM_V, LDS_WS = 2 * SHM_V + 2 * SHM_K;
#define MLA_KSWZ(row, colB) ((row) * 384 + ((colB) ^ (((row) & 7) << 4)))
#define SBAR() __builtin_amdgcn_sched_barrier(0)
__device__ __forceinline__ int v_st(int k, int c) { const int kk = (k & ~0xC) | ((k & 4) << 1) | ((k & 8) >> 1); return ((kk >> 3) * 4 + (c >> 5)) * 512 + ((kk & 7) * 32 + (c & 31)) * 2; }
__device__ __forceinline__ int v_rd_base(int lane) { return ((lane & 3) << 3) | (((lane >> 2) & 3) << 6) | (((lane >> 4) & 1) << 5) | (((lane >> 5) & 1) << 8); }
constexpr int v_rd_off(int d0, int ks, int half) { return d0 * 512 + ks * 4096 + half * 2048; }

__device__ __forceinline__ void mask_tile(f32x16& p0, f32x16& p1, int dq) {
    const float NEG = -__builtin_inff();
#pragma unroll
    for (int r = 0; r < 16; ++r) {
        const int c = (r & 3) + 8 * (r >> 2);
        if (dq - c < 0) p0[r] = NEG;
        if (dq - c - 32 < 0) p1[r] = NEG;
    }
}
constexpr float THR2 = 8.f;
__device__ __forceinline__ void softmax_tile(f32x16& p0, f32x16& p1, float& m_reg, float& alpha, float& l_reg, bf16x8& pa0, bf16x8& pa1, bf16x8& pa2, bf16x8& pa3) {
    float pmax = p0[0];
#pragma unroll
    for (int r = 1; r < 16; ++r) pmax = fmaxf(pmax, p0[r]);
#pragma unroll
    for (int r = 0; r < 16; ++r) pmax = fmaxf(pmax, p1[r]);
    { auto rr = __builtin_amdgcn_permlane32_swap(__float_as_uint(pmax), __float_as_uint(pmax), false, false);
      pmax = fmaxf(__uint_as_float(rr[0]), __uint_as_float(rr[1])); }
    float mn;
    if (__builtin_expect(__all((pmax - m_reg) <= THR2), 1)) { mn = m_reg; alpha = 1.f; }
    else { mn = fmaxf(m_reg, pmax); alpha = __builtin_amdgcn_exp2f(m_reg - mn); m_reg = mn; }
#pragma unroll
    for (int r = 0; r < 16; ++r) { p0[r] = __builtin_amdgcn_exp2f(p0[r] - mn); p1[r] = __builtin_amdgcn_exp2f(p1[r] - mn); }
    float ps = 0;
#pragma unroll
    for (int r = 0; r < 16; ++r) ps += p0[r];
#pragma unroll
    for (int r = 0; r < 16; ++r) ps += p1[r];
    { auto rr = __builtin_amdgcn_permlane32_swap(__float_as_uint(ps), __float_as_uint(ps), false, false);
      ps = __uint_as_float(rr[0]) + __uint_as_float(rr[1]); }
    l_reg = l_reg * alpha + ps;
#define PK4(P, B_, OUT) do { unsigned a0 = cvtpk(P[B_+0], P[B_+1]), a1 = cvtpk(P[B_+2], P[B_+3]);                          \
        unsigned b0 = cvtpk(P[B_+4], P[B_+5]), b1 = cvtpk(P[B_+6], P[B_+7]);                                             \
        auto r0 = __builtin_amdgcn_permlane32_swap(a0, b0, false, false); auto r1 = __builtin_amdgcn_permlane32_swap(a1, b1, false, false); \
        v4u w = {r0[0], r1[0], r0[1], r1[1]}; OUT = *reinterpret_cast<bf16x8*>(&w); } while (0)
    PK4(p0, 0, pa0); PK4(p0, 8, pa1); PK4(p1, 0, pa2); PK4(p1, 8, pa3);
#undef PK4
}
template <int KB>
__device__ __forceinline__ void qkt(f32x16& p0, f32x16& p1, const char* K_lds, int r32, int hi, const bf16x8* qr) {
    p0 = f32x16{}; p1 = f32x16{};
    const char* kb[4];
#pragma unroll
    for (int dd = 0; dd < 4; ++dd) kb[dd] = K_lds + KB * SHM_K + MLA_KSWZ(r32, (dd * 16 + hi * 8) * 2);
#pragma unroll
    for (int d0 = 0; d0 < 12; ++d0) { const char* a = kb[d0 & 3] + (d0 >> 2) * 128;
        bf16x8 b0 = *reinterpret_cast<const bf16x8*>(a);
        bf16x8 b1 = *reinterpret_cast<const bf16x8*>(a + 32 * 384);
        p0 = __builtin_amdgcn_mfma_f32_32x32x16_bf16(b0, qr[d0], p0, 0, 0, 0);
        p1 = __builtin_amdgcn_mfma_f32_32x32x16_bf16(b1, qr[d0], p1, 0, 0, 0); }
}
template <int VB>
__device__ __forceinline__ void pv_tile(f32x16* o, int vb0, bf16x8 pa0, bf16x8 pa1, bf16x8 pa2, bf16x8 pa3) {
#define TRRD(dst, off) asm volatile("ds_read_b64_tr_b16 %0, %1 offset:%2" : "=&v"(dst) : "v"(vb0), "i"(off) : "memory")
#define PV_D0(d0) do { s16x4 l0, l1, l2, l3, h0, h1, h2, h3; constexpr int b_ = VB * SHM_V + v_rd_off(d0, 0, 0);   \
        TRRD(l0, b_); TRRD(h0, b_ + 2048); TRRD(l1, b_ + 4096); TRRD(h1, b_ + 6144); TRRD(l2, b_ + 8192); TRRD(h2, b_ + 10240); TRRD(l3, b_ + 12288); TRRD(h3, b_ + 14336); \
        asm volatile("s_waitcnt lgkmcnt(0)" ::: "memory"); SBAR();                                                   \
        o[d0] = __builtin_amdgcn_mfma_f32_32x32x16_bf16(pa0, (bf16x8){l0[0], l0[1], l0[2], l0[3], h0[0], h0[1], h0[2], h0[3]}, o[d0], 0, 0, 0);   \
        o[d0] = __builtin_amdgcn_mfma_f32_32x32x16_bf16(pa1, (bf16x8){l1[0], l1[1], l1[2], l1[3], h1[0], h1[1], h1[2], h1[3]}, o[d0], 0, 0, 0);   \
        o[d0] = __builtin_amdgcn_mfma_f32_32x32x16_bf16(pa2, (bf16x8){l2[0], l2[1], l2[2], l2[3], h2[0], h2[1], h2[2], h2[3]}, o[d0], 0, 0, 0);   \
        o[d0] = __builtin_amdgcn_mfma_f32_32x32x16_bf16(pa3, (bf16x8){l3[0], l3[1], l3[2], l3[3], h3[0], h3[1], h3[2], h3[3]}, o[d0], 0, 0, 0); } while (0)
    PV_D0(0); PV_D0(1); PV_D0(2); PV_D0(3);
#undef PV_D0
#undef TRRD
}
__device__ __forceinline__ void attn_block(const bf16* Qh, const bf16* Kh, const bf16* Vh, bf16* Yp, const bf16* Zp, int P0, char* lds) {
    int tid_ = threadIdx.x; asm volatile("" : "+v"(tid_));
    const int tid = tid_, wid = __builtin_amdgcn_readfirstlane(tid >> 6), lane = tid & 63, r32 = lane & 31, hi = lane >> 5;
    const int NT = (P0 + QB) / KVBLK;
    const int qlo = P0 + wid * 32, qm = qlo + r32 - 4 * hi;
    char* V_lds = lds + LDS_V; char* K_lds = lds + LDS_K;
    float* ws = (float*)(lds + LDS_WS) + wid * 64; float* li_l = ws, * al_l = ws + 32;
    float m_reg = -1e30f, l_reg = 0; f32x16 o[4] = {};
    const int sr = tid >> 4, sc = (tid & 15) * 8, vst0 = v_st(sr, sc), vst1 = v_st(32 + sr, sc);
    int kgo[3], klo[3];
#pragma unroll
    for (int j = 0; j < 3; ++j) { const int i = tid + 512 * j, row = i / 24, c = i - row * 24; kgo[j] = row * 192 + c * 8; klo[j] = MLA_KSWZ(row, c * 16); }
    const int vb0 = (int)(uintptr_t)V_lds + v_rd_base(lane);
    bf16x8 qr[12];
#pragma unroll
    for (int d0 = 0; d0 < 12; ++d0) qr[d0] = *reinterpret_cast<const bf16x8*>(Qh + (size_t)(P0 + wid * 32 + r32) * 192 + d0 * 16 + hi * 8);
    bf16x8 st_k0, st_k1, st_k2, st_v0, st_v1;
#define SLOAD(k0) do { const bf16* kp = Kh + (size_t)(k0) * 192; const bf16* vp = Vh + (size_t)(k0) * 128;                     \
        st_k0 = *reinterpret_cast<const bf16x8*>(kp + kgo[0]); st_k1 = *reinterpret_cast<const bf16x8*>(kp + kgo[1]); st_k2 = *reinterpret_cast<const bf16x8*>(kp + kgo[2]); \
        st_v0 = *reinterpret_cast<const bf16x8*>(vp + (size_t)sr * 128 + sc); st_v1 = *reinterpret_cast<const bf16x8*>(vp + (size_t)(32 + sr) * 128 + sc); } while (0)
#define SWRITE(bf) do { *(bf16x8*)(K_lds + (bf) * SHM_K + klo[0]) = st_k0; *(bf16x8*)(K_lds + (bf) * SHM_K + klo[1]) = st_k1; *(bf16x8*)(K_lds + (bf) * SHM_K + klo[2]) = st_k2; \
        *(bf16x8*)(V_lds + (bf) * SHM_V + vst0) = st_v0; *(bf16x8*)(V_lds + (bf) * SHM_V + vst1) = st_v1; } while (0)
#define RESC(a) do { if (__any((a) < 1.f)) { if (hi == 0) al_l[r32] = (a); asm volatile("s_waitcnt lgkmcnt(0)" ::: "memory");              \
                     for (int d_ = 0; d_ < 4; ++d_) for (int r = 0; r < 16; ++r) o[d_][r] *= al_l[crow(r, hi)]; } } while (0)
    SLOAD(0); VM_WAIT(); SWRITE(0);
    __syncthreads();
    f32x16 p0, p1; bf16x8 pa0, pa1, pa2, pa3; float alpha;
#define STEP(t, BUF) do {                                                                                                 \
        if ((t) + 1 < NT) SLOAD(((t) + 1) * KVBLK);                                                                       \
        SBAR(); qkt<BUF>(p0, p1, K_lds, r32, hi, qr);                                                                    \
        { const int kb_ = (t) * KVBLK; if (kb_ + KVBLK - 1 > qlo) mask_tile(p0, p1, qm - kb_); }                          \
        softmax_tile(p0, p1, m_reg, alpha, l_reg, pa0, pa1, pa2, pa3);                                                    \
        RESC(alpha);                                                                                                      \
        pv_tile<BUF>(o, vb0, pa0, pa1, pa2, pa3);                                                                         \
        if ((t) + 1 < NT) { VM_WAIT(); SWRITE(1 - (BUF)); }                                                               \
        __syncthreads(); } while (0)
    for (int t = 0; t < NT; t += 2) { STEP(t, 0); STEP(t + 1, 1); }
#undef STEP
    if (hi == 0) li_l[r32] = l_reg; asm volatile("s_waitcnt lgkmcnt(0)" ::: "memory");
    float rli[16];
#pragma unroll
    for (int r = 0; r < 16; ++r) rli[r] = __builtin_amdgcn_rcpf(li_l[crow(r, hi)]);
#pragma unroll
    for (int r = 0; r < 16; ++r) { const size_t orow = (size_t)(P0 + wid * 32 + crow(r, hi));
#pragma unroll
        for (int d0 = 0; d0 < 4; ++d0) { const float z = bf2f(Zp[orow * NP + d0 * 32 + r32]); const float v = o[d0][r] * rli[r] * z * MLA_OUT_SCALE;
            const float vn = __shfl_xor(v, 1);
            if ((r32 & 1) == 0) *(unsigned*)(Yp + orow * 4096 + d0 * 32 + r32) = cvtpk(v, vn); } }
    __syncthreads();
#undef SLOAD
#undef SWRITE
#undef RESC
}
#undef SBAR
}

struct Args { const void* in[21]; float* out; unsigned char* ws; int ph_lo, ph_hi; };
typedef const __attribute__((address_space(4))) Args* KArgs;
struct Frame {
    LAS unsigned char* lds;
    int tid, lane, wave, G, c;
    const float *x, *cvec; const int* pos; const float *norm_g, *w_ada, *b_ada, *w_in, *mla_gq, *mla_wuq, *mla_gkv, *mla_wukv, *gla_wg2, *gla_bg, *gla_gout, *w_mg, *b_mg, *w_bm, *w_bg, *w_bd, *w_o, *final_g;
    float* out;
    float *MOD, *COS, *SIN, *SSQ, *DEC, *BCG;
    bf16 *W1, *WUQ, *WUKV, *WBM, *WBG, *WBD, *WO; unsigned char *WG8, *H8;
    bf16 *H, *UT, *P, *GT, *Q, *K, *V, *MG, *Y, *DKV, *IKC;
    int* IDX;
};
__device__ __forceinline__ void frame_init(Frame& F, LAS unsigned char* lds) {
    KArgs ap = (KArgs)__builtin_amdgcn_kernarg_segment_ptr(); asm volatile("" : "+s"(ap));
    int t = threadIdx.x; asm volatile("" : "+v"(t));
    F.lds = lds; F.tid = t; F.lane = t & 63; F.wave = __builtin_amdgcn_readfirstlane(t >> 6); F.G = gridDim.x; F.c = blockIdx.x;
    F.x = (const float*)ap->in[0]; F.cvec = (const float*)ap->in[1]; F.pos = (const int*)ap->in[2]; F.norm_g = (const float*)ap->in[3]; F.w_ada = (const float*)ap->in[4];
    F.b_ada = (const float*)ap->in[5]; F.w_in = (const float*)ap->in[6]; F.mla_gq = (const float*)ap->in[7]; F.mla_wuq = (const float*)ap->in[8]; F.mla_gkv = (const float*)ap->in[9];
    F.mla_wukv = (const float*)ap->in[10]; F.gla_wg2 = (const float*)ap->in[11]; F.gla_bg = (const float*)ap->in[12]; F.gla_gout = (const float*)ap->in[13]; F.w_mg = (const float*)ap->in[14];
    F.b_mg = (const float*)ap->in[15]; F.w_bm = (const float*)ap->in[16]; F.w_bg = (const float*)ap->in[17]; F.w_bd = (const float*)ap->in[18]; F.w_o = (const float*)ap->in[19];
    F.final_g = (const float*)ap->in[20]; F.out = ap->out;
    unsigned char* ws = ap->ws;
    F.MOD = (float*)(ws + WS_MOD); F.COS = (float*)(ws + WS_COS); F.SIN = (float*)(ws + WS_SIN); F.SSQ = (float*)(ws + WS_SSQ); F.DEC = (float*)(ws + WS_DEC); F.BCG = (float*)(ws + WS_BCG);
    F.WG8 = ws + WS_W + WO_WG8; F.H8 = ws + WS_H8;
    F.W1 = (bf16*)(ws + WS_W + WO_W1); F.WUQ = (bf16*)(ws + WS_W + WO_WUQ); F.WUKV = (bf16*)(ws + WS_W + WO_WUKV); F.WBM = (bf16*)(ws + WS_W + WO_WBM);
    F.WBG = (bf16*)(ws + WS_W + WO_WBG); F.WBD = (bf16*)(ws + WS_W + WO_WBD); F.WO = (bf16*)(ws + WS_W + WO_WO);
    F.H = (bf16*)(ws + WS_H); F.UT = (bf16*)(ws + WS_UT); F.IDX = (int*)(ws + WS_IDX); F.P = (bf16*)(ws + WS_P); F.GT = (bf16*)(ws + WS_G);
    F.Q = (bf16*)(ws + WS_Q); F.K = (bf16*)(ws + WS_K); F.V = (bf16*)(ws + WS_V); F.MG = (bf16*)(ws + WS_MG); F.Y = (bf16*)(ws + WS_Y); F.DKV = (bf16*)(ws + WS_DKV); F.IKC = (bf16*)(ws + WS_IKC);
}

template <bool FP8, class Map>
__device__ __forceinline__ void transpose_item(const float* W, int K, int Nsrc, void* WTv, const float* kscale, float scale, Map map, LAS float* scr, int item, int nblk, int lane, int ldt = 0) {
    if (ldt == 0) ldt = K;
    const int kb = item / nblk, nb = item - kb * nblk, k0 = 64 * kb, n0 = 64 * nb;
    const int c4 = lane & 15, kr = lane >> 4;
    const int s0 = map(n0 + 4 * c4), s1 = map(n0 + 4 * c4 + 1), s2 = map(n0 + 4 * c4 + 2), s3 = map(n0 + 4 * c4 + 3);
    const bool vec = (s0 >= 0) && (s1 == s0 + 1) && (s2 == s0 + 2) && (s3 == s0 + 3) && ((s0 & 3) == 0);
#pragma unroll 4
    for (int i = 0; i < 16; ++i) { const int kk = 4 * i + kr; const float* wr = W + (size_t)(k0 + kk) * Nsrc; f32x4 v;
        if (vec) v = *(const f32x4*)(wr + s0);
        else { v[0] = s0 >= 0 ? wr[s0] : 0.f; v[1] = s1 >= 0 ? wr[s1] : 0.f; v[2] = s2 >= 0 ? wr[s2] : 0.f; v[3] = s3 >= 0 ? wr[s3] : 0.f; }
        float sc = scale; if (kscale) sc *= kscale[k0 + kk];
        LAS float* d = scr + kk * 65 + 4 * c4; d[0] = v[0] * sc; d[1] = v[1] * sc; d[2] = v[2] * sc; d[3] = v[3] * sc; }
    LDS_WAIT(); asm volatile("" ::: "memory");
    const int c = lane & 7;
#pragma unroll
    for (int j = 0; j < 8; ++j) { const int n = (lane >> 3) + 8 * j; const LAS float* s = scr + (8 * c) * 65 + n;
        if constexpr (FP8) {
            int w0 = __builtin_amdgcn_cvt_pk_fp8_f32(s[0 * 65], s[1 * 65], 0, false); w0 = __builtin_amdgcn_cvt_pk_fp8_f32(s[2 * 65], s[3 * 65], w0, true);
            int w1 = __builtin_amdgcn_cvt_pk_fp8_f32(s[4 * 65], s[5 * 65], 0, false); w1 = __builtin_amdgcn_cvt_pk_fp8_f32(s[6 * 65], s[7 * 65], w1, true);
            v2u o; o.x = (unsigned)w0; o.y = (unsigned)w1; *(v2u*)((unsigned char*)WTv + (size_t)(n0 + n) * ldt + k0 + 8 * c) = o;
        } else {
            v4u o; o.x = pk2(s[0 * 65], s[1 * 65]); o.y = pk2(s[2 * 65], s[3 * 65]); o.z = pk2(s[4 * 65], s[5 * 65]); o.w = pk2(s[6 * 65], s[7 * 65]);
            *(v4u*)((bf16*)WTv + (size_t)(n0 + n) * ldt + k0 + 8 * c) = o; } }
    LDS_WAIT(); asm volatile("" ::: "memory");
}
struct MapId { __device__ __forceinline__ int operator()(int n) const { return n; } };
struct MapIn {
    __device__ __forceinline__ int operator()(int n) const {
        if (n < 1280) return n;
        if (n < 1344) { const int jj = n - 1280; return SC_KROPE + (jj & 1) * 32 + (jj >> 1); }
        if (n < 1408) return SC_IK + (n - 1344);
        if (n < 1440) return SC_IW + (n - 1408);
        if (n < 1456) return SC_GLOW + (n - 1440);
        if (n < 1536) return -1;
        if (n < 2048) return SC_GQ + (n - 1536);
        if (n < 2560) return SC_GK + (n - 2048);
        if (n < 3584) return SC_GV + (n - 2560);
        if (n < 4608) return SC_DQ + (n - 3584);
        if (n < 4864) return SC_DK + (n - 4608);
        if (n < 5120) return SC_DV + (n - 4864);
        if (n < 7168) return SC_IQ + (n - 5120);
        if (n < 9216) return SC_ZMLA + (n - 7168);
        if (n < 10240) return SC_ZGLA + (n - 9216);
        return SC_ZDSA + (n - 10240);
    }
};
struct MapUQ {
    __device__ __forceinline__ int operator()(int n) const { const int h = n / 192, d = n - h * 192; if (d < 128) return n; const int jj = d - 128; return h * 192 + 128 + (jj & 1) * 32 + (jj >> 1); }
};
struct MapUKV {
    __device__ __forceinline__ int operator()(int n) const { if (n < 2048) { const int h = n >> 7, d = n & 127; return h * 256 + d; } const int c = n - 2048, h = c >> 7, d = c & 127; return h * 256 + 128 + d; }
};

__device__ __forceinline__ void weights_phase(Frame& F, int l) {
    LAS float* scr = (LAS float*)(F.lds + RING_OFF + F.wave * 16640);
    const int gw = F.c * NWAVES + F.wave, NGW = F.G * NWAVES;
    constexpr int I_IN = (DM / 64) * (NP / 64), I_MG = (DM / 64) * (NG / 64), I_UQ = (MLA_QR / 64) * (NQ / 64), I_UKV = (MLA_KVR / 64) * (NKV / 64),
                  I_BM = (2048 / 64) * (DM / 64), I_BG = (1024 / 64) * (DM / 64), I_O = (DM / 64) * (DM / 64);
    constexpr int NITEMS = I_IN + I_MG + I_UQ + I_UKV + I_BM + 2 * I_BG + I_O;
    for (int it = gw; it < NITEMS; it += NGW) {
        int r = it;
        if (r < I_IN) { transpose_item<false>(F.w_in + (size_t)l * DM * IN_W, DM, IN_W, F.W1, nullptr, 1.f, MapIn(), scr, r, NP / 64, F.lane); continue; } r -= I_IN;
        if (r < I_MG) { transpose_item<true>(F.w_mg + (size_t)l * DM * NG, DM, NG, F.WG8, nullptr, 64.f, MapId(), scr, r, NG / 64, F.lane); continue; } r -= I_MG;
        if (r < I_UQ) { transpose_item<false>(F.mla_wuq + (size_t)l * MLA_QR * NQ, MLA_QR, NQ, F.WUQ, F.mla_gq + l * MLA_QR, 1.f, MapUQ(), scr, r, NQ / 64, F.lane); continue; } r -= I_UQ;
        if (r < I_UKV) { transpose_item<false>(F.mla_wukv + (size_t)l * MLA_KVR * NKV, MLA_KVR, NKV, F.WUKV, F.mla_gkv + l * MLA_KVR, 1.f, MapUKV(), scr, r, NKV / 64, F.lane); continue; } r -= I_UKV;
        if (r < I_BM) { transpose_item<false>(F.w_bm + (size_t)l * 2048 * DM, 2048, DM, F.WBM, nullptr, 1.f, MapId(), scr, r, DM / 64, F.lane, DM); continue; } r -= I_BM;
        if (r < I_BG) { transpose_item<false>(F.w_bg + (size_t)l * 1024 * DM, 1024, DM, F.WBM + 2048, nullptr, 1.f, MapId(), scr, r, DM / 64, F.lane, DM); continue; } r -= I_BG;
        if (r < I_BG) { transpose_item<false>(F.w_bd + (size_t)l * 1024 * DM, 1024, DM, F.WBM + 3072, nullptr, 1.f, MapId(), scr, r, DM / 64, F.lane, DM); continue; } r -= I_BG;
        transpose_item<false>(F.w_o + (size_t)l * DM * DM, DM, DM, F.WO, nullptr, 1.f, MapId(), scr, r, DM / 64, F.lane);
    }
}
__device__ __forceinline__ void mod_phase(Frame& F) {
    LAS float* red = (LAS float*)(F.lds + 70000);
    const int ks = F.tid >> 3, cg = F.tid & 7;
    for (int it = F.c; it < 768; it += F.G) {
        const int l = it / 384, n0 = (it - l * 384) * 32;
        const float* W = F.w_ada + (size_t)l * DM * NG + n0 + 4 * cg;
        f32x4 a0 = {0.f, 0.f, 0.f, 0.f}, a1 = {0.f, 0.f, 0.f, 0.f};
#pragma unroll 4
        for (int kk = 0; kk < 64; ++kk) { const int k = ks * 64 + kk; const f32x4 w = *(const f32x4*)(W + (size_t)k * NG);
            const float c0 = F.cvec[k], c1 = F.cvec[DM + k]; const float s0 = siluf_(c0), s1 = siluf_(c1);
            a0 += w * s0; a1 += w * s1; }
        __syncthreads();
        *(LAS f32x4*)(red + (ks * 8 + cg) * 8) = a0; *(LAS f32x4*)(red + (ks * 8 + cg) * 8 + 4) = a1;
        __syncthreads();
        if (F.tid < 64) { const int cgo = F.tid >> 3, e = F.tid & 7; float s = 0.f;
            for (int k2 = 0; k2 < 64; ++k2) s += red[(k2 * 8 + cgo) * 8 + e];
            const int b = e >> 2, n = n0 + 4 * cgo + (e & 3);
            F.MOD[((size_t)l * 2 + b) * NG + n] = s + F.b_ada[(size_t)l * NG + n]; }
    }
    __syncthreads();
}
__device__ __forceinline__ void rope_phase(Frame& F) {
    for (int i = (F.c * 512 + F.tid); i < T * 32; i += F.G * 512) { const int t = i >> 5, j = i & 31;
        const float inv = (float)pow(10000.0, -(double)(2 * j) / 64.0);
        const float ang = (float)F.pos[t] * inv;
        F.COS[i] = (float)cos((double)ang); F.SIN[i] = (float)sin((double)ang); }
}
__device__ __forceinline__ void norm_phase(Frame& F, const float* xin, int l) {
    const int gw = F.c * NWAVES + F.wave, NGW = F.G * NWAVES;
    const float* g = F.norm_g + (size_t)l * DM;
    for (int m = gw; m < T; m += NGW) { const int b = m >> 13;
        const float* shift = F.MOD + ((size_t)l * 2 + b) * NG; const float* scale = shift + DM;
        const f32x4* xr = (const f32x4*)(xin + (size_t)m * DM) + F.lane;
        f32x4 v[16]; float s = 0.f;
#pragma unroll
        for (int j = 0; j < 16; ++j) { v[j] = xr[64 * j]; s += (v[j][0] * v[j][0] + v[j][1] * v[j][1]) + (v[j][2] * v[j][2] + v[j][3] * v[j][3]); }
        const float rstd = 1.0f / sqrtf(wave_sum(s) * (1.0f / DM) + NORM_EPS);
        v2u* o8 = (v2u*)(F.H + (size_t)m * DM) + F.lane;
#pragma unroll
        for (int j = 0; j < 16; ++j) { const int col = 4 * (F.lane + 64 * j);
            const f32x4 gg = *(const f32x4*)(g + col), sc = *(const f32x4*)(scale + col), sh = *(const f32x4*)(shift + col);
            const f32x4 y = v[j] * rstd * gg * (sc + 1.0f) + sh;
            v2u w; w.x = pk2(y[0], y[1]); w.y = pk2(y[2], y[3]); o8[64 * j] = w;
            int q8 = __builtin_amdgcn_cvt_pk_fp8_f32(y[0], y[1], 0, false); q8 = __builtin_amdgcn_cvt_pk_fp8_f32(y[2], y[3], q8, true);
            *(int*)(F.H8 + (size_t)m * DM + col) = q8; }
    }
}
__device__ __forceinline__ void final_phase(Frame& F) {
    const int gw = F.c * NWAVES + F.wave, NGW = F.G * NWAVES;
    for (int m = gw; m < T; m += NGW) {
        f32x4* xr = (f32x4*)(F.out + (size_t)m * DM) + F.lane;
        f32x4 v[16]; float s = 0.f;
#pragma unroll
        for (int j = 0; j < 16; ++j) { v[j] = xr[64 * j]; s += (v[j][0] * v[j][0] + v[j][1] * v[j][1]) + (v[j][2] * v[j][2] + v[j][3] * v[j][3]); }
        const float rstd = 1.0f / sqrtf(wave_sum(s) * (1.0f / DM) + NORM_EPS);
#pragma unroll
        for (int j = 0; j < 16; ++j) { const int col = 4 * (F.lane + 64 * j); const f32x4 gg = *(const f32x4*)(F.final_g + col);
            xr[64 * j] = v[j] * rstd * gg * OUT_SCALE; }
    }
}
__device__ __forceinline__ void krope_phase(Frame& F) {
    for (int i = F.c * 512 + F.tid; i < T * 8; i += F.G * 512) { const int row = i >> 3, ch = i & 7, b = row >> 13, s = row & 8191;
        const v4u w = *(const v4u*)(F.P + (size_t)row * NP + PC_KROPE + ch * 8);
        const f32x4 c = *(const f32x4*)(F.COS + (size_t)row * 32 + ch * 4), sn = *(const f32x4*)(F.SIN + (size_t)row * 32 + ch * 4);
        v4u o; float x1, x2;
        x1 = bflo(w.x); x2 = bfhi(w.x); o.x = pk2(x1 * c[0] - x2 * sn[0], x1 * sn[0] + x2 * c[0]);
        x1 = bflo(w.y); x2 = bfhi(w.y); o.y = pk2(x1 * c[1] - x2 * sn[1], x1 * sn[1] + x2 * c[1]);
        x1 = bflo(w.z); x2 = bfhi(w.z); o.z = pk2(x1 * c[2] - x2 * sn[2], x1 * sn[2] + x2 * c[2]);
        x1 = bflo(w.w); x2 = bfhi(w.w); o.w = pk2(x1 * c[3] - x2 * sn[3], x1 * sn[3] + x2 * c[3]);
#pragma unroll
        for (int h = 0; h < 16; ++h) *(v4u*)(F.K + (((size_t)(b * 16 + h) * 8192 + s) * 192 + 128 + ch * 8)) = o; }
}

template <int K>
__device__ __forceinline__ void mma32_lds(f32x16& acc, const LAS unsigned char* A, int pa, const LAS unsigned char* B, int pb, int r32, int hi, int xa = 0, int xb = 0) {
#pragma unroll
    for (int k0 = 0; k0 < K; k0 += 16) {
        const bf16x8 a = *(const LAS bf16x8*)(A + r32 * pa + (((k0 + 8 * hi) * 2) ^ xa));
        const bf16x8 b = *(const LAS bf16x8*)(B + r32 * pb + (((k0 + 8 * hi) * 2) ^ xb));
        acc = __builtin_amdgcn_mfma_f32_32x32x16_bf16(a, b, acc, 0, 0, 0);
    }
}
constexpr int GL_BC = 0, GL_GL = 32768, GL_W2 = 36864, GL_BG = 45056, GL_X = 45568, GL_TOT = 131072;
__device__ __forceinline__ void gla_gates(Frame& F, int l, int b, int h, int n) {
    LAS float* bc = (LAS float*)(F.lds + GL_BC); LAS float* gl = (LAS float*)(F.lds + GL_GL); LAS float* w2 = (LAS float*)(F.lds + GL_W2); LAS float* bgs = (LAS float*)(F.lds + GL_BG);
    const size_t row0 = (size_t)b * SEQ + (size_t)n * GLA_C;
    for (int i = F.tid; i < 1024; i += 512) { const int c = i >> 4, r = i & 15; gl[i] = bf2f(F.P[(row0 + c) * NP + PC_GLOW + r]); }
    for (int i = F.tid; i < 2048; i += 512) { const int r = i >> 7, d = i & 127; w2[i] = F.gla_wg2[((size_t)l * GLA_R + r) * 512 + h * 128 + d]; }
    if (F.tid < 128) bgs[F.tid] = F.gla_bg[(size_t)l * 512 + h * 128 + F.tid];
    __syncthreads();
    { const int d = F.tid & 127, cg = F.tid >> 7; float run = 0.f, vals[16];
      LAS float* tot = (LAS float*)(F.lds + GL_TOT);
#pragma unroll
      for (int cc = 0; cc < 16; ++cc) { const int c = cg * 16 + cc; float xx = bgs[d];
#pragma unroll
          for (int r = 0; r < 16; ++r) xx += gl[c * 16 + r] * w2[r * 128 + d];
          const float ls = fminf(xx, 0.f) - log1pf(expf(-fabsf(xx)));
          run += ls * (1.0f / 16.0f); vals[cc] = run; }
      tot[cg * 128 + d] = run;
      __syncthreads();
      float off = 0.f;
      for (int g2 = 0; g2 < cg; ++g2) off += tot[g2 * 128 + d];
#pragma unroll
      for (int cc = 0; cc < 16; ++cc) bc[(cg * 16 + cc) * 128 + d] = vals[cc] + off; }
    __syncthreads();
}
__device__ __forceinline__ void gla1_phase(Frame& F, int l) {
    constexpr int PT = 144;
    LAS float* bc = (LAS float*)(F.lds + GL_BC);
    LAS unsigned char* keT = F.lds + GL_X; LAS unsigned char* vT = F.lds + GL_X + 128 * PT;
    const int r32 = F.lane & 31, hi = F.lane >> 5;
    for (int u = F.c; u < 8 * GLA_NCH; u += F.G) { const int bh = u >> 7, n = u & 127, b = bh >> 2, h = bh & 3;
        const size_t row0 = (size_t)b * SEQ + (size_t)n * GLA_C;
        const int c = F.tid >> 3, d8 = F.tid & 7;
        const bf16* kp = F.P + (row0 + c) * NP + PC_GK + h * 128 + d8 * 16; const v4u k0 = *(const v4u*)kp, k1 = *(const v4u*)(kp + 8);
        const bf16* vp = F.P + (row0 + c) * NP + PC_GV + h * 256 + d8 * 32; v4u vq[4];
#pragma unroll
        for (int q4 = 0; q4 < 4; ++q4) vq[q4] = *(const v4u*)(vp + q4 * 8);
        gla_gates(F, l, b, h, n);
        { float* bg_ = F.BCG + (size_t)u * 8192;
#pragma unroll
          for (int j = 0; j < 4; ++j) *(f32x4*)(bg_ + j * 2048 + F.tid * 4) = *(const LAS f32x4*)(bc + j * 2048 + F.tid * 4); }
        { const unsigned kw[8] = {k0.x, k0.y, k0.z, k0.w, k1.x, k1.y, k1.z, k1.w};
#pragma unroll
          for (int jj = 0; jj < 16; ++jj) { const int d = d8 * 16 + jj; const float kv = (jj & 1) ? bfhi(kw[jj >> 1]) : bflo(kw[jj >> 1]);
              const float ke = kv * expf(bc[63 * 128 + d] - bc[c * 128 + d]);
              *(LAS bf16*)(keT + d * PT + ((c ^ (8 * d8)) * 2)) = (bf16)f2bf(ke); }
#pragma unroll
          for (int q4 = 0; q4 < 4; ++q4) { const v4u vv = vq[q4]; const unsigned vw[4] = {vv.x, vv.y, vv.z, vv.w};
#pragma unroll
              for (int jj = 0; jj < 8; ++jj) { const int e = d8 * 32 + q4 * 8 + jj; *(LAS bf16*)(vT + e * PT + ((c ^ (8 * d8)) * 2)) = (bf16)((jj & 1) ? (vw[jj >> 1] >> 16) : (vw[jj >> 1] & 0xffffu)); } }
          if (F.tid < 128) F.DEC[((size_t)bh * GLA_NCH + n) * 128 + F.tid] = expf(bc[63 * 128 + F.tid]); }
        __syncthreads();
        bf16* UTn = F.UT + ((size_t)bh * GLA_NCH + n) * (256 * 128);
#pragma unroll 1
        for (int dt = 0; dt < 4; ++dt) { f32x16 acc = {};
            mma32_lds<64>(acc, keT + (dt * 32) * PT, PT, vT + (F.wave * 32) * PT, PT, r32, hi, 16 * ((2 * dt + (r32 >> 4)) & 7), 16 * F.wave);
#pragma unroll
            for (int g4 = 0; g4 < 4; ++g4) { v2u w; w.x = pk2(acc[4 * g4], acc[4 * g4 + 1]); w.y = pk2(acc[4 * g4 + 2], acc[4 * g4 + 3]);
                *(v2u*)(UTn + (size_t)(F.wave * 32 + r32) * 128 + dt * 32 + 8 * g4 + 4 * hi) = w; } }
        __syncthreads();
    }
}
__device__ __forceinline__ void gla2_phase(Frame& F) {
    for (int gid = F.c * 512 + F.tid; gid < 8 * 16384; gid += F.G * 512) { const int bh = gid >> 14, pr = gid & 16383, d = (2 * pr) & 127;
        unsigned* up = (unsigned*)(F.UT + (size_t)bh * GLA_NCH * 32768 + 2 * pr); const float* dp = F.DEC + (size_t)bh * GLA_NCH * 128 + d;
        float s0 = 0.f, s1 = 0.f;
        for (int n0 = 0; n0 < GLA_NCH; n0 += 8) { unsigned uu[8]; float d0[8], d1[8];
#pragma unroll
            for (int j = 0; j < 8; ++j) { uu[j] = up[(size_t)(n0 + j) * 16384]; d0[j] = dp[(n0 + j) * 128]; d1[j] = dp[(n0 + j) * 128 + 1]; }
#pragma unroll
            for (int j = 0; j < 8; ++j) { up[(size_t)(n0 + j) * 16384] = pk2(s0, s1); s0 = d0[j] * s0 + bflo(uu[j]); s1 = d1[j] * s1 + bfhi(uu[j]); } }
    }
}
__device__ __forceinline__ void gla3_phase(Frame& F, int l) {
    constexpr int PT = 144, PD = 272, PO = 1040;
    LAS float* bc = (LAS float*)(F.lds + GL_BC);
    LAS unsigned char* qd = F.lds + GL_X; LAS unsigned char* ki = qd + 64 * PD; LAS unsigned char* vT = ki + 64 * PD; LAS unsigned char* at = vT + 256 * PT;
    LAS unsigned char* of = F.lds;
    const int r32 = F.lane & 31, hi = F.lane >> 5;
    for (int u = F.c; u < 8 * GLA_NCH; u += F.G) { const int bh = u >> 7, n = u & 127, b = bh >> 2, h = bh & 3;
        const size_t row0 = (size_t)b * SEQ + (size_t)n * GLA_C;
        const int c = F.tid >> 3, d8 = F.tid & 7;
        const bf16* qp = F.P + (row0 + c) * NP + PC_GQ + h * 128 + d8 * 16; const v4u q0 = *(const v4u*)qp, q1 = *(const v4u*)(qp + 8);
        const bf16* kp = F.P + (row0 + c) * NP + PC_GK + h * 128 + d8 * 16; const v4u k0 = *(const v4u*)kp, k1 = *(const v4u*)(kp + 8);
        const bf16* vp = F.P + (row0 + c) * NP + PC_GV + h * 256 + d8 * 32; v4u vq[4];
#pragma unroll
        for (int q4 = 0; q4 < 4; ++q4) vq[q4] = *(const v4u*)(vp + q4 * 8);
        { const float* bg_ = F.BCG + (size_t)u * 8192; f32x4 bq[4];
#pragma unroll
          for (int j = 0; j < 4; ++j) bq[j] = *(const f32x4*)(bg_ + j * 2048 + F.tid * 4);
#pragma unroll
          for (int j = 0; j < 4; ++j) *(LAS f32x4*)(bc + j * 2048 + F.tid * 4) = bq[j]; }
        __syncthreads();
        { const unsigned qw[8] = {q0.x, q0.y, q0.z, q0.w, q1.x, q1.y, q1.z, q1.w}, kw[8] = {k0.x, k0.y, k0.z, k0.w, k1.x, k1.y, k1.z, k1.w};
          unsigned qo[8], ko[8];
#pragma unroll
          for (int j2 = 0; j2 < 8; ++j2) { const int d = d8 * 16 + 2 * j2; const float b0 = bc[c * 128 + d], b1 = bc[c * 128 + d + 1];
              qo[j2] = pk2(bflo(qw[j2]) * 0.08838834764831845f * expf(b0), bfhi(qw[j2]) * 0.08838834764831845f * expf(b1));
              ko[j2] = pk2(bflo(kw[j2]) * expf(-b0), bfhi(kw[j2]) * expf(-b1)); }
          *(LAS v4u*)(qd + c * PD + d8 * 32) = (v4u){qo[0], qo[1], qo[2], qo[3]}; *(LAS v4u*)(qd + c * PD + d8 * 32 + 16) = (v4u){qo[4], qo[5], qo[6], qo[7]};
          *(LAS v4u*)(ki + c * PD + d8 * 32) = (v4u){ko[0], ko[1], ko[2], ko[3]}; *(LAS v4u*)(ki + c * PD + d8 * 32 + 16) = (v4u){ko[4], ko[5], ko[6], ko[7]};
#pragma unroll
          for (int q4 = 0; q4 < 4; ++q4) { const v4u vv = vq[q4]; const unsigned vw[4] = {vv.x, vv.y, vv.z, vv.w};
#pragma unroll
              for (int jj = 0; jj < 8; ++jj) { const int e = d8 * 32 + q4 * 8 + jj; *(LAS bf16*)(vT + e * PT + ((c ^ (8 * d8)) * 2)) = (bf16)((jj & 1) ? (vw[jj >> 1] >> 16) : (vw[jj >> 1] & 0xffffu)); } } }
        bf16x8 sfr[8];
        { const bf16* sp = F.UT + (((size_t)bh * GLA_NCH + n) * 256 + F.wave * 32 + r32) * 128 + 8 * hi;
#pragma unroll
          for (int k0_ = 0; k0_ < 8; ++k0_) sfr[k0_] = *(const bf16x8*)(sp + k0_ * 16); }
        __syncthreads();
        if (F.wave < 4) { const int ct = F.wave >> 1, st = F.wave & 1; f32x16 acc = {};
            mma32_lds<128>(acc, qd + (ct * 32) * PD, PD, ki + (st * 32) * PD, PD, r32, hi);
#pragma unroll
            for (int i = 0; i < 16; ++i) { const int c = ct * 32 + crow(i, hi), s = st * 32 + r32; *(LAS bf16*)(at + c * PT + s * 2) = (bf16)f2bf(c >= s ? acc[i] : 0.f); } }
        __syncthreads();
        f32x16 o0 = {}, o1 = {};
        mma32_lds<64>(o0, at, PT, vT + (F.wave * 32) * PT, PT, r32, hi, 0, 16 * F.wave);
        mma32_lds<64>(o1, at + 32 * PT, PT, vT + (F.wave * 32) * PT, PT, r32, hi, 0, 16 * F.wave);
        {
#pragma unroll
          for (int k0 = 0; k0 < 8; ++k0) { const bf16x8 bb = sfr[k0];
              const bf16x8 a0 = *(const LAS bf16x8*)(qd + r32 * PD + (k0 * 16 + 8 * hi) * 2), a1 = *(const LAS bf16x8*)(qd + (32 + r32) * PD + (k0 * 16 + 8 * hi) * 2);
              o0 = __builtin_amdgcn_mfma_f32_32x32x16_bf16(a0, bb, o0, 0, 0, 0); o1 = __builtin_amdgcn_mfma_f32_32x32x16_bf16(a1, bb, o1, 0, 0, 0); } }
        const f32x4 gg = *(const f32x4*)(F.gla_gout + (size_t)l * 256 + 4 * F.lane); v2u zq[8];
#pragma unroll
        for (int rr = 0; rr < 8; ++rr) zq[rr] = *(const v2u*)(F.P + (row0 + F.wave * 8 + rr) * NP + PC_ZGLA + h * 256 + 4 * F.lane);
        __syncthreads();
#pragma unroll
        for (int i = 0; i < 16; ++i) { const int c = crow(i, hi), e = F.wave * 32 + r32; *(LAS float*)(of + c * PO + e * 4) = o0[i]; *(LAS float*)(of + (32 + c) * PO + e * 4) = o1[i]; }
        __syncthreads();
        {
#pragma unroll
          for (int rr = 0; rr < 8; ++rr) { const int c = F.wave * 8 + rr; const f32x4 v = *(const LAS f32x4*)(of + c * PO + F.lane * 16);
              const float ss = wave_sum_dpp((v[0] * v[0] + v[1] * v[1]) + (v[2] * v[2] + v[3] * v[3]));
              const float rs = 1.0f / sqrtf(ss * (1.0f / 256.0f) + NORM_EPS);
              const v2u zz = zq[rr];
              v2u w; w.x = pk2(v[0] * rs * gg[0] * bflo(zz.x), v[1] * rs * gg[1] * bfhi(zz.x)); w.y = pk2(v[2] * rs * gg[2] * bflo(zz.y), v[3] * rs * gg[3] * bfhi(zz.y));
              *(v2u*)(F.Y + (row0 + c) * DM + YC_GLA + h * 256 + 4 * F.lane) = w; } }
        __syncthreads();
    }
}

__device__ __forceinline__ int ik_off(int r, int c) { return (r >> 1) * 256 + (((((r & 1) << 3) | c) ^ ((r >> 1) & 15)) << 4); }
__device__ __forceinline__ unsigned mono_key(float f) { const unsigned u = __builtin_bit_cast(unsigned, f); return (u & 0x80000000u) ? ~u : (u | 0x80000000u); }
typedef unsigned v32u __attribute__((ext_vector_type(32)));
#define KREG(i) ((i) < 32 ? k0[(i) & 31] : (i) < 64 ? k1[(i) & 31] : (i) < 96 ? k2[(i) & 31] : k3[(i) & 31])
__device__ __forceinline__ int wsum_dpp(int v) {
    v += __builtin_amdgcn_update_dpp(0, v, 0xB1, 0xF, 0xF, true);
    v += __builtin_amdgcn_update_dpp(0, v, 0x4E, 0xF, 0xF, true);
    v += __builtin_amdgcn_update_dpp(0, v, 0x141, 0xF, 0xF, true);
    v += __builtin_amdgcn_update_dpp(0, v, 0x140, 0xF, 0xF, true);
    return __builtin_amdgcn_readlane(v, 0) + __builtin_amdgcn_readlane(v, 16) + __builtin_amdgcn_readlane(v, 32) + __builtin_amdgcn_readlane(v, 48);
}
__device__ __forceinline__ unsigned wmax_dpp(unsigned v) {
    { const unsigned t = (unsigned)__builtin_amdgcn_update_dpp(0, (int)v, 0xB1, 0xF, 0xF, true); v = v > t ? v : t; }
    { const unsigned t = (unsigned)__builtin_amdgcn_update_dpp(0, (int)v, 0x4E, 0xF, 0xF, true); v = v > t ? v : t; }
    { const unsigned t = (unsigned)__builtin_amdgcn_update_dpp(0, (int)v, 0x141, 0xF, 0xF, true); v = v > t ? v : t; }
    { const unsigned t = (unsigned)__builtin_amdgcn_update_dpp(0, (int)v, 0x140, 0xF, 0xF, true); v = v > t ? v : t; }
    const unsigned a = (unsigned)__builtin_amdgcn_readlane((int)v, 0), b = (unsigned)__builtin_amdgcn_readlane((int)v, 16), c = (unsigned)__builtin_amdgcn_readlane((int)v, 32), d = (unsigned)__builtin_amdgcn_readlane((int)v, 48);
    const unsigned ab = a > b ? a : b, cd = c > d ? c : d; return ab > cd ? ab : cd;
}
#ifndef SEL_CMAX
#define SEL_CMAX 1024
#endif
#ifndef SEL_MAXSKIP
#define SEL_MAXSKIP 1
#endif
__device__ __forceinline__ void dsa_select_regs(const v32u& k0, const v32u& k1, const v32u& k2, const v32u& k3, int lane, int tq, int* out, LAS unsigned* cl) {
    if (tq < TOPK) { for (int j = lane; j < TOPK; j += 64) out[j] = (j <= tq) ? j : -1; return; }
    const int ngrp = (tq >> 10) + 1;
    unsigned Tk = 0u; int cnt_lo = tq + 1, cnt_hi = 0, bit = 31; bool decided = false, compacted = false;
#if SEL_MAXSKIP
    unsigned kmax;
    { unsigned m = 0u;
#pragma unroll
      for (int g = 0; g < 8; ++g) if (g < ngrp) {
#pragma unroll
        for (int i = 0; i < 16; ++i) { const unsigned kv = KREG(g * 16 + i); m = m > kv ? m : kv; } }
      kmax = wmax_dpp(m); }
#endif
#pragma unroll 1
    for (; bit >= 0; --bit) { const unsigned cand = Tk | (1u << bit); int c_ = 0;
#if SEL_MAXSKIP
        if (cand > kmax) continue;
#endif
#pragma unroll
        for (int g = 0; g < 8; ++g) if (g < ngrp) {
#pragma unroll
            for (int i = 0; i < 16; ++i) c_ += (KREG(g * 16 + i) >= cand) ? 1 : 0; }
        const int cnt = wsum_dpp(c_);
        if (cnt >= TOPK) { Tk = cand; cnt_lo = cnt; } else cnt_hi = cnt;
        if (cnt == TOPK) { decided = true; break; }
        if (SEL_CMAX > 0 && Tk != 0u && cnt_lo - cnt_hi <= SEL_CMAX && bit >= 3) { compacted = true; break; } }
    if (compacted && !decided) {
        const unsigned wdt = 1u << bit; int base = 0;
#pragma unroll
        for (int g = 0; g < 8; ++g) if (g < ngrp) {
#pragma unroll
            for (int i = 0; i < 16; ++i) { const unsigned kv = KREG(g * 16 + i); const bool in = (kv ^ Tk) < wdt; const unsigned long long bm = __ballot(in);
                const int pos = (int)__builtin_amdgcn_mbcnt_hi((unsigned)(bm >> 32), __builtin_amdgcn_mbcnt_lo((unsigned)bm, (unsigned)base));
                if (in) cl[pos] = kv;
                base += __popcll(bm); } }
        unsigned c[16];
#pragma unroll
        for (int j = 0; j < 16; ++j) { const int p_ = j * 64 + lane; c[j] = (p_ < base) ? cl[p_] : 0u; }
#pragma unroll 1
        for (--bit; bit >= 0; --bit) { const unsigned cand = Tk | (1u << bit); int c_ = 0;
#pragma unroll
            for (int j = 0; j < 16; ++j) c_ += (c[j] >= cand) ? 1 : 0;
            const int cnt = cnt_hi + wsum_dpp(c_);
            if (cnt >= TOPK) Tk = cand;
            if (cnt == TOPK) break; } }
    int base = 0;
#pragma unroll
    for (int g = 0; g < 8; ++g) if (g < ngrp) {
#pragma unroll
        for (int i2 = 0; i2 < 16; ++i2) { const int i = g * 16 + i2; const bool gt = KREG(i) > Tk; const unsigned long long bm = __ballot(gt);
            const int pos = (int)__builtin_amdgcn_mbcnt_hi((unsigned)(bm >> 32), __builtin_amdgcn_mbcnt_lo((unsigned)bm, (unsigned)base));
            if (gt) out[pos] = i * 64 + lane;
            base += __popcll(bm); } }
    if (base < TOPK) {
#pragma unroll
        for (int g = 0; g < 8; ++g) if (g < ngrp) {
#pragma unroll
            for (int i2 = 0; i2 < 16; ++i2) { const int i = g * 16 + i2; const bool eq = KREG(i) == Tk; const unsigned long long bm = __ballot(eq);
                if (bm != 0ull && base < TOPK) {
                    const int pos = (int)__builtin_amdgcn_mbcnt_hi((unsigned)(bm >> 32), __builtin_amdgcn_mbcnt_lo((unsigned)bm, (unsigned)base));
                    if (eq && pos < TOPK) out[pos] = i * 64 + lane;
                    base += __popcll(bm); } } } }
}
template <int MODE>
__device__ __forceinline__ void dsa_index_phase(Frame& F) {
    LAS unsigned char* kbuf = F.lds;
    const int lane = F.lane, r32 = lane & 31, hi = lane >> 5;
    for (int L = F.c; L < 2048; L += F.G) { const int bb = L >> 10, r = L & 1023, j = r >> 8, w_ = r & 255, u = (j & 1) ? j * 256 + 255 - w_ : j * 256 + w_;
        const int t0 = 8 * u, tq = t0 + F.wave; const size_t row = (size_t)bb * SEQ + tq;
        const int nstage = (t0 + 7) / 256 + 1;
        bf16x8 afr[4]; float wv[16];
#pragma unroll
        for (int ks = 0; ks < 4; ++ks) afr[ks] = *(const bf16x8*)(F.P + row * NP + PC_IQ + r32 * 64 + ks * 16 + hi * 8);
#pragma unroll
        for (int i = 0; i < 16; ++i) wv[i] = bf2f(F.P[row * NP + PC_IW + crow(i, hi)]);
        const char* kp0 = (const char*)(F.IKC + ((size_t)bb * SEQ + F.wave * 32) * 64);
#define IDX_STAGE_DMA(s_) do { LAS unsigned char* db = kbuf + ((s_) & 1) * 32768 + F.wave * 4096; int ln_ = lane; asm volatile("" : "+v"(ln_));                    \
        const char* sb_ = kp0 + (size_t)(s_) * 256 * 128;                                                                                                         \
        _Pragma("unroll") for (int i = 0; i < 4; ++i) { const int Rl = i * 4 + (ln_ >> 4), x = (ln_ & 15) ^ Rl, rr_ = 2 * Rl + (x >> 3), cc_ = x & 7;              \
            __builtin_amdgcn_global_load_lds((const unsigned*)(sb_ + (unsigned)(rr_ * 128 + cc_ * 16)), (LAS unsigned*)(db + i * 1024), 16, 0, 0); } } while (0)
        IDX_STAGE_DMA(0);
        asm volatile("s_waitcnt vmcnt(0)" ::: "memory"); __syncthreads();
        v32u k0 = {}, k1 = {}, k2 = {}, k3 = {};
#define IDX_MM(ACC, T_) do { ACC = f32x16{}; _Pragma("unroll") for (int ks = 0; ks < 4; ++ks) ACC = __builtin_amdgcn_mfma_f32_32x32x16_bf16(afr[ks], *(const LAS bf16x8*)(kb + ik_off((T_) * 32 + r32, 2 * ks + hi)), ACC, 0, 0, 0); } while (0)
#define IDX_RED(P_, ACC) do { P_ = 0.f; _Pragma("unroll") for (int i = 0; i < 16; ++i) { const float xf_ = ACC[i]; const int xi_ = __float_as_int(xf_); P_ += wv[i] * __int_as_float(xi_ > 0 ? xi_ : 0); } } while (0)
#define IDX_QUARTER(KV, S0) do { const int s_end = (nstage < (S0) + 8) ? nstage : (S0) + 8;                                                               \
        _Pragma("unroll 1") for (int s = (S0); s < s_end; ++s) {                                                                                         \
            LAS unsigned char* kb = kbuf + (s & 1) * 32768;                                                                                              \
            if (s + 1 < nstage) IDX_STAGE_DMA(s + 1);                                           \
                         \
            _Pragma("unroll") for (int c = 0; c < 4; ++c) { const int kb0 = s * 256 + c * 64; f32x16 acc_; float pA, pB;                                   \
                IDX_MM(acc_, 2 * c); IDX_RED(pA, acc_); __builtin_amdgcn_sched_barrier(0);                                                                \
                IDX_MM(acc_, 2 * c + 1); IDX_RED(pB, acc_); __builtin_amdgcn_sched_barrier(0);                                                            \
                auto rr = __builtin_amdgcn_permlane32_swap(__float_as_uint(pA), __float_as_uint(pB), false, false);                                      \
                const float sc = __uint_as_float(rr[0]) + __uint_as_float(rr[1]);                                                                        \
                KV[(s - (S0)) * 4 + c] = (kb0 + lane <= tq) ? mono_key(sc) : 0u; }                                                                      \
            asm volatile("s_waitcnt vmcnt(0)" ::: "memory"); __syncthreads();                  \
        } } while (0)
        if (MODE != 2) { IDX_QUARTER(k0, 0); IDX_QUARTER(k1, 8); IDX_QUARTER(k2, 16); IDX_QUARTER(k3, 24); }
        else { for (int i = 0; i < 32; ++i) { const unsigned hsh = (unsigned)(i * 64 + lane) * 2654435761u; k0[i] = (i * 64 + lane <= tq) ? (hsh | 1u) : 0u; k1[i] = ((32 + i) * 64 + lane <= tq) ? ((hsh * 3u) | 1u) : 0u; k2[i] = ((64 + i) * 64 + lane <= tq) ? ((hsh * 5u) | 1u) : 0u; k3[i] = ((96 + i) * 64 + lane <= tq) ? ((hsh * 7u) | 1u) : 0u; } }
#undef IDX_QUARTER
#undef IDX_MM
#undef IDX_RED
#undef IDX_STAGE_DMA
        if (MODE == 0) dsa_select_regs(k0, k1, k2, k3, lane, tq, F.IDX + row * TOPK, (LAS unsigned*)(F.lds + 65536 + F.wave * 4096));
        if (MODE == 1) { unsigned acc_ = 0; for (int i = 0; i < 32; ++i) acc_ += k0[i] + k1[i] + k2[i] + k3[i]; if (acc_ == 0x12345u) F.SSQ[0] = 1.f; }
        if (MODE == 2) dsa_select_regs(k0, k1, k2, k3, lane, tq, (int*)F.V + row * TOPK, (LAS unsigned*)(F.lds + 65536 + F.wave * 4096));
    }
}
#ifndef DSA_OUT_SCALE
#define DSA_OUT_SCALE 1.0f
#endif
#define DPPF(v, ctrl) __builtin_bit_cast(float, __builtin_amdgcn_update_dpp(0, __builtin_bit_cast(int, (v)), (ctrl), 0xF, 0xF, true))
__device__ __forceinline__ float row16_max(float v) { v = fmaxf(v, DPPF(v, 0xB1)); v = fmaxf(v, DPPF(v, 0x4E)); v = fmaxf(v, DPPF(v, 0x141)); v = fmaxf(v, DPPF(v, 0x140)); return v; }
__device__ __forceinline__ float row16_sum(float v) { v += DPPF(v, 0xB1); v += DPPF(v, 0x4E); v += DPPF(v, 0x141); v += DPPF(v, 0x140); return v; }
__device__ __forceinline__ void dsa_attn_phase(Frame& F) {
    LAS float* pl = (LAS float*)(F.lds + F.wave * 7168);
    LAS int* kidx0 = (LAS int*)(F.lds + F.wave * 7168 + 4096);
    LAS unsigned* zb = (LAS unsigned*)(F.lds + F.wave * 7168 + 6144);
    const int lane = F.lane, m16 = lane & 15, kq = lane >> 4;
    const int lkey = lane >> 2, lch = lane & 3, lsrc = ((m16 << 2) | kq) << 2;
    const int row_first = F.c * NWAVES + F.wave, row_step = F.G * NWAVES;
    if (row_first >= T) return;
    unsigned qmask = (m16 < 4) ? 0xffffffffu : 0u; asm volatile("" : "+v"(qmask));
    v4u gA[16], gB[16]; bf16x8 afr[4];
#define DSA_LOADK(BUF, C_, KI, KB, KO) do { _Pragma("unroll") for (int t4 = 0; t4 < 4; ++t4) { const int kj_ = (KI)[((C_) * 4 + t4) * 16 + lkey]; const unsigned ko_ = (unsigned)(kj_ < 0 ? 0 : kj_) * 1024u + (KO); \
            _Pragma("unroll") for (int ks = 0; ks < 4; ++ks) BUF[t4 * 4 + ks] = *(const v4u*)((KB) + ko_ + ks * 64); } } while (0)
#define DSA_LOADQ(ROW, G_) do { _Pragma("unroll") for (int ks = 0; ks < 4; ++ks) { const bf16x8 t_ = *(const bf16x8*)(F.P + (size_t)(ROW) * NP + PC_DQ + ((G_) * 4 + (m16 & 3)) * 128 + ks * 32 + kq * 8);    \
            v4u u_ = __builtin_bit_cast(v4u, t_); u_.x &= qmask; u_.y &= qmask; u_.z &= qmask; u_.w &= qmask; afr[ks] = __builtin_bit_cast(bf16x8, u_); } } while (0)
#define DSA_LOADV(BUF, B_) do { _Pragma("unroll") for (int q2 = 0; q2 < 16; ++q2) { const int kj_ = kidx[((B_) * 16 + q2) * 4 + kq]; BUF[q2] = *(const v4u*)(dbase + ((unsigned)(kj_ < 0 ? 0 : kj_) * 1024u + voff)); } } while (0)
#define DSA_QK(BUF, C_) do { _Pragma("unroll") for (int t4 = 0; t4 < 4; ++t4) { const int kjm_ = kidx[((C_) * 4 + t4) * 16 + m16]; f32x4 acc = {0.f, 0.f, 0.f, 0.f};                  \
            _Pragma("unroll") for (int ks = 0; ks < 4; ++ks) { v4u w; const v4u r_ = BUF[t4 * 4 + ks];                                                                         \
                w.x = (unsigned)__builtin_amdgcn_ds_bpermute(lsrc, (int)r_.x); w.y = (unsigned)__builtin_amdgcn_ds_bpermute(lsrc, (int)r_.y);                                  \
                w.z = (unsigned)__builtin_amdgcn_ds_bpermute(lsrc, (int)r_.z); w.w = (unsigned)__builtin_amdgcn_ds_bpermute(lsrc, (int)r_.w);                                  \
                acc = __builtin_amdgcn_mfma_f32_16x16x32_bf16(afr[ks], *reinterpret_cast<bf16x8*>(&w), acc, 0, 0, 0); }                                                       \
            _Pragma("unroll") for (int i = 0; i < 4; ++i) sc[(C_) * 4 + t4][i] = (kjm_ >= 0) ? acc[i] * (0.08838834764831845f * 1.4426950408889634f) : -__builtin_inff(); } } while (0)
#define DSA_PV(BUF, B_) do { _Pragma("unroll") for (int q2 = 0; q2 < 16; ++q2) { const f32x4 pp = *(const LAS f32x4*)(pl + (((B_) * 16 + q2) * 4 + kq) * 4); const v4u v = BUF[q2];     \
            const f32x2 vf[4] = {{bflo(v.x), bfhi(v.x)}, {bflo(v.y), bfhi(v.y)}, {bflo(v.z), bfhi(v.z)}, {bflo(v.w), bfhi(v.w)}};                                             \
            _Pragma("unroll") for (int i = 0; i < 4; ++i) _Pragma("unroll") for (int e = 0; e < 4; ++e) o[i][e] += vf[e] * pp[i]; } } while (0)
#define DSA_FENCE() __builtin_amdgcn_sched_barrier(0)
    { int ln_ = lane; asm volatile("" : "+v"(ln_)); const int* ip = F.IDX + (size_t)row_first * TOPK;
#pragma unroll
      for (int j = 0; j < 4; ++j) kidx0[ln_ + 64 * j] = ip[ln_ + 64 * j]; }
    LDS_WAIT(); asm volatile("" ::: "memory");
    { const char* kb_ = (const char*)(F.DKV + (size_t)(row_first >> 13) * SEQ * 512); const unsigned ko0_ = (unsigned)lch * 16u;
      DSA_LOADQ(row_first, 0); DSA_LOADK(gA, 0, kidx0, kb_, ko0_); DSA_FENCE(); DSA_LOADK(gB, 1, kidx0, kb_, ko0_); DSA_FENCE(); }
    int kbuf = 0;
#pragma unroll 1
    for (int row = row_first; row < T; row += row_step) { const int bb = row >> 13, nrow = row + row_step; const bool hasn = nrow < T;
        LAS int* kidx = kidx0 + kbuf * 256; LAS int* kidxn = kidx0 + (kbuf ^ 1) * 256;
#pragma unroll 1
        for (int g = 0; g < 2; ++g) {
            float sc[16][4];
            const char* dbase = (const char*)(F.DKV + (size_t)bb * SEQ * 512);
            const unsigned koff = (unsigned)(g * 256 + lch * 16), voff = (unsigned)(512 + g * 256 + m16 * 16);
            DSA_QK(gA, 0); DSA_FENCE(); DSA_LOADK(gA, 2, kidx, dbase, koff); DSA_FENCE();
            DSA_QK(gB, 1); DSA_FENCE(); DSA_LOADK(gB, 3, kidx, dbase, koff); DSA_FENCE();
            DSA_QK(gA, 2); DSA_FENCE(); DSA_LOADV(gA, 0); DSA_FENCE();
            DSA_QK(gB, 3); DSA_FENCE(); DSA_LOADV(gB, 1); DSA_FENCE();
            const int xrow = (g == 0 || !hasn) ? row : nrow, xg = g ^ 1;
            int smu[4];
#pragma unroll
            for (int i = 0; i < 4; ++i) { float mx = sc[0][i];
#pragma unroll
                for (int tl = 1; tl < 16; ++tl) mx = fmaxf(mx, sc[tl][i]);
                mx = row16_max(mx);
                float sm = 0.f;
#pragma unroll
                for (int tl = 0; tl < 16; ++tl) { const float pe = __builtin_amdgcn_exp2f(sc[tl][i] - mx); sm += pe; if (kq == 0) pl[(tl * 16 + m16) * 4 + i] = pe; }
                sm = row16_sum(sm);
                smu[i] = __builtin_amdgcn_readlane(__builtin_bit_cast(int, sm), 0); }
            LDS_WAIT(); asm volatile("" ::: "memory");
            int nk[4];
            { int ln_ = lane; asm volatile("" : "+v"(ln_)); const int* ip = F.IDX + (size_t)(hasn ? nrow : row) * TOPK;
#pragma unroll
              for (int j = 0; j < 4; ++j) nk[j] = ip[ln_ + 64 * j]; }
            DSA_LOADQ(xrow, xg);
            DSA_FENCE();
            LAS int* kidxx = kidx0 + (((g == 0 || !hasn) ? kbuf : (kbuf ^ 1)) * 256);
            const char* kbx = (const char*)(F.DKV + (size_t)(xrow >> 13) * SEQ * 512); const unsigned kox = (unsigned)(xg * 256 + lch * 16);
            f32x2 o[4][4] = {};
            v4u zq[4];
            { int mo_ = lane; asm volatile("" : "+v"(mo_));
#pragma unroll
              for (int i = 0; i < 4; ++i) zq[i] = *(const v4u*)(F.P + (size_t)row * NP + PC_ZDSA + (g * 4 + i) * 128 + (mo_ & 15) * 8); }
            DSA_FENCE();
            DSA_PV(gA, 0); DSA_FENCE(); DSA_LOADV(gA, 2); DSA_FENCE();
#pragma unroll
            for (int i = 0; i < 4; ++i) *(LAS v4u*)(zb + (i * 16 + m16) * 4) = zq[i];
            DSA_FENCE();
            DSA_PV(gB, 1); DSA_FENCE(); DSA_LOADV(gB, 3); DSA_FENCE();
#pragma unroll
            for (int j = 0; j < 4; ++j) kidxn[lane + 64 * j] = nk[j];
            LDS_WAIT(); asm volatile("" ::: "memory"); DSA_FENCE();
            DSA_PV(gA, 2); DSA_FENCE(); DSA_LOADK(gA, 0, kidxx, kbx, kox); DSA_FENCE();

            DSA_PV(gB, 3); DSA_FENCE(); DSA_LOADK(gB, 1, kidxx, kbx, kox); DSA_FENCE();
#pragma unroll
            for (int i = 0; i < 4; ++i) { const float inv_i = (1.0f / __builtin_bit_cast(float, smu[i])) * DSA_OUT_SCALE;
#pragma unroll
                for (int e = 0; e < 4; ++e) { float x = o[i][e].x, y = o[i][e].y; x += __shfl_xor(x, 16); x += __shfl_xor(x, 32); y += __shfl_xor(y, 16); y += __shfl_xor(y, 32); o[i][e].x = x * inv_i; o[i][e].y = y * inv_i; } }
            if (kq == 0) { int mo_ = m16; asm volatile("" : "+v"(mo_));
#pragma unroll
                for (int i = 0; i < 4; ++i) { const v4u z = *(const LAS v4u*)(zb + (i * 16 + m16) * 4);
                    v4u w; w.x = pk2(o[i][0].x * bflo(z.x), o[i][0].y * bfhi(z.x)); w.y = pk2(o[i][1].x * bflo(z.y), o[i][1].y * bfhi(z.y));
                    w.z = pk2(o[i][2].x * bflo(z.z), o[i][2].y * bfhi(z.z)); w.w = pk2(o[i][3].x * bflo(z.w), o[i][3].y * bfhi(z.w));
                    *(v4u*)(F.Y + (size_t)row * DM + YC_DSA + (g * 4 + i) * 128 + mo_ * 8) = w; } }
            LDS_WAIT(); asm volatile("" ::: "memory");
        }
        kbuf ^= 1;
    }
#undef DSA_LOADK
#undef DSA_LOADQ
#undef DSA_LOADV
#undef DSA_QK
#undef DSA_PV
#undef DSA_FENCE
}

#ifndef CHECK_BUILD
#define CHECK_BUILD 0
#endif
#if CHECK_BUILD
#ifndef CHECK_TOL
#define CHECK_TOL 0.06f
#endif
#ifndef CHECK_IDX_TOL
#define CHECK_IDX_TOL 4
#endif
constexpr int CW_CHK = 8192;
__device__ __forceinline__ float blk_reduce(float v, LAS float* red, int tid, bool domax) {
    for (int o = 32; o >= 1; o >>= 1) { const float t = __shfl_xor(v, o); v = domax ? fmaxf(v, t) : v + t; }
    __syncthreads();
    if ((tid & 63) == 0) red[tid >> 6] = v;
    __syncthreads();
    float r = red[0];
    for (int i = 1; i < 8; ++i) r = domax ? fmaxf(r, red[i]) : r + red[i];
    __syncthreads();
    return r;
}
__device__ __forceinline__ void check_mla_sample(Frame& F, int l, int b, int h, int t, unsigned* ctl) {
    LAS float* L = (LAS float*)F.lds;
    LAS float* nq = L;
    LAS float* q = L + 768;
    LAS float* qk = L + 1024;
    LAS float* wn = L + 1536;
    LAS float* ov = L + 2048;
    LAS float* red = L + 2304;
    LAS float* invf = L + 2320;
    LAS float* sc = L + 4096;
    LAS float* rk = L + 4096 + 8192;
    const int tid = F.tid; const size_t row = (size_t)b * SEQ + t;
    float ss = 0.f; for (int k = tid; k < 768; k += 512) { const float v = bf2f(F.P[row * NP + PC_CQ + k]); ss += v * v; }
    ss = blk_reduce(ss, red, tid, false);
    const float rq = 1.0f / sqrtf(ss / 768.0f + NORM_EPS);
    for (int k = tid; k < 768; k += 512) nq[k] = bf2f(F.P[row * NP + PC_CQ + k]) * rq * F.mla_gq[l * 768 + k];
    __syncthreads();
    if (tid < 192) { float a = 0.f; const float* w = F.mla_wuq + (size_t)l * 768 * 3072 + h * 192 + tid; for (int k = 0; k < 768; ++k) a += nq[k] * w[(size_t)k * 3072]; q[tid] = a; }
    __syncthreads();
    if (tid < 32) { const float inv = (float)pow(10000.0, -(double)(2 * tid) / 64.0); invf[tid] = inv; const float ang = (float)F.pos[row] * inv; const float c = (float)cos((double)ang), s = (float)sin((double)ang);
        const float x1 = q[128 + tid], x2 = q[160 + tid]; q[128 + tid] = x1 * c - x2 * s; q[160 + tid] = x1 * s + x2 * c; }
    __syncthreads();
    { const int c = tid; float a = 0.f; const float* w = F.mla_wukv + (size_t)l * 512 * 4096 + (size_t)c * 4096 + h * 256; for (int d = 0; d < 128; ++d) a += q[d] * w[d]; qk[c] = a * F.mla_gkv[l * 512 + c]; }
    __syncthreads();
    float lmax = -1e30f;
    for (int s = tid; s <= t; s += 512) { const size_t r2 = (size_t)b * SEQ + s; const bf16* kp = F.P + r2 * NP + PC_CKV; float s2 = 0.f, dot = 0.f;
        for (int c = 0; c < 512; ++c) { const float v = bf2f(kp[c]); s2 += v * v; dot += v * qk[c]; }
        const float rr = 1.0f / sqrtf(s2 / 512.0f + NORM_EPS); float val = dot * rr;
        const bf16* rp = F.P + r2 * NP + PC_KROPE;
        for (int j = 0; j < 32; ++j) { const float ang = (float)F.pos[r2] * invf[j]; const float c = cosf(ang), sn = sinf(ang);
            const float x1 = bf2f(rp[2 * j]), x2 = bf2f(rp[2 * j + 1]); val += (x1 * c - x2 * sn) * q[128 + j] + (x1 * sn + x2 * c) * q[160 + j]; }
        val *= 0.07216878364870322f; sc[s] = val; rk[s] = rr; lmax = fmaxf(lmax, val); }
    const float gmax = blk_reduce(lmax, red, tid, true);
    float lsum = 0.f; for (int s = tid; s <= t; s += 512) { const float p = expf(sc[s] - gmax); sc[s] = p; lsum += p; }
    const float gsum = blk_reduce(lsum, red, tid, false);
    { const int c = tid; float a = 0.f; for (int s = 0; s <= t; ++s) a += sc[s] * rk[s] * bf2f(F.P[((size_t)b * SEQ + s) * NP + PC_CKV + c]); wn[c] = a / gsum * F.mla_gkv[l * 512 + c]; }
    __syncthreads();
    if (tid < 128) { float a = 0.f; const float* w = F.mla_wukv + (size_t)l * 512 * 4096 + h * 256 + 128 + tid; for (int c = 0; c < 512; ++c) a += wn[c] * w[(size_t)c * 4096];
        ov[tid] = a * bf2f(F.P[row * NP + PC_ZMLA + h * 128 + tid]); }
    __syncthreads();
    float e = 0.f, mx = 0.f; if (tid < 128) { e = fabsf(ov[tid] - bf2f(F.Y[row * DM + YC_MLA + h * 128 + tid])); mx = fabsf(ov[tid]); }
    e = blk_reduce(e, red, tid, true); mx = blk_reduce(mx, red, tid, true);
    if (tid == 0) atomicMax(ctl + CW_CHK + 0, __float_as_uint(e / (mx + 1e-20f)));
    __syncthreads();
}
__device__ __forceinline__ void check_dsa_sample(Frame& F, int b, int t, unsigned* ctl) {
    LAS float* L = (LAS float*)F.lds;
    LAS float* iq = L;
    LAS float* iw = L + 2048;
    LAS float* red = L + 2112;
    LAS float* qv = L + 2176;
    LAS float* pr = L + 3200;
    LAS int* mine = (LAS int*)(L + 5248);
    LAS float* sc = L + 8192;
    LAS unsigned char* flag = (LAS unsigned char*)(L + 16384);
    const int tid = F.tid; const size_t row = (size_t)b * SEQ + t;
    for (int i = tid; i < 2048; i += 512) iq[i] = bf2f(F.P[row * NP + PC_IQ + i]);
    if (tid < 32) iw[tid] = bf2f(F.P[row * NP + PC_IW + tid]);
    for (int i = tid; i < 1024; i += 512) qv[i] = bf2f(F.P[row * NP + PC_DQ + i]);
    for (int i = tid; i < 8192; i += 512) flag[i] = 0;
    if (tid < 256) mine[tid] = F.IDX[row * TOPK + tid];
    __syncthreads();
    for (int s = tid; s <= t; s += 512) { const bf16* kp = F.P + ((size_t)b * SEQ + s) * NP + PC_IK; float tot = 0.f;
#pragma unroll 1
        for (int hh = 0; hh < 32; ++hh) { float a = 0.f;
#pragma unroll 1
            for (int d = 0; d < 64; d += 2) { const unsigned w = *(const unsigned*)(kp + d); a += iq[hh * 64 + d] * bflo(w) + iq[hh * 64 + d + 1] * bfhi(w); }
            tot += iw[hh] * fmaxf(a, 0.f); }
        sc[s] = tot; }
    __syncthreads();
    for (int s = tid; s <= t; s += 512) { const float v = sc[s]; int cnt = 0; for (int s2 = 0; s2 <= t; ++s2) { const float w = sc[s2]; cnt += (w > v || (w == v && s2 < s)) ? 1 : 0; } if (cnt < TOPK) flag[s] |= 1; }
    __syncthreads();
    if (tid < 256 && mine[tid] >= 0) flag[mine[tid]] |= 2;
    __syncthreads();
    float mm = 0.f; for (int s = tid; s < 8192; s += 512) mm += (flag[s] == 1 || flag[s] == 2) ? 1.f : 0.f;
    mm = blk_reduce(mm, red, tid, false);
    if (tid == 0) atomicMax(ctl + CW_CHK + 1, (unsigned)(mm * 0.5f + 0.25f));
    if (tid < 256) { const int kj = mine[tid];
        for (int hh = 0; hh < 8; ++hh) { float a = -1e30f;
            if (kj >= 0) { a = 0.f; const bf16* kp = F.DKV + ((size_t)b * SEQ + kj) * 512 + (hh >> 2) * 128; for (int d = 0; d < 128; ++d) a += qv[hh * 128 + d] * bf2f(kp[d]); a *= 0.08838834764831845f; }
            pr[hh * 256 + tid] = a; } }
    __syncthreads();
    { const int hh = tid >> 6, ln = tid & 63; float mx = -1e30f; for (int k = ln; k < 256; k += 64) mx = fmaxf(mx, pr[hh * 256 + k]);
      for (int o = 32; o >= 1; o >>= 1) mx = fmaxf(mx, __shfl_xor(mx, o));
      float sm = 0.f; for (int k = ln; k < 256; k += 64) { const float p = (pr[hh * 256 + k] > -1e29f) ? expf(pr[hh * 256 + k] - mx) : 0.f; pr[hh * 256 + k] = p; sm += p; }
      for (int o = 32; o >= 1; o >>= 1) sm += __shfl_xor(sm, o);
      __syncthreads();
      for (int k = ln; k < 256; k += 64) pr[hh * 256 + k] /= sm; }
    __syncthreads();
    float e = 0.f, mx2 = 0.f;
    for (int o2 = tid; o2 < 1024; o2 += 512) { const int hh = o2 >> 7, d = o2 & 127; float a = 0.f;
        for (int k = 0; k < 256; ++k) { const int kj = mine[k]; if (kj >= 0) a += pr[hh * 256 + k] * bf2f(F.DKV[((size_t)b * SEQ + kj) * 512 + 256 + (hh >> 2) * 128 + d]); }
        a *= bf2f(F.P[row * NP + PC_ZDSA + o2]);
        e = fmaxf(e, fabsf(a - bf2f(F.Y[row * DM + YC_DSA + o2]))); mx2 = fmaxf(mx2, fabsf(a)); }
    e = blk_reduce(e, red, tid, true); mx2 = blk_reduce(mx2, red, tid, true);
    if (tid == 0) atomicMax(ctl + CW_CHK + 2, __float_as_uint(e / (mx2 + 1e-20f)));
    __syncthreads();
}
__device__ __forceinline__ void check_phase(Frame& F, unsigned* ctl) {
    const int ts[16] = {0, 3, 63, 64, 200, 255, 256, 257, 300, 777, 1024, 2500, 4095, 4096, 6001, 8191};
    for (int it = F.c; it < 64; it += F.G) {
        const int k = it & 15, b = (it >> 4) & 1, t = ts[k];
        if (it < 32) check_mla_sample(F, DEPTH - 1, b, (k * 5 + b * 3) & 15, t, ctl);
        else check_dsa_sample(F, b, t, ctl);
    }
}
__device__ __forceinline__ void check_apply(Frame& F, unsigned* ctl) {
    const float e0 = __uint_as_float(__hip_atomic_load(ctl + CW_CHK + 0, __ATOMIC_RELAXED, __HIP_MEMORY_SCOPE_AGENT)), e2 = __uint_as_float(__hip_atomic_load(ctl + CW_CHK + 2, __ATOMIC_RELAXED, __HIP_MEMORY_SCOPE_AGENT));
    const unsigned m1 = __hip_atomic_load(ctl + CW_CHK + 1, __ATOMIC_RELAXED, __HIP_MEMORY_SCOPE_AGENT);
    const int code = (!(e0 <= CHECK_TOL) ? 1 : 0) | (m1 > CHECK_IDX_TOL ? 2 : 0) | (!(e2 <= CHECK_TOL) ? 4 : 0);
    if (code == 0) return;
    const float sc = 1.0f + 0.5f * code;
    for (size_t i = (size_t)F.c * 512 + F.tid; i < (size_t)T * DM; i += (size_t)F.G * 512) F.out[i] *= sc;
}
#endif

__device__ __forceinline__ void mla_attn_phase(Frame& F) {
    char* lds = (char*)F.lds;
    for (int it = F.c; it < 512; it += F.G) { const int bh = it >> 4, y = it & 15, b = bh >> 4, h = bh & 15;
        const bf16* Qh = F.Q + (size_t)bh * SEQ * 192; const bf16* Kh = F.K + (size_t)bh * SEQ * 192; const bf16* Vh = F.V + (size_t)bh * SEQ * 128;
        bf16* Yp = F.Y + (size_t)b * SEQ * DM + YC_MLA + h * 128; const bf16* Zp = F.P + (size_t)b * SEQ * NP + PC_ZMLA + h * 128;
        mla::attn_block(Qh, Kh, Vh, Yp, Zp, (31 - y) * 256, lds);
        mla::attn_block(Qh, Kh, Vh, Yp, Zp, y * 256, lds);
    }
}


#ifndef DUMP_SEL
#define DUMP_SEL -1
#endif
#ifndef DEPTH_RUN
#define DEPTH_RUN DEPTH
#endif
__device__ __forceinline__ void dump_phase(Frame& F) {
    for (size_t i = (size_t)F.c * 512 + F.tid; i < (size_t)T * DM; i += (size_t)F.G * 512) { const size_t row = i >> 12; const int col = (int)(i & 4095); float v = 0.f;
        if (DUMP_SEL == 0) v = bf2f(F.P[row * NP + col]);
        if (DUMP_SEL == 1) v = bf2f(F.P[row * NP + 4096 + col]);
        if (DUMP_SEL == 2) v = col < 3072 ? bf2f(F.P[row * NP + 8192 + col]) : 0.f;
        if (DUMP_SEL == 3) v = bf2f(F.GT[row * NG + col]);
        if (DUMP_SEL == 4) v = bf2f(F.UT[i & (size_t)(32 * 1024 * 1024 - 1)]);
        if (DUMP_SEL == 5) v = bf2f(F.Y[row * DM + col]);
        if (DUMP_SEL == 6) v = bf2f(F.MG[row * DM + col]);
        if (DUMP_SEL == 7) v = bf2f(F.H[row * DM + col]);
        if (DUMP_SEL == 8) v = bf2f(F.W1[i]);
        if (DUMP_SEL == 9) v = (i < (size_t)4 * NG) ? F.MOD[i] : ((i < (size_t)4 * NG + (size_t)T * 20) ? F.SSQ[i - 4 * NG] : 0.f);
        if (DUMP_SEL == 10) v = bf2f(F.Q[i]);
        if (DUMP_SEL == 11) v = bf2f(F.K[i]);
        if (DUMP_SEL == 12) v = bf2f(F.V[i & (size_t)(32 * 1024 * 1024 - 1)]);
        if (DUMP_SEL == 14) v = bf2f(F.W1[(size_t)NP * DM + (i % ((size_t)NG * DM))]);
        if (DUMP_SEL == 13) v = (i < (size_t)T * TOPK) ? (float)F.IDX[i] : 0.f;
        F.out[i] = v; }
}
#ifndef G1_SPLIT
#define G1_SPLIT 0
#endif
#ifndef G_AS_P
#define G_AS_P 0
#endif
#ifndef G_ALIGN
#define G_ALIGN true
#endif
#ifndef G_SP2
#define G_SP2 true
#endif
#ifndef PHASE_MASK
#define PHASE_MASK 0xFFFF
#endif
#define PM(b) (((PHASE_MASK) >> (b)) & 1)
#ifndef EXTRA_INDEX
#define EXTRA_INDEX 0
#endif
#ifndef REPEAT_MASK
#define REPEAT_MASK 0
#endif
#define RP(b) _Pragma("unroll 1") for (int rep_ = 0; rep_ < 1 + (((REPEAT_MASK) >> (b)) & 1); ++rep_)
constexpr int NPHASE = 16;
__global__ void __launch_bounds__(NWAVES * 64, 2) fwd_kernel(Args args) {
    extern __shared__ __attribute__((aligned(16))) unsigned char lds[];
    Frame F;
#define REFRESH() frame_init(F, (LAS unsigned char*)lds)
    REFRESH();
    unsigned char* ws = args.ws;
    volatile LAS unsigned* MISC = (volatile LAS unsigned*)(F.lds + MISC_OFF);
    for (int u = F.tid; u < 64; u += NWAVES * 64) MISC[u] = 0u;
    __syncthreads();
    const bool single = (args.ph_hi - args.ph_lo) > 1;
    XcdBarrier bar; bar.bar = (unsigned*)(ws + WS_CTL) + CW_BAR; bar.x = 0; bar.st = nullptr;
    if (single) bar = xcd_barrier_post((unsigned*)(ws + WS_CTL) + CW_BAR, MISC + 8);
    const int lo = args.ph_lo, hi = args.ph_hi;
#define IN(k) (lo <= (k) && (k) < hi)
#ifndef SEAM_REPS
#define SEAM_REPS 1
#endif
#define SEAM(k) do { if (IN(k) && IN((k) + 1)) { for (int sr_ = 0; sr_ < SEAM_REPS; ++sr_) xcd_barrier(bar); } } while (0)

    if (IN(0) && PM(0)) RP(0) { REFRESH(); weights_phase(F, 0); mod_phase(F); rope_phase(F); }
    SEAM(0);
#pragma unroll 1
    for (int l = 0; l < DEPTH_RUN; ++l) {
        const int pb = 1 + 7 * l;
                if (IN(pb) && PM(1)) RP(1) { REFRESH(); if (l > 0) weights_phase(F, l); norm_phase(F, (l == 0) ? F.x : F.out, l); }
        SEAM(pb);
        if (IN(pb + 1) && PM(2)) RP(2) { REFRESH();
            { pg8::Gemm g{F.H, F.W1, T, NP, DM, DM, DM}; pg8::StaticOrder S; S.init(T, NP, F.G, F.c);
              pg8::EpiG1 E{F.P, F.GT, F.b_mg + (size_t)l * NG, F.SSQ, 0, 1.0f, F.DKV, F.IKC};
              pg8::gemm_phase<pg8::EpiG1, pg8::StaticOrder, G_ALIGN, G_SP2>(F.lds + RING_OFF, g, S, E); }
            REFRESH();
            { pg8::Gemm g{(const bf16*)F.H8, (const bf16*)F.WG8, T, NG, DM / 2, DM / 2, DM / 2}; pg8::StaticOrder S; S.init(T, NG, F.G, F.c);
              pg8::EpiG1 E{F.P, F.GT, F.b_mg + (size_t)l * NG, F.SSQ, 44, 1.0f / 64.0f, F.DKV, F.IKC};
              pg8::gemm_phase<pg8::EpiG1, pg8::StaticOrder, G_ALIGN, G_SP2, true>(F.lds + RING_OFF, g, S, E); }
        }
        SEAM(pb + 1);
        if (IN(pb + 2)) {
            if (PM(3)) RP(3) { REFRESH();
            { pg8::Gemm g{F.P + PC_CQ, F.WUQ, T, NQ, MLA_QR, NP, MLA_QR}; pg8::StaticOrder S; S.init(T, NQ, F.G, F.c);
              pg8::EpiQ E{F.Q, F.SSQ, F.COS, F.SIN, 0.07216878364870322f * 1.4426950408889634f};
              pg8::gemm_phase<pg8::EpiQ, pg8::StaticOrder, G_ALIGN, G_SP2>(F.lds + RING_OFF, g, S, E); }
            REFRESH();
            { pg8::Gemm g{F.P + PC_CKV, F.WUKV, T, NKV, MLA_KVR, NP, MLA_KVR}; pg8::StaticOrder S; S.init(T, NKV, F.G, F.c);
              pg8::EpiKV E{F.K, F.V, F.SSQ};
              pg8::gemm_phase<pg8::EpiKV, pg8::StaticOrder, G_ALIGN, G_SP2>(F.lds + RING_OFF, g, S, E); }
            REFRESH(); krope_phase(F); }
            if (PM(4)) RP(4) { REFRESH(); gla1_phase(F, l); }

        }
        SEAM(pb + 2);
        if (IN(pb + 3)) { if (PM(5)) RP(5) { REFRESH(); dsa_index_phase<0>(F); } if (PM(6)) { REFRESH(); gla2_phase(F); } }
        SEAM(pb + 3);
        if (IN(pb + 4)) { if (PM(7)) RP(7) { REFRESH(); mla_attn_phase(F); } if (PM(8)) RP(8) { REFRESH(); dsa_attn_phase(F); } __syncthreads(); if (PM(9)) RP(9) { __syncthreads(); REFRESH(); gla3_phase(F, l); } }
        SEAM(pb + 4);
        #if EXTRA_INDEX
        if (IN(pb + 5)) { REFRESH(); dsa_index_phase<EXTRA_INDEX - 1>(F); }
#endif
        if (IN(pb + 5) && PM(10)) RP(10) {
            REFRESH();
            { pg8::Gemm g{F.Y, F.WBM, T, DM, DM, DM, DM}; pg8::StaticOrder S; S.init(T, DM, F.G, F.c);
              pg8::EpiMergeCat E{F.MG, F.GT}; pg8::gemm_phase<pg8::EpiMergeCat, pg8::StaticOrder, G_ALIGN, G_SP2>(F.lds + RING_OFF, g, S, E); }
        }
        SEAM(pb + 5);
        if (IN(pb + 6) && PM(11)) for (int rep_ = 0; rep_ < 1 + ((l == 0) ? (((REPEAT_MASK) >> 11) & 1) : 0); ++rep_) { REFRESH();
            pg8::Gemm g{F.MG, F.WO, T, DM, DM, DM, DM}; pg8::StaticOrder S; S.init(T, DM, F.G, F.c);
            pg8::EpiOut E{(l == 0) ? F.x : F.out, F.out, F.MOD + (size_t)l * 2 * NG + 2 * DM};
            pg8::gemm_phase<pg8::EpiOut, pg8::StaticOrder, G_ALIGN, G_SP2>(F.lds + RING_OFF, g, S, E);
        }
        SEAM(pb + 6);
    }
    if (IN(15) && PM(12)) { REFRESH(); final_phase(F); }
    if (DUMP_SEL >= 0) { SEAM(15); if (IN(16)) { REFRESH(); dump_phase(F); } }
#if CHECK_BUILD
    SEAM(15); if (IN(16)) { REFRESH(); check_phase(F, (unsigned*)(ws + WS_CTL)); }
    SEAM(16); if (IN(17)) { REFRESH(); check_apply(F, (unsigned*)(ws + WS_CTL)); }
#endif
#undef IN
#undef SEAM
}

extern "C" void kernel_launch(void* const* d_in, const int* in_sizes, int n_in, void* d_out, int out_size, void* d_ws, size_t ws_size, hipStream_t stream) {
    static int grid = 0;
    if (grid == 0) {
        if (n_in != 21 || out_size != T * DM || ws_size < WS_END) { fprintf(stderr, "kernel_launch: unexpected shapes (n_in %d out %d ws %zu need %zu)\n", n_in, out_size, ws_size, (size_t)WS_END); grid = -1; return; }
        int dev = 0, cus = 0, per_cu = 0;
        if (hipGetDevice(&dev) != hipSuccess || hipDeviceGetAttribute(&cus, hipDeviceAttributeMultiprocessorCount, dev) != hipSuccess) { grid = -1; return; }
        if (hipFuncSetAttribute((const void*)fwd_kernel, hipFuncAttributeMaxDynamicSharedMemorySize, LDS_BYTES) != hipSuccess) { fprintf(stderr, "kernel_launch: hipFuncSetAttribute failed\n"); grid = -1; return; }
        if (hipOccupancyMaxActiveBlocksPerMultiprocessor(&per_cu, (const void*)fwd_kernel, NWAVES * 64, LDS_BYTES) != hipSuccess || per_cu < 1) { fprintf(stderr, "kernel_launch: occupancy query says %d\n", per_cu); }
        (void)hipGetLastError();
        grid = cus > 256 ? 256 : cus;
    }
    if (grid < 0) return;
    (void)hipMemsetAsync((char*)d_ws + WS_CTL, 0, CTL_ZERO_BYTES, stream);
    Args a{};
    for (int i = 0; i < 21; ++i) a.in[i] = d_in[i];
    a.out = (float*)d_out; a.ws = (unsigned char*)d_ws;
#if MK_PER_PHASE
    for (int p = 0; p < NPHASE + (DUMP_SEL >= 0 ? 1 : 0) + (CHECK_BUILD ? 2 : 0); ++p) { a.ph_lo = p; a.ph_hi = p + 1; hipLaunchKernelGGL(fwd_kernel, dim3(grid), dim3(NWAVES * 64), LDS_BYTES, stream, a); }
#else
    a.ph_lo = 0; a.ph_hi = NPHASE + (DUMP_SEL >= 0 ? 1 : 0) + (CHECK_BUILD ? 2 : 0);
    hipLaunchKernelGGL(fwd_kernel, dim3(grid), dim3(NWAVES * 64), LDS_BYTES, stream, a);
#endif
}
```

```cpp
#include <hip/hip_runtime.h>
#include <cstdio>
#include <cstdint>
#ifndef MK_PER_PHASE
#define MK_PER_PHASE 0
#endif
#ifndef OUT_SCALE_V
#define OUT_SCALE_V 1.0f
#endif
constexpr float OUT_SCALE = OUT_SCALE_V;

constexpr int DM = 4096, NBATCH = 2, SEQ = 8192, T = NBATCH * SEQ, DEPTH = 2;
constexpr int MLA_H = 16, MLA_QR = 768, MLA_KVR = 512, MLA_NOPE = 128, MLA_ROPE = 64, MLA_DV = 128, MLA_DQK = 192;
constexpr int GLA_H = 4, GLA_DK = 128, GLA_DV = 256, GLA_R = 16, GLA_C = 64, GLA_NCH = SEQ / GLA_C;
constexpr int DSA_H = 8, DSA_KVH = 2, DSA_DH = 128, IDX_H = 32, IDX_DH = 64, TOPK = 256;
constexpr int IN_W = 11184;
constexpr float NORM_EPS = 1e-6f;
constexpr int SC_CQ = 0, SC_CKV = 768, SC_KROPE = 1280, SC_GQ = 1344, SC_GK = 1856, SC_GV = 2368, SC_GLOW = 3392, SC_DQ = 3408, SC_DK = 4432, SC_DV = 4688,
              SC_IQ = 4944, SC_IK = 6992, SC_IW = 7056, SC_ZMLA = 7088, SC_ZGLA = 9136, SC_ZDSA = 10160;
static_assert(SC_ZDSA + 1024 == IN_W, "splits");
constexpr int NP = 11264;
constexpr int PC_CQ = 0, PC_CKV = 768, PC_KROPE = 1280, PC_IK = 1344, PC_IW = 1408, PC_GLOW = 1440, PC_GQ = 1536, PC_GK = 2048, PC_GV = 2560, PC_DQ = 3584, PC_DK = 4608,
              PC_DV = 4864, PC_IQ = 5120, PC_ZMLA = 7168, PC_ZGLA = 9216, PC_ZDSA = 10240;
constexpr int NG = 3 * DM;
constexpr int N1 = NP + NG;
constexpr int NQ = MLA_H * MLA_DQK;
constexpr int NKV = MLA_H * (MLA_NOPE + MLA_DV);
constexpr int YC_MLA = 0, YC_GLA = 2048, YC_DSA = 3072;

constexpr size_t MiB = 1u << 20;
constexpr size_t WS_CTL = 0, CTL_ZERO_BYTES = 1 * MiB;
constexpr size_t WS_MOD = 1 * MiB;
constexpr size_t WS_COS = WS_MOD + 256 * 1024;
constexpr size_t WS_SIN = WS_COS + 2 * MiB;
constexpr size_t WS_SSQ = WS_SIN + 2 * MiB;
constexpr size_t WS_DEC = WS_SSQ + 2 * MiB;
constexpr size_t WS_W = 16 * MiB;
constexpr size_t WO_W1 = 0;
constexpr size_t WO_WG8 = WO_W1 + (size_t)NP * DM * 2;
constexpr size_t WO_WUQ = WO_WG8 + (size_t)NG * DM;
constexpr size_t WO_WUKV = WO_WUQ + (size_t)NQ * MLA_QR * 2;
constexpr size_t WO_WBM = WO_WUKV + (size_t)NKV * MLA_KVR * 2;
constexpr size_t WO_WBG = WO_WBM + (size_t)DM * 2048 * 2;
constexpr size_t WO_WBD = WO_WBG + (size_t)DM * 1024 * 2;
constexpr size_t WO_WO = WO_WBD + (size_t)DM * 1024 * 2;
constexpr size_t W_BYTES = WO_WO + (size_t)DM * DM * 2;
constexpr size_t WS_H = WS_W + ((W_BYTES + MiB - 1) / MiB) * MiB;
constexpr size_t WS_UT = WS_H;
constexpr size_t WS_IDX = WS_H + 64 * MiB;
constexpr size_t WS_P = WS_H + (size_t)T * DM * 2;
constexpr size_t WS_G = WS_P + (size_t)T * NP * 2;
constexpr size_t WS_Q = WS_G + (size_t)T * NG * 2;
constexpr size_t WS_K = WS_Q + (size_t)T * NQ * 2;
constexpr size_t WS_V = WS_K + (size_t)T * NQ * 2;
constexpr size_t WS_MG = WS_Q;
constexpr size_t WS_Y = WS_V + (size_t)T * 2048 * 2;
constexpr size_t WS_H8 = WS_Y;
constexpr size_t WS_DKV = WS_Y + (size_t)T * DM * 2;
constexpr size_t WS_IKC = WS_DKV + (size_t)T * 512 * 2;
constexpr size_t WS_BCG = WS_IKC + (size_t)T * 64 * 2;
constexpr size_t WS_END = WS_BCG + 32 * MiB;
static_assert(WS_END <= 1536ull * MiB, "workspace map must stay below the guaranteed size (4 x the largest tensor)");

constexpr int CW_BAR = 4096;

constexpr int RING_OFF = 0, RING_BYTES = 131072;
constexpr int KBUF_OFF = 131072;
constexpr int MISC_OFF = 147456;
constexpr int LDS_BYTES = 148480;
constexpr int NWAVES = 8;

#define GAS __attribute__((address_space(1)))
#define LAS __attribute__((address_space(3)))
typedef unsigned short bf16;
typedef unsigned v4u __attribute__((ext_vector_type(4)));
typedef unsigned v2u __attribute__((ext_vector_type(2)));
typedef float f32x4 __attribute__((ext_vector_type(4)));
typedef float f32x2 __attribute__((ext_vector_type(2)));
typedef float f32x16 __attribute__((ext_vector_type(16)));
typedef short bf16x8 __attribute__((ext_vector_type(8)));
typedef short s16x4 __attribute__((ext_vector_type(4)));
#define LDS_WAIT() asm volatile("s_waitcnt lgkmcnt(0)" ::: "memory")
#define VM_WAIT() asm volatile("s_waitcnt vmcnt(0)" ::: "memory")
__device__ __forceinline__ unsigned f2bf(float f) { unsigned u = __builtin_bit_cast(unsigned, f); return (u + 0x7fffu + ((u >> 16) & 1u)) >> 16; }
__device__ __forceinline__ unsigned pk2(float lo, float hi) { return f2bf(lo) | (f2bf(hi) << 16); }
__device__ __forceinline__ float bf2f(unsigned b) { return __builtin_bit_cast(float, b << 16); }
__device__ __forceinline__ float bflo(unsigned w) { return __builtin_bit_cast(float, w << 16); }
__device__ __forceinline__ float bfhi(unsigned w) { return __builtin_bit_cast(float, w & 0xffff0000u); }
__device__ __forceinline__ unsigned cvtpk(float lo, float hi) { unsigned r; asm volatile("v_cvt_pk_bf16_f32 %0, %1, %2" : "=v"(r) : "v"(lo), "v"(hi)); return r; }
__device__ __forceinline__ float fast_exp(float x) { return __builtin_amdgcn_exp2f(x * 1.4426950408889634f); }
__device__ __forceinline__ float sigmoidf_(float x) { return __builtin_amdgcn_rcpf(1.0f + fast_exp(-x)); }
__device__ __forceinline__ float siluf_(float x) { return x * sigmoidf_(x); }
__device__ __forceinline__ float wave_sum(float v) {
#pragma unroll
    for (int o = 1; o < 64; o <<= 1) v += __shfl_xor(v, o);
    return v;
}
__device__ __forceinline__ float wave_sum_dpp(float v) {
    v += __builtin_bit_cast(float, __builtin_amdgcn_update_dpp(0, __builtin_bit_cast(int, v), 0xB1, 0xF, 0xF, true));
    v += __builtin_bit_cast(float, __builtin_amdgcn_update_dpp(0, __builtin_bit_cast(int, v), 0x4E, 0xF, 0xF, true));
    v += __builtin_bit_cast(float, __builtin_amdgcn_update_dpp(0, __builtin_bit_cast(int, v), 0x141, 0xF, 0xF, true));
    v += __builtin_bit_cast(float, __builtin_amdgcn_update_dpp(0, __builtin_bit_cast(int, v), 0x140, 0xF, 0xF, true));
    const int vi = __builtin_bit_cast(int, v);
    return (__builtin_bit_cast(float, __builtin_amdgcn_readlane(vi, 0)) + __builtin_bit_cast(float, __builtin_amdgcn_readlane(vi, 16))) +
           (__builtin_bit_cast(float, __builtin_amdgcn_readlane(vi, 32)) + __builtin_bit_cast(float, __builtin_amdgcn_readlane(vi, 48)));
}
__device__ __forceinline__ int lane_now() { int l_; asm volatile("v_mbcnt_lo_u32_b32 %0, -1, 0\n\tv_mbcnt_hi_u32_b32 %0, -1, %0" : "=v"(l_)); return l_; }
__device__ __forceinline__ int crow(int r, int hi) { return (r & 3) + 8 * (r >> 2) + 4 * hi; }

namespace pg8 {
#define PG8_LAS __attribute__((address_space(3)))
typedef unsigned short bf16_t;
typedef short bf16x8 __attribute__((ext_vector_type(8)));
typedef float f32x4 __attribute__((ext_vector_type(4)));
typedef unsigned u32x4 __attribute__((ext_vector_type(4)));
constexpr int BM = 256, BK = 64, HALF = 128, HTB = HALF * BK * 2  , STAGE_BYTES = 8 * HTB, NXCD = 8, WGM = 8;

__host__ __device__ __forceinline__ int lds_byte(int r, int c) { const int st = (r >> 4) * 2 + (c >> 5), rr = r & 15, cc = c & 31, ob = rr * 64 + cc * 2; return st * 1024 + (ob ^ (((ob >> 9) & 1) << 5)); }
__host__ __device__ __forceinline__ void stage_rc(int b, int& R, int& C) { const int st = b / 1024, sb = b % 1024, swz = sb ^ (((sb >> 9) & 1) << 5); R = (st >> 1) * 16 + swz / 64; C = (st & 1) * 32 + (swz % 64) / 2; }
__host__ __device__ __forceinline__ int perm32(int rho) { const int n = rho >> 4, i = rho & 15; return 8 * (i >> 2) + 4 * n + (i & 3); }

struct Unit { int pm, pn; };
struct Gemm { const bf16_t* A; const bf16_t* Bt; int M, N, K, lda, ldb; };

struct StaticOrder {
    int nM, nN, nwg, G, c;
    __host__ __device__ void init(int M, int N, int G_, int c_) { nM = M / BM; nN = N / BM; nwg = nM * nN; G = G_; c = c_; }
    __host__ __device__ bool next(int i, Unit& u) const {
        const long L = (long)i * G + c; if (L >= nwg) return false;
        int wgid = (int)L; { const int q = nwg / NXCD, r = nwg % NXCD, xcd = wgid % NXCD, off = wgid / NXCD; wgid = (xcd < r ? xcd * (q + 1) : r * (q + 1) + (xcd - r) * q) + off; }
        const int nig = WGM * nN, gid = wgid / nig, fm = gid * WGM, gsz = (nM - fm) < WGM ? (nM - fm) : WGM;
        u.pm = fm + ((wgid % nig) % gsz); u.pn = (wgid % nig) / gsz; return true;
    }
    __device__ __forceinline__ void a_ready(const Unit&) const {}
    __device__ __forceinline__ void done(const Unit&) const {}
};

__device__ __forceinline__ unsigned cvt_pk_bf16(float lo, float hi) { unsigned r; asm volatile("v_cvt_pk_bf16_f32 %0, %1, %2" : "=v"(r) : "v"(lo), "v"(hi)); return r; }
__device__ __forceinline__ float fexp(float x) { return __builtin_amdgcn_exp2f(x * 1.4426950408889634f); }
__device__ __forceinline__ float fsig(float x) { return __builtin_amdgcn_rcpf(1.0f + fexp(-x)); }
__device__ __forceinline__ float blo(unsigned w) { return __builtin_bit_cast(float, w << 16); }
__device__ __forceinline__ float bhi(unsigned w) { return __builtin_bit_cast(float, w & 0xffff0000u); }
__device__ __forceinline__ u32x4 pack8(const f32x4 v0, const f32x4 v1) { u32x4 w; w.x = cvt_pk_bf16(v0[0], v0[1]); w.y = cvt_pk_bf16(v0[2], v0[3]); w.z = cvt_pk_bf16(v1[0], v1[1]); w.w = cvt_pk_bf16(v1[2], v1[3]); return w; }

#ifndef G_CONST
#define G_CONST 0
#endif
#ifndef NT_STORE
#define NT_STORE 0
#endif
#ifndef NOBIAS
#define NOBIAS 0
#endif
struct EpiG1 {
    static constexpr bool PERM = true, AFTER_DRAIN = false, HAS_MID = false;
    bf16_t* P; bf16_t* G; const float* bmg; float* ssq; int pn0; float gsc; bf16_t* DKV; bf16_t* IKC;
    __device__ __forceinline__ void operator()(const f32x4 (&acc)[2][2][4][2], const Unit& uu, int wr, int wc, int fr, int fq) const {
        const int pn = uu.pn + pn0;
        const int row0 = uu.pm * BM + wr * 64 + fr;
        const bool isG = pn >= 44, stat = pn < 5;
        const int mode = isG ? 2 : (pn >= 28 ? 1 : 0);
        const bool isKV = (pn == 18) || (pn == 19);
        const ptrdiff_t dsel = (isG ? (G - P) : (ptrdiff_t)0) + (isKV ? (DKV - P) : (ptrdiff_t)0);
        bf16_t* base = P + dsel; const int pitch = isG ? 12288 : (isKV ? 512 : 11264);
        const int col0 = (isG ? (pn - 44) : (isKV ? (pn - 18) : pn)) * BM + wc * 32 + 8 * fq;
        const bool isIK = (pn == 5) && (wc >= 2);
#pragma unroll
        for (int ai = 0; ai < 2; ++ai)
#pragma unroll
            for (int m = 0; m < 4; ++m) { const int row = row0 + ai * HALF + m * 16; bf16_t* rowp = base + (size_t)row * pitch + col0; float ss = 0.f;
#pragma unroll
                for (int bj = 0; bj < 2; ++bj) { f32x4 v0 = acc[ai][bj][m][0], v1 = acc[ai][bj][m][1];
                    if (stat) ss += (v0[0] * v0[0] + v0[1] * v0[1]) + (v0[2] * v0[2] + v0[3] * v0[3]) + (v1[0] * v1[0] + v1[1] * v1[1]) + (v1[2] * v1[2] + v1[3] * v1[3]);
                    if (mode == 1) {
#pragma unroll
                        for (int j = 0; j < 4; ++j) { v0[j] = v0[j] * fsig(v0[j]); v1[j] = v1[j] * fsig(v1[j]); } }
                    if (mode == 2) { const f32x4 b0 = *(const f32x4*)(bmg + col0 + bj * HALF), b1 = *(const f32x4*)(bmg + col0 + bj * HALF + 4);
#pragma unroll
                        for (int j = 0; j < 4; ++j) { v0[j] = fsig(v0[j] * gsc + b0[j]); v1[j] = fsig(v1[j] * gsc + b1[j]); } }
                    const u32x4 pk_ = pack8(v0, v1); if (NT_STORE) __builtin_nontemporal_store(pk_, (u32x4*)(rowp + bj * HALF)); else *(u32x4*)(rowp + bj * HALF) = pk_;
                    if (isIK && bj == 0) *(u32x4*)(IKC + (size_t)row * 64 + (wc - 2) * 32 + 8 * fq) = pk_; }
                if (stat) { ss += __shfl_xor(ss, 16); ss += __shfl_xor(ss, 32); if (fq == 0) ssq[(size_t)row * 20 + pn * 4 + wc] = ss; } }
    }
};
struct EpiQ {
    static constexpr bool PERM = true, AFTER_DRAIN = false, HAS_MID = false;
    bf16_t* Q; const float* ssq; const float* cosT; const float* sinT; float qscale;
    __device__ __forceinline__ void operator()(const f32x4 (&acc)[2][2][4][2], const Unit& u, int wr, int wc, int fr, int fq) const {
        const int row0 = u.pm * BM + wr * 64 + fr, col0 = u.pn * BM + wc * 32 + 8 * fq;
#pragma unroll
        for (int ai = 0; ai < 2; ++ai)
#pragma unroll
            for (int m = 0; m < 4; ++m) { const int row = row0 + ai * HALF + m * 16, b = row >> 13, s = row & 8191;
                const f32x4* sp = (const f32x4*)(ssq + (size_t)row * 20); const f32x4 s0 = sp[0], s1 = sp[1], s2 = sp[2];
                const float tot = ((s0[0] + s0[1]) + (s0[2] + s0[3])) + ((s1[0] + s1[1]) + (s1[2] + s1[3])) + ((s2[0] + s2[1]) + (s2[2] + s2[3]));
                const float rq = __builtin_amdgcn_rsqf(tot * (1.0f / 768.0f) + 1e-6f) * qscale;
#pragma unroll
                for (int bj = 0; bj < 2; ++bj) { const int col = col0 + bj * HALF, h = col / 192, d = col - h * 192;
                    f32x4 v0 = acc[ai][bj][m][0] * rq, v1 = acc[ai][bj][m][1] * rq;
                    if (d >= 128) { const int j0 = (d - 128) >> 1; const f32x4 c = *(const f32x4*)(cosT + (size_t)row * 32 + j0), sn = *(const f32x4*)(sinT + (size_t)row * 32 + j0);
                        float x1, x2;
                        x1 = v0[0]; x2 = v0[1]; v0[0] = x1 * c[0] - x2 * sn[0]; v0[1] = x1 * sn[0] + x2 * c[0];
                        x1 = v0[2]; x2 = v0[3]; v0[2] = x1 * c[1] - x2 * sn[1]; v0[3] = x1 * sn[1] + x2 * c[1];
                        x1 = v1[0]; x2 = v1[1]; v1[0] = x1 * c[2] - x2 * sn[2]; v1[1] = x1 * sn[2] + x2 * c[2];
                        x1 = v1[2]; x2 = v1[3]; v1[2] = x1 * c[3] - x2 * sn[3]; v1[3] = x1 * sn[3] + x2 * c[3]; }
                    *(u32x4*)(Q + (((size_t)(b * 16 + h) * 8192 + s) * 192 + d)) = pack8(v0, v1); } }
    }
};
struct EpiKV {
    static constexpr bool PERM = true, AFTER_DRAIN = false, HAS_MID = false;
    bf16_t* Kb; bf16_t* Vb; const float* ssq;
    __device__ __forceinline__ void operator()(const f32x4 (&acc)[2][2][4][2], const Unit& u, int wr, int wc, int fr, int fq) const {
        const int row0 = u.pm * BM + wr * 64 + fr, col0 = u.pn * BM + wc * 32 + 8 * fq;
#pragma unroll
        for (int ai = 0; ai < 2; ++ai)
#pragma unroll
            for (int m = 0; m < 4; ++m) { const int row = row0 + ai * HALF + m * 16, b = row >> 13, s = row & 8191;
                const f32x4* sp = (const f32x4*)(ssq + (size_t)row * 20 + 12); const f32x4 s0 = sp[0], s1 = sp[1];
                const float tot = ((s0[0] + s0[1]) + (s0[2] + s0[3])) + ((s1[0] + s1[1]) + (s1[2] + s1[3]));
                const float rk = __builtin_amdgcn_rsqf(tot * (1.0f / 512.0f) + 1e-6f);
#pragma unroll
                for (int bj = 0; bj < 2; ++bj) { const int col = col0 + bj * HALF;
                    const f32x4 v0 = acc[ai][bj][m][0] * rk, v1 = acc[ai][bj][m][1] * rk;
                    bf16_t* dst;
                    if (col < 2048) { const int h = col >> 7, d = col & 127; dst = Kb + (((size_t)(b * 16 + h) * 8192 + s) * 192 + d); }
                    else { const int c2 = col - 2048, h = c2 >> 7, d = c2 & 127; dst = Vb + (((size_t)(b * 16 + h) * 8192 + s) * 128 + d); }
                    *(u32x4*)dst = pack8(v0, v1); } }
    }
};
template <int STEP> struct EpiMerge {
    static constexpr bool PERM = true, AFTER_DRAIN = false, HAS_MID = false;
    bf16_t* MG; const bf16_t* G;
    __device__ __forceinline__ void operator()(const f32x4 (&acc)[2][2][4][2], const Unit& u, int wr, int wc, int fr, int fq) const {
        const int row0 = u.pm * BM + wr * 64 + fr, col0 = u.pn * BM + wc * 32 + 8 * fq;
#pragma unroll
        for (int ai = 0; ai < 2; ++ai)
#pragma unroll
            for (int m = 0; m < 4; ++m) { const int row = row0 + ai * HALF + m * 16;
#pragma unroll
                for (int bj = 0; bj < 2; ++bj) { const int col = col0 + bj * HALF;
                    const u32x4 gw = *(const u32x4*)(G + (size_t)row * 12288 + STEP * 4096 + col);
                    f32x4 v0 = acc[ai][bj][m][0], v1 = acc[ai][bj][m][1];
                    v0[0] *= blo(gw.x); v0[1] *= bhi(gw.x); v0[2] *= blo(gw.y); v0[3] *= bhi(gw.y); v1[0] *= blo(gw.z); v1[1] *= bhi(gw.z); v1[2] *= blo(gw.w); v1[3] *= bhi(gw.w);
                    bf16_t* dst = MG + (size_t)row * 4096 + col;
                    if (STEP > 0) { const u32x4 pw = *(const u32x4*)dst;
                        v0[0] += blo(pw.x); v0[1] += bhi(pw.x); v0[2] += blo(pw.y); v0[3] += bhi(pw.y); v1[0] += blo(pw.z); v1[1] += bhi(pw.z); v1[2] += blo(pw.w); v1[3] += bhi(pw.w); }
                    *(u32x4*)dst = pack8(v0, v1); } }
    }
};
struct EpiMergeCat {
    static constexpr bool PERM = true, AFTER_DRAIN = false, HAS_MID = true;
    bf16_t* MG; const bf16_t* G;
    __device__ __forceinline__ bool is_mid(int t) const { return t == 32 || t == 48; }
    __device__ __forceinline__ void mid(f32x4 (&acc)[2][2][4][2], const Unit& u, int wr, int wc, int fr, int fq, int t) const {
        int fr_ = fr, fq_ = fq; asm volatile("" : "+v"(fr_), "+v"(fq_));
        const int row0 = u.pm * BM + wr * 64 + fr_, col0 = u.pn * BM + wc * 32 + 8 * fq_, x = (t == 32) ? 0 : 1;
        u32x4 gr[3][2][2];
#define MC_LD(DST, I_) do { const int row_ = row0 + ((I_) >> 2) * HALF + ((I_) & 3) * 16; _Pragma("unroll") for (int bj = 0; bj < 2; ++bj) { const int col_ = col0 + bj * HALF;     \
            DST[bj][0] = *(const u32x4*)(G + (size_t)row_ * 12288 + x * 4096 + col_); DST[bj][1] = *(const u32x4*)(G + (size_t)row_ * 12288 + (x + 1) * 4096 + col_); } } while (0)
        MC_LD(gr[0], 0); MC_LD(gr[1], 1);
#pragma unroll
        for (int i = 0; i < 8; ++i) { const int ai = i >> 2, m = i & 3;
            if (i + 2 < 8) MC_LD(gr[(i + 2) % 3], i + 2);
            asm volatile("" ::: "memory");
#pragma unroll
            for (int bj = 0; bj < 2; ++bj) { const u32x4 gn = gr[i % 3][bj][0], gd = gr[i % 3][bj][1];
                const unsigned nw[4] = {gn.x, gn.y, gn.z, gn.w}, dw[4] = {gd.x, gd.y, gd.z, gd.w};
#pragma unroll
                for (int j = 0; j < 4; ++j) { const float n0 = fmaxf(blo(nw[j]), 1e-20f), n1 = fmaxf(bhi(nw[j]), 1e-20f), d0 = fmaxf(blo(dw[j]), 1e-20f), d1 = fmaxf(bhi(dw[j]), 1e-20f);
                    f32x4& a = acc[ai][bj][m][j >> 1]; a[(j & 1) * 2] *= n0 * __builtin_amdgcn_rcpf(d0); a[(j & 1) * 2 + 1] *= n1 * __builtin_amdgcn_rcpf(d1); } } }
#undef MC_LD
    }
    __device__ __forceinline__ void operator()(const f32x4 (&acc)[2][2][4][2], const Unit& u, int wr, int wc, int fr, int fq) const {
        const int row0 = u.pm * BM + wr * 64 + fr, col0 = u.pn * BM + wc * 32 + 8 * fq;
#pragma unroll
        for (int ai = 0; ai < 2; ++ai) { u32x4 gq[4][2];
#pragma unroll
            for (int m = 0; m < 4; ++m)
#pragma unroll
                for (int bj = 0; bj < 2; ++bj) gq[m][bj] = *(const u32x4*)(G + (size_t)(row0 + ai * HALF + m * 16) * 12288 + 2 * 4096 + col0 + bj * HALF);
#pragma unroll
            for (int m = 0; m < 4; ++m) { const int row = row0 + ai * HALF + m * 16;
#pragma unroll
                for (int bj = 0; bj < 2; ++bj) { const int col = col0 + bj * HALF;
                    const u32x4 gw = gq[m][bj];
                    f32x4 v0 = acc[ai][bj][m][0], v1 = acc[ai][bj][m][1];
                    v0[0] *= fmaxf(blo(gw.x), 1e-20f); v0[1] *= fmaxf(bhi(gw.x), 1e-20f); v0[2] *= fmaxf(blo(gw.y), 1e-20f); v0[3] *= fmaxf(bhi(gw.y), 1e-20f);
                    v1[0] *= fmaxf(blo(gw.z), 1e-20f); v1[1] *= fmaxf(bhi(gw.z), 1e-20f); v1[2] *= fmaxf(blo(gw.w), 1e-20f); v1[3] *= fmaxf(bhi(gw.w), 1e-20f);
                    *(u32x4*)(MG + (size_t)row * 4096 + col) = pack8(v0, v1); } } }
    }
};
struct EpiOut {
    static constexpr bool PERM = false, AFTER_DRAIN = false, HAS_MID = false;
    const float* xin; float* out; const float* gate;
    __device__ __forceinline__ void operator()(const f32x4 (&acc)[2][2][4][2], const Unit& u, int wr, int wc, int fr, int fq) const {
        const int row0 = u.pm * BM + wr * 64 + fr, col0 = u.pn * BM + wc * 32 + 4 * fq;
        const int b = (u.pm * BM) >> 13;
        f32x4 gv[2][2];
#pragma unroll
        for (int bj = 0; bj < 2; ++bj)
#pragma unroll
            for (int n = 0; n < 2; ++n) gv[bj][n] = *(const f32x4*)(gate + (size_t)b * 12288 + col0 + bj * HALF + n * 16);
#pragma unroll
        for (int ai = 0; ai < 2; ++ai) { f32x4 xv[4][2][2];
#pragma unroll
            for (int m = 0; m < 4; ++m) { const int row = row0 + ai * HALF + m * 16;
#pragma unroll
                for (int bj = 0; bj < 2; ++bj)
#pragma unroll
                    for (int n = 0; n < 2; ++n) xv[m][bj][n] = *(const f32x4*)(xin + (size_t)row * 4096 + col0 + bj * HALF + n * 16); }
#pragma unroll
            for (int m = 0; m < 4; ++m) { const int row = row0 + ai * HALF + m * 16;
#pragma unroll
                for (int bj = 0; bj < 2; ++bj)
#pragma unroll
                    for (int n = 0; n < 2; ++n) *(f32x4*)(out + (size_t)row * 4096 + col0 + bj * HALF + n * 16) = xv[m][bj][n] + gv[bj][n] * acc[ai][bj][m][n]; } }
    }
};


typedef int v8i_t __attribute__((ext_vector_type(8)));
__device__ __forceinline__ v8i_t cat16(const bf16x8 lo, const bf16x8 hi) { v8i_t r; bf16x8* p = reinterpret_cast<bf16x8*>(&r); p[0] = lo; p[1] = hi; return r; }
template <class Epi, class Sched, bool ALIGN_EPI = false, bool SP2 = false, bool FP8 = false>
__device__ __forceinline__ void gemm_phase(PG8_LAS unsigned char* lds, const Gemm g, const Sched& S, const Epi& E, int wv_) {
    int tid_ = wv_ * 64 + lane_now(); asm volatile("" : "+v"(tid_));
    const int tid = tid_, wid = __builtin_amdgcn_readfirstlane(tid >> 6), lane = tid & 63, wr = wid >> 2, wc = wid & 3, fr = lane & 15, fq = lane >> 4;
    const int K = g.K, nt = K / BK;
    unsigned voffA[2], voffB[2];
#pragma unroll
    for (int i = 0; i < 2; ++i) { int R, C; stage_rc(tid * 16 + i * 8192, R, C); const int Rb = Epi::PERM ? ((R & ~31) + perm32(R & 31)) : R;
        voffA[i] = (unsigned)(R * g.lda + C) * 2u; voffB[i] = (unsigned)(Rb * g.ldb + C) * 2u; }
    const size_t kstep = (size_t)(BK * 2);
    const size_t hstepA = (size_t)HALF * g.lda * 2, hstepB = (size_t)HALF * g.ldb * 2;
    const size_t tstepA = 2 * hstepA, tstepB = 2 * hstepB;
    const unsigned ldsw = (unsigned)wid * 1024u;
    const int aoff = lds_byte(wr * 64 + fr, fq * 8), boff = lds_byte(wc * 32 + fr, fq * 8);
#define PG8_SA(b, h) (((b) * 2 + (h)) * HTB)
#define PG8_SB(b, h) ((4 + (b) * 2 + (h)) * HTB)
#define PG8_STAGE(bufoff, gbase, voff) do { _Pragma("unroll") for (int _i = 0; _i < 2; ++_i) \
        __builtin_amdgcn_global_load_lds((const unsigned*)((const char*)(gbase) + (voff)[_i]), (PG8_LAS unsigned*)(lds + (bufoff) + ldsw + _i * 8192), 16, 0, 0); } while (0)
#define PG8_LDA(dst, b, h) do { _Pragma("unroll") for (int m = 0; m < 4; ++m) _Pragma("unroll") for (int k = 0; k < 2; ++k) dst[m][k] = *(const PG8_LAS bf16x8*)(lds + PG8_SA(b, h) + aoff + m * 2048 + k * 1024); } while (0)
#define PG8_LDB(dst, b, h) do { _Pragma("unroll") for (int n = 0; n < 2; ++n) _Pragma("unroll") for (int k = 0; k < 2; ++k) dst[n][k] = *(const PG8_LAS bf16x8*)(lds + PG8_SB(b, h) + boff + n * 2048 + k * 1024); } while (0)
#define PG8_MMA(ai, bj, At, Bt) do { __builtin_amdgcn_s_setprio(1); \
        if constexpr (FP8) { _Pragma("unroll") for (int m = 0; m < 4; ++m) _Pragma("unroll") for (int n = 0; n < 2; ++n) \
            asm volatile("v_mfma_scale_f32_16x16x128_f8f6f4 %0, %1, %2, %0, %3, %3 op_sel_hi:[0,0,0]" : "+v"(acc[ai][bj][m][n]) : "v"(cat16(Bt[n][0], Bt[n][1])), "v"(cat16(At[m][0], At[m][1])), "v"(0x7F7F7F7F)); } \
        else { _Pragma("unroll") for (int m = 0; m < 4; ++m) _Pragma("unroll") for (int n = 0; n < 2; ++n) _Pragma("unroll") for (int k = 0; k < 2; ++k) \
            acc[ai][bj][m][n] = __builtin_amdgcn_mfma_f32_16x16x32_bf16(Bt[n][k], At[m][k], acc[ai][bj][m][n], 0, 0, 0); } \
        __builtin_amdgcn_s_setprio(0); } while (0)
#define PG8_WAIT_V(n) asm volatile("s_waitcnt vmcnt(" #n ")" ::: "memory")
#define PG8_WAIT_L(n) asm volatile("s_waitcnt lgkmcnt(" #n ")" ::: "memory")
#define PG8_BAR __builtin_amdgcn_s_barrier()
#define PG8_SCHED __builtin_amdgcn_sched_barrier(0)
    Unit cur, nxt; int ui = 0;
    if (!S.next(0, cur)) return;
    f32x4 acc[2][2][4][2];
#pragma unroll
    for (int a = 0; a < 2; ++a)
#pragma unroll
        for (int b = 0; b < 2; ++b)
#pragma unroll
            for (int m = 0; m < 4; ++m)
#pragma unroll
                for (int n = 0; n < 2; ++n) acc[a][b][m][n] = (f32x4){0.f, 0.f, 0.f, 0.f};
    bf16x8 At[4][2], B0[2][2], B1[2][2];
    const char* cA = (const char*)g.A + (size_t)cur.pm * tstepA; const char* cB = (const char*)g.Bt + (size_t)cur.pn * tstepB;
    S.a_ready(cur);
    if constexpr (SP2) {
        PG8_STAGE(PG8_SB(0, 0), cB, voffB); PG8_STAGE(PG8_SB(0, 1), cB + hstepB, voffB); PG8_STAGE(PG8_SA(0, 0), cA, voffA); PG8_STAGE(PG8_SA(0, 1), cA + hstepA, voffA);
        if (wr == 1) PG8_BAR;
        PG8_WAIT_V(2); PG8_BAR;
        PG8_STAGE(PG8_SB(1, 0), cB + kstep, voffB); PG8_STAGE(PG8_SA(1, 0), cA + kstep, voffA); PG8_STAGE(PG8_SB(1, 1), cB + hstepB + kstep, voffB);
        PG8_WAIT_V(6); PG8_BAR;
    } else {
        PG8_STAGE(PG8_SB(0, 0), cB, voffB); PG8_STAGE(PG8_SA(0, 0), cA, voffA); PG8_STAGE(PG8_SB(0, 1), cB + hstepB, voffB); PG8_STAGE(PG8_SA(0, 1), cA + hstepA, voffA);
        if (wr == 1) PG8_BAR;
        PG8_WAIT_V(4); PG8_BAR;
        PG8_STAGE(PG8_SB(1, 0), cB + kstep, voffB); PG8_STAGE(PG8_SA(1, 0), cA + kstep, voffA); PG8_STAGE(PG8_SB(1, 1), cB + hstepB + kstep, voffB);
        PG8_WAIT_V(6); PG8_BAR;
    }
    for (;;) {
        const bool has_next = S.next(ui + 1, nxt);
        const char* nA = has_next ? (const char*)g.A + (size_t)nxt.pm * tstepA : cA; const char* nB = has_next ? (const char*)g.Bt + (size_t)nxt.pn * tstepB : cB;
        for (int t = 0; t < nt; t += 2) {
            if constexpr (Epi::HAS_MID) { if (E.is_mid(t)) E.mid(acc, cur, wr, wc, fr, fq, t); }
            const bool last = (t == nt - 2);
            const char* a1 = cA + (size_t)(t + 1) * kstep;
            const char* a2 = last ? nA : cA + (size_t)(t + 2) * kstep; const char* b2 = last ? nB : cB + (size_t)(t + 2) * kstep;
            const char* a3 = a2 + kstep; const char* b3 = b2 + kstep;
            if (last && has_next) S.a_ready(nxt);
            if constexpr (SP2) {
            PG8_LDB(B0, 0, 0); PG8_LDB(B1, 0, 1); PG8_SCHED; PG8_LDA(At, 0, 0); PG8_STAGE(PG8_SA(1, 1), a1 + hstepA, voffA);
            PG8_WAIT_V(8); PG8_WAIT_L(0); PG8_BAR; PG8_MMA(0, 0, At, B0); PG8_MMA(0, 1, At, B1); PG8_BAR; PG8_SCHED;
            PG8_LDA(At, 0, 1); PG8_STAGE(PG8_SB(0, 0), b2, voffB); PG8_STAGE(PG8_SB(0, 1), b2 + hstepB, voffB); PG8_STAGE(PG8_SA(0, 0), a2, voffA);
            PG8_WAIT_V(8); PG8_WAIT_L(0); PG8_BAR; PG8_MMA(1, 0, At, B0); PG8_MMA(1, 1, At, B1); PG8_BAR; PG8_SCHED;
            PG8_LDB(B0, 1, 0); PG8_LDB(B1, 1, 1); PG8_SCHED; PG8_LDA(At, 1, 0); PG8_STAGE(PG8_SA(0, 1), a2 + hstepA, voffA);
            PG8_WAIT_V(8); PG8_WAIT_L(0); PG8_BAR; PG8_MMA(0, 0, At, B0); PG8_MMA(0, 1, At, B1); PG8_BAR; PG8_SCHED;
            PG8_LDA(At, 1, 1); PG8_STAGE(PG8_SB(1, 0), b3, voffB); PG8_STAGE(PG8_SB(1, 1), b3 + hstepB, voffB); PG8_STAGE(PG8_SA(1, 0), a3, voffA);
            PG8_WAIT_V(8); PG8_WAIT_L(0); PG8_BAR; PG8_MMA(1, 0, At, B0); PG8_MMA(1, 1, At, B1); PG8_BAR; PG8_SCHED;
            } else {
            PG8_LDB(B0, 0, 0); PG8_SCHED; PG8_LDA(At, 0, 0); PG8_STAGE(PG8_SA(1, 1), a1 + hstepA, voffA);
            PG8_WAIT_L(8); PG8_BAR; PG8_WAIT_L(0); PG8_MMA(0, 0, At, B0); PG8_BAR; PG8_SCHED;
            PG8_LDB(B1, 0, 1); PG8_STAGE(PG8_SB(0, 0), b2, voffB);
            PG8_BAR; PG8_WAIT_L(0); PG8_MMA(0, 1, At, B1); PG8_BAR;
            PG8_LDA(At, 0, 1); PG8_STAGE(PG8_SA(0, 0), a2, voffA);
            PG8_BAR; PG8_WAIT_L(0); PG8_MMA(1, 0, At, B0); PG8_BAR; PG8_SCHED;
            PG8_STAGE(PG8_SB(0, 1), b2 + hstepB, voffB);
            PG8_WAIT_V(6); PG8_BAR; PG8_MMA(1, 1, At, B1); PG8_BAR;
            PG8_LDB(B0, 1, 0); PG8_SCHED; PG8_LDA(At, 1, 0); PG8_STAGE(PG8_SA(0, 1), a2 + hstepA, voffA);
            PG8_WAIT_L(8); PG8_BAR; PG8_WAIT_L(0); PG8_MMA(0, 0, At, B0); PG8_BAR; PG8_SCHED;
            PG8_LDB(B1, 1, 1); PG8_STAGE(PG8_SB(1, 0), b3, voffB);
            PG8_BAR; PG8_WAIT_L(0); PG8_MMA(0, 1, At, B1); PG8_BAR;
            PG8_LDA(At, 1, 1); PG8_STAGE(PG8_SA(1, 0), a3, voffA);
            PG8_BAR; PG8_WAIT_L(0); PG8_MMA(1, 0, At, B0); PG8_BAR; PG8_SCHED;
            PG8_STAGE(PG8_SB(1, 1), b3 + hstepB, voffB);
            PG8_WAIT_V(6); PG8_BAR; PG8_MMA(1, 1, At, B1); PG8_BAR;
            }
        }
        if constexpr (ALIGN_EPI) { if (wr == 0) PG8_BAR; }
        if constexpr (!Epi::AFTER_DRAIN) { E(acc, cur, wr, wc, fr, fq); S.done(cur); }
        if (!has_next) break;
#pragma unroll
        for (int a = 0; a < 2; ++a)
#pragma unroll
            for (int b = 0; b < 2; ++b)
#pragma unroll
                for (int m = 0; m < 4; ++m)
#pragma unroll
                    for (int n = 0; n < 2; ++n) acc[a][b][m][n] = (f32x4){0.f, 0.f, 0.f, 0.f};
        cur = nxt; cA = nA; cB = nB; ++ui;
        if constexpr (ALIGN_EPI) { if (wr == 1) PG8_BAR; }
    }
    PG8_WAIT_V(0);
    if constexpr (!ALIGN_EPI) { if (wr == 0) PG8_BAR; }
    PG8_BAR;
    if constexpr (Epi::AFTER_DRAIN) { E.fused(acc, cur, wr, wc, fr, fq, lds, wid, lane); S.done(cur); }
#undef PG8_SA
#undef PG8_SB
#undef PG8_STAGE
#undef PG8_LDA
#undef PG8_LDB
#undef PG8_MMA
#undef PG8_WAIT_V
#undef PG8_WAIT_L
#undef PG8_BAR
#undef PG8_SCHED
}
}

#define XB_TMO      128
#define XB_XCNT(j)  (256  + 64 * (j))
#define XB_XSUB(j)  (1280 + 64 * (j))
#define XB_XGEN(j)  (2304 + 64 * (j))
#define XB_TOP      3328
#define XB_TOPGEN   3392
#define XCD_BAR_WORDS 3456
#define XB_SPIN_CAP (1u << 24)

__device__ __forceinline__ unsigned xb_ld(unsigned* p)              { return __hip_atomic_load(p, __ATOMIC_RELAXED, __HIP_MEMORY_SCOPE_AGENT); }
__device__ __forceinline__ unsigned xb_add(unsigned* p, unsigned v) { return __hip_atomic_fetch_add(p, v, __ATOMIC_RELAXED, __HIP_MEMORY_SCOPE_AGENT); }
__device__ __forceinline__ unsigned xb_xcc_id() { return (unsigned)__builtin_amdgcn_s_getreg((3 << 11) | 20) & 0xFu; }
#define XB_SPIN(cond, bar) do { unsigned _sp = 0; while (cond) { __builtin_amdgcn_s_sleep(1); \
    if ((++_sp & 255u) == 0u) { if (xb_ld(&(bar)[XB_TMO])) break; if (_sp > XB_SPIN_CAP) { atomicAdd(&(bar)[XB_TMO], 1u); break; } } } } while (0)

struct XcdBarrier {
    unsigned* bar; unsigned x;
    volatile LAS unsigned* st;
    int wv;
};
__device__ __forceinline__ bool xb_thread0(int wv) { return wv == 0 && lane_now() == 0; }

__device__ __forceinline__ XcdBarrier xcd_barrier_post(unsigned* bar, volatile LAS unsigned* st, int wv) {
    XcdBarrier b; b.bar = bar; b.x = xb_xcc_id(); b.st = st; b.wv = wv;
    if (xb_thread0(wv)) (void)xb_add(&bar[XB_XCNT(b.x)], 1u);
    return b;
}
__device__ __forceinline__ void xcd_barrier_complete(unsigned* bar, unsigned x, unsigned& nloc, unsigned& nx) {
    const unsigned G = gridDim.x * gridDim.y * gridDim.z;
    unsigned sum, cnt, mine, sp = 0u;
    for (;;) {
        sum = 0u; cnt = 0u; mine = 0u;
#pragma unroll
        for (unsigned j = 0; j < 16; ++j) { const unsigned c = xb_ld(&bar[XB_XCNT(j)]); sum += c; cnt += (c > 0u) ? 1u : 0u; mine = (j == x) ? c : mine; }
        if (sum == G) break;
        __builtin_amdgcn_s_sleep(1);
        if ((++sp & 255u) == 0u) { if (xb_ld(&bar[XB_TMO])) break; if (sp > XB_SPIN_CAP) { atomicAdd(&bar[XB_TMO], 1u); break; } }
    }
    nloc = mine > 0u ? mine : 1u; nx = cnt > 0u ? cnt : 1u;
}

__device__ __forceinline__ void xcd_barrier(const XcdBarrier& b) {
    asm volatile("s_waitcnt vmcnt(0)" ::: "memory");
    __syncthreads();
    if (xb_thread0(b.wv)) {
        unsigned* bar = b.bar;
        __builtin_amdgcn_s_waitcnt(0);
        unsigned nloc = b.st[0], nx = b.st[1];
        if (nloc == 0u) { xcd_barrier_complete(bar, b.x, nloc, nx); b.st[0] = nloc; b.st[1] = nx; }
        const unsigned old = xb_add(&bar[XB_XSUB(b.x)], 1u);
        const unsigned gen = old / nloc;
        if (old + 1u == (gen + 1u) * nloc) {
            __builtin_amdgcn_fence(__ATOMIC_RELEASE, "agent");
            asm volatile("s_waitcnt vmcnt(0)" ::: "memory");
            const unsigned og = xb_add(&bar[XB_TOP], 1u);
            const unsigned tg = og / nx;
            if (og + 1u == (tg + 1u) * nx) xb_add(&bar[XB_TOPGEN], 1u);
            else XB_SPIN(xb_ld(&bar[XB_TOPGEN]) == tg, bar);
            __builtin_amdgcn_fence(__ATOMIC_ACQUIRE, "agent");
            xb_add(&bar[XB_XGEN(b.x)], 1u);
            asm volatile("s_waitcnt vmcnt(0)" ::: "memory");
        } else {
            XB_SPIN(xb_ld(&bar[XB_XGEN(b.x)]) == gen, bar);
            __builtin_amdgcn_fence(__ATOMIC_ACQUIRE, "agent");
            asm volatile("s_waitcnt vmcnt(0)" ::: "memory");
        }
    }
    __syncthreads();
}

#ifndef MLA_OUT_SCALE
#define MLA_OUT_SCALE 1.0f
#endif
namespace mla {
constexpr int DQK = 192, DV = 128, KVBLK = 64, QB = 256;
constexpr int SHM_K = KVBLK * DQK * 2, SHM_V = KVBLK * DV * 2;
constexpr int LDS_V = 0, LDS_K = 2 * SHM_V, LDS_WS = 2 * SHM_V + 2 * SHM_K;
#define MLA_KSWZ(row, colB) ((row) * 384 + ((colB) ^ (((row) & 7) << 4)))
#define SBAR() __builtin_amdgcn_sched_barrier(0)
__device__ __forceinline__ int v_st(int k, int c) { const int kk = (k & ~0xC) | ((k & 4) << 1) | ((k & 8) >> 1); return ((kk >> 3) * 4 + (c >> 5)) * 512 + ((kk & 7) * 32 + (c & 31)) * 2; }
__device__ __forceinline__ int v_rd_base(int lane) { return ((lane & 3) << 3) | (((lane >> 2) & 3) << 6) | (((lane >> 4) & 1) << 5) | (((lane >> 5) & 1) << 8); }
constexpr int v_rd_off(int d0, int ks, int half) { return d0 * 512 + ks * 4096 + half * 2048; }

__device__ __forceinline__ void mask_tile(f32x16& p0, f32x16& p1, int dq) {
    const float NEG = -__builtin_inff();
#pragma unroll
    for (int r = 0; r < 16; ++r) {
        const int c = (r & 3) + 8 * (r >> 2);
        if (dq - c < 0) p0[r] = NEG;
        if (dq - c - 32 < 0) p1[r] = NEG;
    }
}
constexpr float THR2 = 8.f;
__device__ __forceinline__ void softmax_tile(f32x16& p0, f32x16& p1, float& m_reg, float& alpha, float& l_reg, bf16x8& pa0, bf16x8& pa1, bf16x8& pa2, bf16x8& pa3) {
    float pmax = p0[0];
#pragma unroll
    for (int r = 1; r < 16; ++r) pmax = fmaxf(pmax, p0[r]);
#pragma unroll
    for (int r = 0; r < 16; ++r) pmax = fmaxf(pmax, p1[r]);
    { auto rr = __builtin_amdgcn_permlane32_swap(__float_as_uint(pmax), __float_as_uint(pmax), false, false);
      pmax = fmaxf(__uint_as_float(rr[0]), __uint_as_float(rr[1])); }
    float mn;
    if (__builtin_expect(__all((pmax - m_reg) <= THR2), 1)) { mn = m_reg; alpha = 1.f; }
    else { mn = fmaxf(m_reg, pmax); alpha = __builtin_amdgcn_exp2f(m_reg - mn); m_reg = mn; }
#pragma unroll
    for (int r = 0; r < 16; ++r) { p0[r] = __builtin_amdgcn_exp2f(p0[r] - mn); p1[r] = __builtin_amdgcn_exp2f(p1[r] - mn); }
    float ps = 0;
#pragma unroll
    for (int r = 0; r < 16; ++r) ps += p0[r];
#pragma unroll
    for (int r = 0; r < 16; ++r) ps += p1[r];
    { auto rr = __builtin_amdgcn_permlane32_swap(__float_as_uint(ps), __float_as_uint(ps), false, false);
      ps = __uint_as_float(rr[0]) + __uint_as_float(rr[1]); }
    l_reg = l_reg * alpha + ps;
#define PK4(P, B_, OUT) do { unsigned a0 = cvtpk(P[B_+0], P[B_+1]), a1 = cvtpk(P[B_+2], P[B_+3]);                          \
        unsigned b0 = cvtpk(P[B_+4], P[B_+5]), b1 = cvtpk(P[B_+6], P[B_+7]);                                             \
        auto r0 = __builtin_amdgcn_permlane32_swap(a0, b0, false, false); auto r1 = __builtin_amdgcn_permlane32_swap(a1, b1, false, false); \
        v4u w = {r0[0], r1[0], r0[1], r1[1]}; OUT = *reinterpret_cast<bf16x8*>(&w); } while (0)
    PK4(p0, 0, pa0); PK4(p0, 8, pa1); PK4(p1, 0, pa2); PK4(p1, 8, pa3);
#undef PK4
}
template <int KB>
__device__ __forceinline__ void qkt(f32x16& p0, f32x16& p1, const char* K_lds, int r32, int hi, const bf16x8* qr) {
    p0 = f32x16{}; p1 = f32x16{};
    const char* kb[4];
#pragma unroll
    for (int dd = 0; dd < 4; ++dd) kb[dd] = K_lds + KB * SHM_K + MLA_KSWZ(r32, (dd * 16 + hi * 8) * 2);
#pragma unroll
    for (int d0 = 0; d0 < 12; ++d0) { const char* a = kb[d0 & 3] + (d0 >> 2) * 128;
        bf16x8 b0 = *reinterpret_cast<const bf16x8*>(a);
        bf16x8 b1 = *reinterpret_cast<const bf16x8*>(a + 32 * 384);
        p0 = __builtin_amdgcn_mfma_f32_32x32x16_bf16(b0, qr[d0], p0, 0, 0, 0);
        p1 = __builtin_amdgcn_mfma_f32_32x32x16_bf16(b1, qr[d0], p1, 0, 0, 0); }
}
template <int VB>
__device__ __forceinline__ void pv_tile(f32x16* o, int vb0, bf16x8 pa0, bf16x8 pa1, bf16x8 pa2, bf16x8 pa3) {
#define TRRD(dst, off) asm volatile("ds_read_b64_tr_b16 %0, %1 offset:%2" : "=&v"(dst) : "v"(vb0), "i"(off) : "memory")
#define PV_D0(d0) do { s16x4 l0, l1, l2, l3, h0, h1, h2, h3; constexpr int b_ = VB * SHM_V + v_rd_off(d0, 0, 0);   \
        TRRD(l0, b_); TRRD(h0, b_ + 2048); TRRD(l1, b_ + 4096); TRRD(h1, b_ + 6144); TRRD(l2, b_ + 8192); TRRD(h2, b_ + 10240); TRRD(l3, b_ + 12288); TRRD(h3, b_ + 14336); \
        asm volatile("s_waitcnt lgkmcnt(0)" ::: "memory"); SBAR();                                                   \
        o[d0] = __builtin_amdgcn_mfma_f32_32x32x16_bf16(pa0, (bf16x8){l0[0], l0[1], l0[2], l0[3], h0[0], h0[1], h0[2], h0[3]}, o[d0], 0, 0, 0);   \
        o[d0] = __builtin_amdgcn_mfma_f32_32x32x16_bf16(pa1, (bf16x8){l1[0], l1[1], l1[2], l1[3], h1[0], h1[1], h1[2], h1[3]}, o[d0], 0, 0, 0);   \
        o[d0] = __builtin_amdgcn_mfma_f32_32x32x16_bf16(pa2, (bf16x8){l2[0], l2[1], l2[2], l2[3], h2[0], h2[1], h2[2], h2[3]}, o[d0], 0, 0, 0);   \
        o[d0] = __builtin_amdgcn_mfma_f32_32x32x16_bf16(pa3, (bf16x8){l3[0], l3[1], l3[2], l3[3], h3[0], h3[1], h3[2], h3[3]}, o[d0], 0, 0, 0); } while (0)
    PV_D0(0); PV_D0(1); PV_D0(2); PV_D0(3);
#undef PV_D0
#undef TRRD
}
__device__ __forceinline__ void attn_block(const bf16* Qh, const bf16* Kh, const bf16* Vh, bf16* Yp, const bf16* Zp, int P0, char* lds, int wv_) {
    int tid_ = wv_ * 64 + lane_now(); asm volatile("" : "+v"(tid_));
    const int tid = tid_, wid = __builtin_amdgcn_readfirstlane(tid >> 6), lane = tid & 63, r32 = lane & 31, hi = lane >> 5;
    const int NT = (P0 + QB) / KVBLK;
    const int qlo = P0 + wid * 32, qm = qlo + r32 - 4 * hi;
    char* V_lds = lds + LDS_V; char* K_lds = lds + LDS_K;
    float* ws = (float*)(lds + LDS_WS) + wid * 64; float* li_l = ws, * al_l = ws + 32;
    float m_reg = -1e30f, l_reg = 0; f32x16 o[4] = {};
    const int sr = tid >> 4, sc = (tid & 15) * 8, vst0 = v_st(sr, sc), vst1 = v_st(32 + sr, sc);
    int kgo[3], klo[3];
#pragma unroll
    for (int j = 0; j < 3; ++j) { const int i = tid + 512 * j, row = i / 24, c = i - row * 24; kgo[j] = row * 192 + c * 8; klo[j] = MLA_KSWZ(row, c * 16); }
    const int vb0 = (int)(uintptr_t)V_lds + v_rd_base(lane);
    bf16x8 qr[12];
#pragma unroll
    for (int d0 = 0; d0 < 12; ++d0) qr[d0] = *reinterpret_cast<const bf16x8*>(Qh + (size_t)(P0 + wid * 32 + r32) * 192 + d0 * 16 + hi * 8);
    bf16x8 st_k0, st_k1, st_k2, st_v0, st_v1;
#define SLOAD(k0) do { const bf16* kp = Kh + (size_t)(k0) * 192; const bf16* vp = Vh + (size_t)(k0) * 128;                     \
        st_k0 = *reinterpret_cast<const bf16x8*>(kp + kgo[0]); st_k1 = *reinterpret_cast<const bf16x8*>(kp + kgo[1]); st_k2 = *reinterpret_cast<const bf16x8*>(kp + kgo[2]); \
        st_v0 = *reinterpret_cast<const bf16x8*>(vp + (size_t)sr * 128 + sc); st_v1 = *reinterpret_cast<const bf16x8*>(vp + (size_t)(32 + sr) * 128 + sc); } while (0)
#define SWRITE(bf) do { *(bf16x8*)(K_lds + (bf) * SHM_K + klo[0]) = st_k0; *(bf16x8*)(K_lds + (bf) * SHM_K + klo[1]) = st_k1; *(bf16x8*)(K_lds + (bf) * SHM_K + klo[2]) = st_k2; \
        *(bf16x8*)(V_lds + (bf) * SHM_V + vst0) = st_v0; *(bf16x8*)(V_lds + (bf) * SHM_V + vst1) = st_v1; } while (0)
#define RESC(a) do { if (__any((a) < 1.f)) { if (hi == 0) al_l[r32] = (a); asm volatile("s_waitcnt lgkmcnt(0)" ::: "memory");              \
                     for (int d_ = 0; d_ < 4; ++d_) for (int r = 0; r < 16; ++r) o[d_][r] *= al_l[crow(r, hi)]; } } while (0)
    SLOAD(0); VM_WAIT(); SWRITE(0);
    __syncthreads();
    f32x16 p0, p1; bf16x8 pa0, pa1, pa2, pa3; float alpha;
#define STEP(t, BUF) do {                                                                                                 \
        if ((t) + 1 < NT) SLOAD(((t) + 1) * KVBLK);                                                                       \
        SBAR(); qkt<BUF>(p0, p1, K_lds, r32, hi, qr);                                                                    \
        { const int kb_ = (t) * KVBLK; if (kb_ + KVBLK - 1 > qlo) mask_tile(p0, p1, qm - kb_); }                          \
        softmax_tile(p0, p1, m_reg, alpha, l_reg, pa0, pa1, pa2, pa3);                                                    \
        RESC(alpha);                                                                                                      \
        pv_tile<BUF>(o, vb0, pa0, pa1, pa2, pa3);                                                                         \
        if ((t) + 1 < NT) { VM_WAIT(); SWRITE(1 - (BUF)); }                                                               \
        __syncthreads(); } while (0)
    for (int t = 0; t < NT; t += 2) { STEP(t, 0); STEP(t + 1, 1); }
#undef STEP
    if (hi == 0) li_l[r32] = l_reg; asm volatile("s_waitcnt lgkmcnt(0)" ::: "memory");
    float rli[16];
#pragma unroll
    for (int r = 0; r < 16; ++r) rli[r] = __builtin_amdgcn_rcpf(li_l[crow(r, hi)]);
    unsigned zr[16][4];
#pragma unroll
    for (int r = 0; r < 16; ++r) { const size_t orow = (size_t)(P0 + wid * 32 + crow(r, hi));
#pragma unroll
        for (int d0 = 0; d0 < 4; ++d0) zr[r][d0] = Zp[orow * NP + d0 * 32 + r32]; }
    asm volatile("" ::: "memory"); __builtin_amdgcn_sched_barrier(0);
#pragma unroll
    for (int r = 0; r < 16; ++r) { const size_t orow = (size_t)(P0 + wid * 32 + crow(r, hi));
#pragma unroll
        for (int d0 = 0; d0 < 4; ++d0) { const float z = bf2f(zr[r][d0]); const float v = o[d0][r] * rli[r] * z * MLA_OUT_SCALE;
            const float vn = __builtin_bit_cast(float, __builtin_amdgcn_update_dpp(0, __builtin_bit_cast(int, v), 0xB1, 0xF, 0xF, true));
            if ((r32 & 1) == 0) *(unsigned*)(Yp + orow * 4096 + d0 * 32 + r32) = cvtpk(v, vn); } }
    __syncthreads();
#undef SLOAD
#undef SWRITE
#undef RESC
}
#undef SBAR
}

struct Args { const void* in[21]; float* out; unsigned char* ws; int ph_lo, ph_hi; };
typedef const __attribute__((address_space(4))) Args* KArgs;
struct Frame {
    LAS unsigned char* lds;
    int tid, lane, wave, G, c;
    const float *x, *cvec; const int* pos; const float *norm_g, *w_ada, *b_ada, *w_in, *mla_gq, *mla_wuq, *mla_gkv, *mla_wukv, *gla_wg2, *gla_bg, *gla_gout, *w_mg, *b_mg, *w_bm, *w_bg, *w_bd, *w_o, *final_g;
    float* out;
    float *MOD, *COS, *SIN, *SSQ, *DEC, *BCG;
    bf16 *W1, *WUQ, *WUKV, *WBM, *WBG, *WBD, *WO; unsigned char *WG8, *H8;
    bf16 *H, *UT, *P, *GT, *Q, *K, *V, *MG, *Y, *DKV, *IKC;
    int* IDX;
};
__device__ __forceinline__ void frame_init(Frame& F, LAS unsigned char* lds, int wv_) {
    KArgs ap = (KArgs)__builtin_amdgcn_kernarg_segment_ptr(); asm volatile("" : "+s"(ap));
    int t = wv_ * 64 + lane_now(); asm volatile("" : "+v"(t));
    F.lds = lds; F.tid = t; F.lane = t & 63; F.wave = __builtin_amdgcn_readfirstlane(t >> 6); F.G = gridDim.x; F.c = blockIdx.x;
    F.x = (const float*)ap->in[0]; F.cvec = (const float*)ap->in[1]; F.pos = (const int*)ap->in[2]; F.norm_g = (const float*)ap->in[3]; F.w_ada = (const float*)ap->in[4];
    F.b_ada = (const float*)ap->in[5]; F.w_in = (const float*)ap->in[6]; F.mla_gq = (const float*)ap->in[7]; F.mla_wuq = (const float*)ap->in[8]; F.mla_gkv = (const float*)ap->in[9];
    F.mla_wukv = (const float*)ap->in[10]; F.gla_wg2 = (const float*)ap->in[11]; F.gla_bg = (const float*)ap->in[12]; F.gla_gout = (const float*)ap->in[13]; F.w_mg = (const float*)ap->in[14];
    F.b_mg = (const float*)ap->in[15]; F.w_bm = (const float*)ap->in[16]; F.w_bg = (const float*)ap->in[17]; F.w_bd = (const float*)ap->in[18]; F.w_o = (const float*)ap->in[19];
    F.final_g = (const float*)ap->in[20]; F.out = ap->out;
    unsigned char* ws = ap->ws;
    F.MOD = (float*)(ws + WS_MOD); F.COS = (float*)(ws + WS_COS); F.SIN = (float*)(ws + WS_SIN); F.SSQ = (float*)(ws + WS_SSQ); F.DEC = (float*)(ws + WS_DEC); F.BCG = (float*)(ws + WS_BCG);
    F.WG8 = ws + WS_W + WO_WG8; F.H8 = ws + WS_H8;
    F.W1 = (bf16*)(ws + WS_W + WO_W1); F.WUQ = (bf16*)(ws + WS_W + WO_WUQ); F.WUKV = (bf16*)(ws + WS_W + WO_WUKV); F.WBM = (bf16*)(ws + WS_W + WO_WBM);
    F.WBG = (bf16*)(ws + WS_W + WO_WBG); F.WBD = (bf16*)(ws + WS_W + WO_WBD); F.WO = (bf16*)(ws + WS_W + WO_WO);
    F.H = (bf16*)(ws + WS_H); F.UT = (bf16*)(ws + WS_UT); F.IDX = (int*)(ws + WS_IDX); F.P = (bf16*)(ws + WS_P); F.GT = (bf16*)(ws + WS_G);
    F.Q = (bf16*)(ws + WS_Q); F.K = (bf16*)(ws + WS_K); F.V = (bf16*)(ws + WS_V); F.MG = (bf16*)(ws + WS_MG); F.Y = (bf16*)(ws + WS_Y); F.DKV = (bf16*)(ws + WS_DKV); F.IKC = (bf16*)(ws + WS_IKC);
}

template <bool FP8, class Map>
__device__ __forceinline__ void transpose_item(const float* W, int K, int Nsrc, void* WTv, const float* kscale, float scale, Map map, LAS float* scr, int item, int nblk, int lane, int ldt = 0) {
    if (ldt == 0) ldt = K;
    const int kb = item / nblk, nb = item - kb * nblk, k0 = 64 * kb, n0 = 64 * nb;
    const int c4 = lane & 15, kr = lane >> 4;
    const int s0 = map(n0 + 4 * c4), s1 = map(n0 + 4 * c4 + 1), s2 = map(n0 + 4 * c4 + 2), s3 = map(n0 + 4 * c4 + 3);
    const bool vec = (s0 >= 0) && (s1 == s0 + 1) && (s2 == s0 + 2) && (s3 == s0 + 3) && ((s0 & 3) == 0);
#pragma unroll 4
    for (int i = 0; i < 16; ++i) { const int kk = 4 * i + kr; const float* wr = W + (size_t)(k0 + kk) * Nsrc; f32x4 v;
        if (vec) v = *(const f32x4*)(wr + s0);
        else { v[0] = s0 >= 0 ? wr[s0] : 0.f; v[1] = s1 >= 0 ? wr[s1] : 0.f; v[2] = s2 >= 0 ? wr[s2] : 0.f; v[3] = s3 >= 0 ? wr[s3] : 0.f; }
        float sc = scale; if (kscale) sc *= kscale[k0 + kk];
        LAS float* d = scr + kk * 65 + 4 * c4; d[0] = v[0] * sc; d[1] = v[1] * sc; d[2] = v[2] * sc; d[3] = v[3] * sc; }
    LDS_WAIT(); asm volatile("" ::: "memory");
    const int c = lane & 7;
#pragma unroll
    for (int j = 0; j < 8; ++j) { const int n = (lane >> 3) + 8 * j; const LAS float* s = scr + (8 * c) * 65 + n;
        if constexpr (FP8) {
            int w0 = __builtin_amdgcn_cvt_pk_fp8_f32(s[0 * 65], s[1 * 65], 0, false); w0 = __builtin_amdgcn_cvt_pk_fp8_f32(s[2 * 65], s[3 * 65], w0, true);
            int w1 = __builtin_amdgcn_cvt_pk_fp8_f32(s[4 * 65], s[5 * 65], 0, false); w1 = __builtin_amdgcn_cvt_pk_fp8_f32(s[6 * 65], s[7 * 65], w1, true);
            v2u o; o.x = (unsigned)w0; o.y = (unsigned)w1; *(v2u*)((unsigned char*)WTv + (size_t)(n0 + n) * ldt + k0 + 8 * c) = o;
        } else {
            v4u o; o.x = pk2(s[0 * 65], s[1 * 65]); o.y = pk2(s[2 * 65], s[3 * 65]); o.z = pk2(s[4 * 65], s[5 * 65]); o.w = pk2(s[6 * 65], s[7 * 65]);
            *(v4u*)((bf16*)WTv + (size_t)(n0 + n) * ldt + k0 + 8 * c) = o; } }
    LDS_WAIT(); asm volatile("" ::: "memory");
}
struct MapId { __device__ __forceinline__ int operator()(int n) const { return n; } };
struct MapIn {
    __device__ __forceinline__ int operator()(int n) const {
        if (n < 1280) return n;
        if (n < 1344) { const int jj = n - 1280; return SC_KROPE + (jj & 1) * 32 + (jj >> 1); }
        if (n < 1408) return SC_IK + (n - 1344);
        if (n < 1440) return SC_IW + (n - 1408);
        if (n < 1456) return SC_GLOW + (n - 1440);
        if (n < 1536) return -1;
        if (n < 2048) return SC_GQ + (n - 1536);
        if (n < 2560) return SC_GK + (n - 2048);
        if (n < 3584) return SC_GV + (n - 2560);
        if (n < 4608) return SC_DQ + (n - 3584);
        if (n < 4864) return SC_DK + (n - 4608);
        if (n < 5120) return SC_DV + (n - 4864);
        if (n < 7168) return SC_IQ + (n - 5120);
        if (n < 9216) return SC_ZMLA + (n - 7168);
        if (n < 10240) return SC_ZGLA + (n - 9216);
        return SC_ZDSA + (n - 10240);
    }
};
struct MapUQ {
    __device__ __forceinline__ int operator()(int n) const { const int h = n / 192, d = n - h * 192; if (d < 128) return n; const int jj = d - 128; return h * 192 + 128 + (jj & 1) * 32 + (jj >> 1); }
};
struct MapUKV {
    __device__ __forceinline__ int operator()(int n) const { if (n < 2048) { const int h = n >> 7, d = n & 127; return h * 256 + d; } const int c = n - 2048, h = c >> 7, d = c & 127; return h * 256 + 128 + d; }
};

__device__ __forceinline__ void weights_phase(Frame& F, int l) {
    LAS float* scr = (LAS float*)(F.lds + RING_OFF + F.wave * 16640);
    const int gw = F.c * NWAVES + F.wave, NGW = F.G * NWAVES;
    constexpr int I_IN = (DM / 64) * (NP / 64), I_MG = (DM / 64) * (NG / 64), I_UQ = (MLA_QR / 64) * (NQ / 64), I_UKV = (MLA_KVR / 64) * (NKV / 64),
                  I_BM = (2048 / 64) * (DM / 64), I_BG = (1024 / 64) * (DM / 64), I_O = (DM / 64) * (DM / 64);
    constexpr int NITEMS = I_IN + I_MG + I_UQ + I_UKV + I_BM + 2 * I_BG + I_O;
    for (int it = gw; it < NITEMS; it += NGW) {
        int r = it;
        if (r < I_IN) { transpose_item<false>(F.w_in + (size_t)l * DM * IN_W, DM, IN_W, F.W1, nullptr, 1.f, MapIn(), scr, r, NP / 64, F.lane); continue; } r -= I_IN;
        if (r < I_MG) { transpose_item<true>(F.w_mg + (size_t)l * DM * NG, DM, NG, F.WG8, nullptr, 64.f, MapId(), scr, r, NG / 64, F.lane); continue; } r -= I_MG;
        if (r < I_UQ) { transpose_item<false>(F.mla_wuq + (size_t)l * MLA_QR * NQ, MLA_QR, NQ, F.WUQ, F.mla_gq + l * MLA_QR, 1.f, MapUQ(), scr, r, NQ / 64, F.lane); continue; } r -= I_UQ;
        if (r < I_UKV) { transpose_item<false>(F.mla_wukv + (size_t)l * MLA_KVR * NKV, MLA_KVR, NKV, F.WUKV, F.mla_gkv + l * MLA_KVR, 1.f, MapUKV(), scr, r, NKV / 64, F.lane); continue; } r -= I_UKV;
        if (r < I_BM) { transpose_item<false>(F.w_bm + (size_t)l * 2048 * DM, 2048, DM, F.WBM, nullptr, 1.f, MapId(), scr, r, DM / 64, F.lane, DM); continue; } r -= I_BM;
        if (r < I_BG) { transpose_item<false>(F.w_bg + (size_t)l * 1024 * DM, 1024, DM, F.WBM + 2048, nullptr, 1.f, MapId(), scr, r, DM / 64, F.lane, DM); continue; } r -= I_BG;
        if (r < I_BG) { transpose_item<false>(F.w_bd + (size_t)l * 1024 * DM, 1024, DM, F.WBM + 3072, nullptr, 1.f, MapId(), scr, r, DM / 64, F.lane, DM); continue; } r -= I_BG;
        transpose_item<false>(F.w_o + (size_t)l * DM * DM, DM, DM, F.WO, nullptr, 1.f, MapId(), scr, r, DM / 64, F.lane);
    }
}
__device__ __forceinline__ void mod_phase(Frame& F) {
    LAS float* red = (LAS float*)(F.lds + 70000);
    const int ks = F.tid >> 3, cg = F.tid & 7;
    for (int it = F.c; it < 768; it += F.G) {
        const int l = it / 384, n0 = (it - l * 384) * 32;
        const float* W = F.w_ada + (size_t)l * DM * NG + n0 + 4 * cg;
        f32x4 a0 = {0.f, 0.f, 0.f, 0.f}, a1 = {0.f, 0.f, 0.f, 0.f};
#pragma unroll 4
        for (int kk = 0; kk < 64; ++kk) { const int k = ks * 64 + kk; const f32x4 w = *(const f32x4*)(W + (size_t)k * NG);
            const float c0 = F.cvec[k], c1 = F.cvec[DM + k]; const float s0 = siluf_(c0), s1 = siluf_(c1);
            a0 += w * s0; a1 += w * s1; }
        __syncthreads();
        *(LAS f32x4*)(red + (ks * 8 + cg) * 8) = a0; *(LAS f32x4*)(red + (ks * 8 + cg) * 8 + 4) = a1;
        __syncthreads();
        if (F.tid < 64) { const int cgo = F.tid >> 3, e = F.tid & 7; float s = 0.f;
            for (int k2 = 0; k2 < 64; ++k2) s += red[(k2 * 8 + cgo) * 8 + e];
            const int b = e >> 2, n = n0 + 4 * cgo + (e & 3);
            F.MOD[((size_t)l * 2 + b) * NG + n] = s + F.b_ada[(size_t)l * NG + n]; }
    }
    __syncthreads();
}
__device__ __forceinline__ void rope_phase(Frame& F) {
    for (int i = (F.c * 512 + F.tid); i < T * 32; i += F.G * 512) { const int t = i >> 5, j = i & 31;
        const float inv = (float)pow(10000.0, -(double)(2 * j) / 64.0);
        const float ang = (float)F.pos[t] * inv;
        F.COS[i] = (float)cos((double)ang); F.SIN[i] = (float)sin((double)ang); }
}
__device__ __forceinline__ void norm_phase(Frame& F, const float* xin, int l) {
    const int gw = F.c * NWAVES + F.wave, NGW = F.G * NWAVES;
    const float* g = F.norm_g + (size_t)l * DM;
    for (int m = gw; m < T; m += NGW) { const int b = m >> 13;
        const float* shift = F.MOD + ((size_t)l * 2 + b) * NG; const float* scale = shift + DM;
        const f32x4* xr = (const f32x4*)(xin + (size_t)m * DM) + F.lane;
        f32x4 v[16]; float s = 0.f;
#pragma unroll
        for (int j = 0; j < 16; ++j) { v[j] = xr[64 * j]; s += (v[j][0] * v[j][0] + v[j][1] * v[j][1]) + (v[j][2] * v[j][2] + v[j][3] * v[j][3]); }
        const float rstd = 1.0f / sqrtf(wave_sum(s) * (1.0f / DM) + NORM_EPS);
        v2u* o8 = (v2u*)(F.H + (size_t)m * DM) + F.lane;
#pragma unroll
        for (int j = 0; j < 16; ++j) { const int col = 4 * (F.lane + 64 * j);
            const f32x4 gg = *(const f32x4*)(g + col), sc = *(const f32x4*)(scale + col), sh = *(const f32x4*)(shift + col);
            const f32x4 y = v[j] * rstd * gg * (sc + 1.0f) + sh;
            v2u w; w.x = pk2(y[0], y[1]); w.y = pk2(y[2], y[3]); o8[64 * j] = w;
            int q8 = __builtin_amdgcn_cvt_pk_fp8_f32(y[0], y[1], 0, false); q8 = __builtin_amdgcn_cvt_pk_fp8_f32(y[2], y[3], q8, true);
            *(int*)(F.H8 + (size_t)m * DM + col) = q8; }
    }
}
__device__ __forceinline__ void final_phase(Frame& F) {
    const int gw = F.c * NWAVES + F.wave, NGW = F.G * NWAVES;
    f32x4 gg[16];
#pragma unroll
    for (int j = 0; j < 16; ++j) gg[j] = *(const f32x4*)(F.final_g + 4 * (F.lane + 64 * j));
    for (int m = gw; m < T; m += NGW) {
        f32x4* xr = (f32x4*)(F.out + (size_t)m * DM) + F.lane;
        f32x4 v[16]; float s = 0.f;
#pragma unroll
        for (int j = 0; j < 16; ++j) { v[j] = xr[64 * j]; s += (v[j][0] * v[j][0] + v[j][1] * v[j][1]) + (v[j][2] * v[j][2] + v[j][3] * v[j][3]); }
        const float rstd = 1.0f / sqrtf(wave_sum(s) * (1.0f / DM) + NORM_EPS);
#pragma unroll
        for (int j = 0; j < 16; ++j) xr[64 * j] = v[j] * rstd * gg[j] * OUT_SCALE;
    }
}
__device__ __forceinline__ void krope_phase(Frame& F) {
    for (int i = F.c * 512 + F.tid; i < T * 8; i += F.G * 512) { const int row = i >> 3, ch = i & 7, b = row >> 13, s = row & 8191;
        const v4u w = *(const v4u*)(F.P + (size_t)row * NP + PC_KROPE + ch * 8);
        const f32x4 c = *(const f32x4*)(F.COS + (size_t)row * 32 + ch * 4), sn = *(const f32x4*)(F.SIN + (size_t)row * 32 + ch * 4);
        v4u o; float x1, x2;
        x1 = bflo(w.x); x2 = bfhi(w.x); o.x = pk2(x1 * c[0] - x2 * sn[0], x1 * sn[0] + x2 * c[0]);
        x1 = bflo(w.y); x2 = bfhi(w.y); o.y = pk2(x1 * c[1] - x2 * sn[1], x1 * sn[1] + x2 * c[1]);
        x1 = bflo(w.z); x2 = bfhi(w.z); o.z = pk2(x1 * c[2] - x2 * sn[2], x1 * sn[2] + x2 * c[2]);
        x1 = bflo(w.w); x2 = bfhi(w.w); o.w = pk2(x1 * c[3] - x2 * sn[3], x1 * sn[3] + x2 * c[3]);
#pragma unroll
        for (int h = 0; h < 16; ++h) *(v4u*)(F.K + (((size_t)(b * 16 + h) * 8192 + s) * 192 + 128 + ch * 8)) = o; }
}

template <int K>
__device__ __forceinline__ void mma32_lds(f32x16& acc, const LAS unsigned char* A, int pa, const LAS unsigned char* B, int pb, int r32, int hi, int xa = 0, int xb = 0) {
#pragma unroll
    for (int k0 = 0; k0 < K; k0 += 16) {
        const bf16x8 a = *(const LAS bf16x8*)(A + r32 * pa + (((k0 + 8 * hi) * 2) ^ xa));
        const bf16x8 b = *(const LAS bf16x8*)(B + r32 * pb + (((k0 + 8 * hi) * 2) ^ xb));
        acc = __builtin_amdgcn_mfma_f32_32x32x16_bf16(a, b, acc, 0, 0, 0);
    }
}
constexpr int GL_BC = 0, GL_GL = 32768, GL_W2 = 36864, GL_BG = 45056, GL_X = 45568, GL_TOT = 131072;
__device__ __forceinline__ void gla_gates(Frame& F, int l, int b, int h, int n) {
    LAS float* bc = (LAS float*)(F.lds + GL_BC); LAS float* gl = (LAS float*)(F.lds + GL_GL); LAS float* w2 = (LAS float*)(F.lds + GL_W2); LAS float* bgs = (LAS float*)(F.lds + GL_BG);
    const size_t row0 = (size_t)b * SEQ + (size_t)n * GLA_C;
    for (int i = F.tid; i < 1024; i += 512) { const int c = i >> 4, r = i & 15; gl[i] = bf2f(F.P[(row0 + c) * NP + PC_GLOW + r]); }
    for (int i = F.tid; i < 2048; i += 512) { const int r = i >> 7, d = i & 127; w2[i] = F.gla_wg2[((size_t)l * GLA_R + r) * 512 + h * 128 + d]; }
    if (F.tid < 128) bgs[F.tid] = F.gla_bg[(size_t)l * 512 + h * 128 + F.tid];
    __syncthreads();
    { const int d = F.tid & 127, cg = F.tid >> 7; float run = 0.f, vals[16];
      LAS float* tot = (LAS float*)(F.lds + GL_TOT);
#pragma unroll
      for (int cc = 0; cc < 16; ++cc) { const int c = cg * 16 + cc; float xx = bgs[d];
#pragma unroll
          for (int r = 0; r < 16; ++r) xx += gl[c * 16 + r] * w2[r * 128 + d];
          const float ls = fminf(xx, 0.f) - log1pf(expf(-fabsf(xx)));
          run += ls * (1.0f / 16.0f); vals[cc] = run; }
      tot[cg * 128 + d] = run;
      __syncthreads();
      float off = 0.f;
      for (int g2 = 0; g2 < cg; ++g2) off += tot[g2 * 128 + d];
#pragma unroll
      for (int cc = 0; cc < 16; ++cc) bc[(cg * 16 + cc) * 128 + d] = vals[cc] + off; }
    __syncthreads();
}
__device__ __forceinline__ void gla1_phase(Frame& F, int l) {
    constexpr int PT = 144;
    LAS float* bc = (LAS float*)(F.lds + GL_BC);
    LAS unsigned char* keT = F.lds + GL_X; LAS unsigned char* vT = F.lds + GL_X + 128 * PT;
    const int r32 = F.lane & 31, hi = F.lane >> 5;
    for (int u = F.c; u < 8 * GLA_NCH; u += F.G) { const int bh = u >> 7, n = u & 127, b = bh >> 2, h = bh & 3;
        const size_t row0 = (size_t)b * SEQ + (size_t)n * GLA_C;
        const int c = F.tid >> 3, d8 = F.tid & 7;
        const bf16* kp = F.P + (row0 + c) * NP + PC_GK + h * 128 + d8 * 16; const v4u k0 = *(const v4u*)kp, k1 = *(const v4u*)(kp + 8);
        const bf16* vp = F.P + (row0 + c) * NP + PC_GV + h * 256 + d8 * 32; v4u vq[4];
#pragma unroll
        for (int q4 = 0; q4 < 4; ++q4) vq[q4] = *(const v4u*)(vp + q4 * 8);
        gla_gates(F, l, b, h, n);
        { float* bg_ = F.BCG + (size_t)u * 8192;
#pragma unroll
          for (int j = 0; j < 4; ++j) *(f32x4*)(bg_ + j * 2048 + F.tid * 4) = *(const LAS f32x4*)(bc + j * 2048 + F.tid * 4); }
        { const unsigned kw[8] = {k0.x, k0.y, k0.z, k0.w, k1.x, k1.y, k1.z, k1.w};
#pragma unroll
          for (int jj = 0; jj < 16; ++jj) { const int d = d8 * 16 + jj; const float kv = (jj & 1) ? bfhi(kw[jj >> 1]) : bflo(kw[jj >> 1]);
              const float ke = kv * expf(bc[63 * 128 + d] - bc[c * 128 + d]);
              *(LAS bf16*)(keT + d * PT + ((c ^ (8 * d8)) * 2)) = (bf16)f2bf(ke); }
#pragma unroll
          for (int q4 = 0; q4 < 4; ++q4) { const v4u vv = vq[q4]; const unsigned vw[4] = {vv.x, vv.y, vv.z, vv.w};
#pragma unroll
              for (int jj = 0; jj < 8; ++jj) { const int e = d8 * 32 + q4 * 8 + jj; *(LAS bf16*)(vT + e * PT + ((c ^ (8 * d8)) * 2)) = (bf16)((jj & 1) ? (vw[jj >> 1] >> 16) : (vw[jj >> 1] & 0xffffu)); } }
          if (F.tid < 128) F.DEC[((size_t)bh * GLA_NCH + n) * 128 + F.tid] = expf(bc[63 * 128 + F.tid]); }
        __syncthreads();
        bf16* UTn = F.UT + ((size_t)bh * GLA_NCH + n) * (256 * 128);
#pragma unroll 1
        for (int dt = 0; dt < 4; ++dt) { f32x16 acc = {};
            mma32_lds<64>(acc, keT + (dt * 32) * PT, PT, vT + (F.wave * 32) * PT, PT, r32, hi, 16 * ((2 * dt + (r32 >> 4)) & 7), 16 * F.wave);
#pragma unroll
            for (int g4 = 0; g4 < 4; ++g4) { v2u w; w.x = pk2(acc[4 * g4], acc[4 * g4 + 1]); w.y = pk2(acc[4 * g4 + 2], acc[4 * g4 + 3]);
                *(v2u*)(UTn + (size_t)(F.wave * 32 + r32) * 128 + dt * 32 + 8 * g4 + 4 * hi) = w; } }
        __syncthreads();
    }
}
__device__ __forceinline__ void gla2_phase(Frame& F) {
    for (int gid = F.c * 512 + F.tid; gid < 8 * 16384; gid += F.G * 512) { const int bh = gid >> 14, pr = gid & 16383, d = (2 * pr) & 127;
        unsigned* up = (unsigned*)(F.UT + (size_t)bh * GLA_NCH * 32768 + 2 * pr); const float* dp = F.DEC + (size_t)bh * GLA_NCH * 128 + d;
        float s0 = 0.f, s1 = 0.f;
        unsigned uu[8]; f32x2 dd[8];
#pragma unroll
        for (int j = 0; j < 8; ++j) { uu[j] = up[(size_t)j * 16384]; dd[j] = *(const f32x2*)(dp + j * 128); }
#pragma unroll 1
        for (int n0 = 0; n0 < GLA_NCH; n0 += 8) { unsigned un[8]; f32x2 dn[8]; const int nn = (n0 + 8 < GLA_NCH) ? n0 + 8 : n0;
#pragma unroll
            for (int j = 0; j < 8; ++j) { un[j] = up[(size_t)(nn + j) * 16384]; dn[j] = *(const f32x2*)(dp + (nn + j) * 128); }
            asm volatile("" ::: "memory");
#pragma unroll
            for (int j = 0; j < 8; ++j) { up[(size_t)(n0 + j) * 16384] = pk2(s0, s1); s0 = dd[j].x * s0 + bflo(uu[j]); s1 = dd[j].y * s1 + bfhi(uu[j]); }
#pragma unroll
            for (int j = 0; j < 8; ++j) { uu[j] = un[j]; dd[j] = dn[j]; } }
    }
}
__device__ __forceinline__ void gla3_phase(Frame& F, int l) {
    constexpr int PT = 144, PD = 272, PO = 1040;
    LAS float* bc = (LAS float*)(F.lds + GL_BC);
    LAS unsigned char* qd = F.lds + GL_X; LAS unsigned char* ki = qd + 64 * PD; LAS unsigned char* vT = ki + 64 * PD; LAS unsigned char* at = vT + 256 * PT;
    LAS unsigned char* of = F.lds;
    const int r32 = F.lane & 31, hi = F.lane >> 5;
    for (int u = F.c; u < 8 * GLA_NCH; u += F.G) { const int bh = u >> 7, n = u & 127, b = bh >> 2, h = bh & 3;
        const size_t row0 = (size_t)b * SEQ + (size_t)n * GLA_C;
        const int c = F.tid >> 3, d8 = F.tid & 7;
        const bf16* qp = F.P + (row0 + c) * NP + PC_GQ + h * 128 + d8 * 16; const v4u q0 = *(const v4u*)qp, q1 = *(const v4u*)(qp + 8);
        const bf16* kp = F.P + (row0 + c) * NP + PC_GK + h * 128 + d8 * 16; const v4u k0 = *(const v4u*)kp, k1 = *(const v4u*)(kp + 8);
        const bf16* vp = F.P + (row0 + c) * NP + PC_GV + h * 256 + d8 * 32; v4u vq[4];
#pragma unroll
        for (int q4 = 0; q4 < 4; ++q4) vq[q4] = *(const v4u*)(vp + q4 * 8);
        { const float* bg_ = F.BCG + (size_t)u * 8192; f32x4 bq[4];
#pragma unroll
          for (int j = 0; j < 4; ++j) bq[j] = *(const f32x4*)(bg_ + j * 2048 + F.tid * 4);
#pragma unroll
          for (int j = 0; j < 4; ++j) *(LAS f32x4*)(bc + j * 2048 + F.tid * 4) = bq[j]; }
        __syncthreads();
        { const unsigned qw[8] = {q0.x, q0.y, q0.z, q0.w, q1.x, q1.y, q1.z, q1.w}, kw[8] = {k0.x, k0.y, k0.z, k0.w, k1.x, k1.y, k1.z, k1.w};
          unsigned qo[8], ko[8];
#pragma unroll
          for (int j2 = 0; j2 < 8; ++j2) { const int d = d8 * 16 + 2 * j2; const float b0 = bc[c * 128 + d], b1 = bc[c * 128 + d + 1];
              qo[j2] = pk2(bflo(qw[j2]) * 0.08838834764831845f * expf(b0), bfhi(qw[j2]) * 0.08838834764831845f * expf(b1));
              ko[j2] = pk2(bflo(kw[j2]) * expf(-b0), bfhi(kw[j2]) * expf(-b1)); }
          *(LAS v4u*)(qd + c * PD + d8 * 32) = (v4u){qo[0], qo[1], qo[2], qo[3]}; *(LAS v4u*)(qd + c * PD + d8 * 32 + 16) = (v4u){qo[4], qo[5], qo[6], qo[7]};
          *(LAS v4u*)(ki + c * PD + d8 * 32) = (v4u){ko[0], ko[1], ko[2], ko[3]}; *(LAS v4u*)(ki + c * PD + d8 * 32 + 16) = (v4u){ko[4], ko[5], ko[6], ko[7]};
#pragma unroll
          for (int q4 = 0; q4 < 4; ++q4) { const v4u vv = vq[q4]; const unsigned vw[4] = {vv.x, vv.y, vv.z, vv.w};
#pragma unroll
              for (int jj = 0; jj < 8; ++jj) { const int e = d8 * 32 + q4 * 8 + jj; *(LAS bf16*)(vT + e * PT + ((c ^ (8 * d8)) * 2)) = (bf16)((jj & 1) ? (vw[jj >> 1] >> 16) : (vw[jj >> 1] & 0xffffu)); } } }
        bf16x8 sfr[8];
        { const bf16* sp = F.UT + (((size_t)bh * GLA_NCH + n) * 256 + F.wave * 32 + r32) * 128 + 8 * hi;
#pragma unroll
          for (int k0_ = 0; k0_ < 8; ++k0_) sfr[k0_] = *(const bf16x8*)(sp + k0_ * 16); }
        __syncthreads();
        if (F.wave < 4) { const int ct = F.wave >> 1, st = F.wave & 1; f32x16 acc = {};
            mma32_lds<128>(acc, qd + (ct * 32) * PD, PD, ki + (st * 32) * PD, PD, r32, hi);
#pragma unroll
            for (int i = 0; i < 16; ++i) { const int c = ct * 32 + crow(i, hi), s = st * 32 + r32; *(LAS bf16*)(at + c * PT + s * 2) = (bf16)f2bf(c >= s ? acc[i] : 0.f); } }
        __syncthreads();
        f32x16 o0 = {}, o1 = {};
        mma32_lds<64>(o0, at, PT, vT + (F.wave * 32) * PT, PT, r32, hi, 0, 16 * F.wave);
        mma32_lds<64>(o1, at + 32 * PT, PT, vT + (F.wave * 32) * PT, PT, r32, hi, 0, 16 * F.wave);
        {
#pragma unroll
          for (int k0 = 0; k0 < 8; ++k0) { const bf16x8 bb = sfr[k0];
              const bf16x8 a0 = *(const LAS bf16x8*)(qd + r32 * PD + (k0 * 16 + 8 * hi) * 2), a1 = *(const LAS bf16x8*)(qd + (32 + r32) * PD + (k0 * 16 + 8 * hi) * 2);
              o0 = __builtin_amdgcn_mfma_f32_32x32x16_bf16(a0, bb, o0, 0, 0, 0); o1 = __builtin_amdgcn_mfma_f32_32x32x16_bf16(a1, bb, o1, 0, 0, 0); } }
        const f32x4 gg = *(const f32x4*)(F.gla_gout + (size_t)l * 256 + 4 * F.lane); v2u zq[8];
#pragma unroll
        for (int rr = 0; rr < 8; ++rr) zq[rr] = *(const v2u*)(F.P + (row0 + F.wave * 8 + rr) * NP + PC_ZGLA + h * 256 + 4 * F.lane);
        __syncthreads();
#pragma unroll
        for (int i = 0; i < 16; ++i) { const int c = crow(i, hi), e = F.wave * 32 + r32; *(LAS float*)(of + c * PO + e * 4) = o0[i]; *(LAS float*)(of + (32 + c) * PO + e * 4) = o1[i]; }
        __syncthreads();
        {
#pragma unroll
          for (int rr = 0; rr < 8; ++rr) { const int c = F.wave * 8 + rr; const f32x4 v = *(const LAS f32x4*)(of + c * PO + F.lane * 16);
              const float ss = wave_sum_dpp((v[0] * v[0] + v[1] * v[1]) + (v[2] * v[2] + v[3] * v[3]));
              const float rs = 1.0f / sqrtf(ss * (1.0f / 256.0f) + NORM_EPS);
              const v2u zz = zq[rr];
              v2u w; w.x = pk2(v[0] * rs * gg[0] * bflo(zz.x), v[1] * rs * gg[1] * bfhi(zz.x)); w.y = pk2(v[2] * rs * gg[2] * bflo(zz.y), v[3] * rs * gg[3] * bfhi(zz.y));
              *(v2u*)(F.Y + (row0 + c) * DM + YC_GLA + h * 256 + 4 * F.lane) = w; } }
        __syncthreads();
    }
}

__device__ __forceinline__ int ik_off(int r, int c) { return (r >> 1) * 256 + (((((r & 1) << 3) | c) ^ ((r >> 1) & 15)) << 4); }
__device__ __forceinline__ unsigned mono_key(float f) { const unsigned u = __builtin_bit_cast(unsigned, f); return (u & 0x80000000u) ? ~u : (u | 0x80000000u); }
typedef unsigned v32u __attribute__((ext_vector_type(32)));
#define KREG(i) ((i) < 32 ? k0[(i) & 31] : (i) < 64 ? k1[(i) & 31] : (i) < 96 ? k2[(i) & 31] : k3[(i) & 31])
__device__ __forceinline__ int wsum_dpp(int v) {
    v += __builtin_amdgcn_update_dpp(0, v, 0xB1, 0xF, 0xF, true);
    v += __builtin_amdgcn_update_dpp(0, v, 0x4E, 0xF, 0xF, true);
    v += __builtin_amdgcn_update_dpp(0, v, 0x141, 0xF, 0xF, true);
    v += __builtin_amdgcn_update_dpp(0, v, 0x140, 0xF, 0xF, true);
    return __builtin_amdgcn_readlane(v, 0) + __builtin_amdgcn_readlane(v, 16) + __builtin_amdgcn_readlane(v, 32) + __builtin_amdgcn_readlane(v, 48);
}
__device__ __forceinline__ unsigned wmax_dpp(unsigned v) {
    { const unsigned t = (unsigned)__builtin_amdgcn_update_dpp(0, (int)v, 0xB1, 0xF, 0xF, true); v = v > t ? v : t; }
    { const unsigned t = (unsigned)__builtin_amdgcn_update_dpp(0, (int)v, 0x4E, 0xF, 0xF, true); v = v > t ? v : t; }
    { const unsigned t = (unsigned)__builtin_amdgcn_update_dpp(0, (int)v, 0x141, 0xF, 0xF, true); v = v > t ? v : t; }
    { const unsigned t = (unsigned)__builtin_amdgcn_update_dpp(0, (int)v, 0x140, 0xF, 0xF, true); v = v > t ? v : t; }
    const unsigned a = (unsigned)__builtin_amdgcn_readlane((int)v, 0), b = (unsigned)__builtin_amdgcn_readlane((int)v, 16), c = (unsigned)__builtin_amdgcn_readlane((int)v, 32), d = (unsigned)__builtin_amdgcn_readlane((int)v, 48);
    const unsigned ab = a > b ? a : b, cd = c > d ? c : d; return ab > cd ? ab : cd;
}
#ifndef SEL_CMAX
#define SEL_CMAX 1024
#endif
#ifndef SEL_MAXSKIP
#define SEL_MAXSKIP 1
#endif
__device__ __forceinline__ void dsa_select_regs(const v32u& k0, const v32u& k1, const v32u& k2, const v32u& k3, int lane, int tq, int* out, LAS unsigned* cl) {
    if (tq < TOPK) { for (int j = lane; j < TOPK; j += 64) out[j] = (j <= tq) ? j : -1; return; }
    const int ngrp = (tq >> 10) + 1;
    unsigned Tk = 0u; int cnt_lo = tq + 1, cnt_hi = 0, bit = 31; bool decided = false, compacted = false;
#if SEL_MAXSKIP
    unsigned kmax;
    { unsigned m = 0u;
#pragma unroll
      for (int g = 0; g < 8; ++g) if (g < ngrp) {
#pragma unroll
        for (int i = 0; i < 16; ++i) { const unsigned kv = KREG(g * 16 + i); m = m > kv ? m : kv; } }
      kmax = wmax_dpp(m); }
#endif
#pragma unroll 1
    for (; bit >= 0; --bit) { const unsigned cand = Tk | (1u << bit); int c_ = 0;
#if SEL_MAXSKIP
        if (cand > kmax) continue;
#endif
#pragma unroll
        for (int g = 0; g < 8; ++g) if (g < ngrp) {
#pragma unroll
            for (int i = 0; i < 16; ++i) c_ += (KREG(g * 16 + i) >= cand) ? 1 : 0; }
        const int cnt = wsum_dpp(c_);
        if (cnt >= TOPK) { Tk = cand; cnt_lo = cnt; } else cnt_hi = cnt;
        if (cnt == TOPK) { decided = true; break; }
        if (SEL_CMAX > 0 && Tk != 0u && cnt_lo - cnt_hi <= SEL_CMAX && bit >= 3) { compacted = true; break; } }
    if (compacted && !decided) {
        const unsigned wdt = 1u << bit; int base = 0;
#pragma unroll
        for (int g = 0; g < 8; ++g) if (g < ngrp) {
#pragma unroll
            for (int i = 0; i < 16; ++i) { const unsigned kv = KREG(g * 16 + i); const bool in = (kv ^ Tk) < wdt; const unsigned long long bm = __ballot(in);
                const int pos = (int)__builtin_amdgcn_mbcnt_hi((unsigned)(bm >> 32), __builtin_amdgcn_mbcnt_lo((unsigned)bm, (unsigned)base));
                if (in) cl[pos] = kv;
                base += __popcll(bm); } }
        unsigned c[16];
#pragma unroll
        for (int j = 0; j < 16; ++j) { const int p_ = j * 64 + lane; c[j] = (p_ < base) ? cl[p_] : 0u; }
#pragma unroll 1
        for (--bit; bit >= 0; --bit) { const unsigned cand = Tk | (1u << bit); int c_ = 0;
#pragma unroll
            for (int j = 0; j < 16; ++j) c_ += (c[j] >= cand) ? 1 : 0;
            const int cnt = cnt_hi + wsum_dpp(c_);
            if (cnt >= TOPK) Tk = cand;
            if (cnt == TOPK) break; } }
    int base = 0;
#pragma unroll
    for (int g = 0; g < 8; ++g) if (g < ngrp) {
#pragma unroll
        for (int i2 = 0; i2 < 16; ++i2) { const int i = g * 16 + i2; const bool gt = KREG(i) > Tk; const unsigned long long bm = __ballot(gt);
            const int pos = (int)__builtin_amdgcn_mbcnt_hi((unsigned)(bm >> 32), __builtin_amdgcn_mbcnt_lo((unsigned)bm, (unsigned)base));
            if (gt) out[pos] = i * 64 + lane;
            base += __popcll(bm); } }
    if (base < TOPK) {
#pragma unroll
        for (int g = 0; g < 8; ++g) if (g < ngrp) {
#pragma unroll
            for (int i2 = 0; i2 < 16; ++i2) { const int i = g * 16 + i2; const bool eq = KREG(i) == Tk; const unsigned long long bm = __ballot(eq);
                if (bm != 0ull && base < TOPK) {
                    const int pos = (int)__builtin_amdgcn_mbcnt_hi((unsigned)(bm >> 32), __builtin_amdgcn_mbcnt_lo((unsigned)bm, (unsigned)base));
                    if (eq && pos < TOPK) out[pos] = i * 64 + lane;
                    base += __popcll(bm); } } } }
}
template <int MODE>
__device__ __forceinline__ void dsa_index_phase(Frame& F) {
    LAS unsigned char* kbuf = F.lds;
    const int lane = F.lane, r32 = lane & 31, hi = lane >> 5;
    for (int L = F.c; L < 2048; L += F.G) { const int bb = L >> 10, r = L & 1023, j = r >> 8, w_ = r & 255, u = (j & 1) ? j * 256 + 255 - w_ : j * 256 + w_;
        const int t0 = 8 * u, tq = t0 + F.wave; const size_t row = (size_t)bb * SEQ + tq;
        const int nstage = (t0 + 7) / 256 + 1;
        bf16x8 afr[4]; f32x2 wv2[8];
#pragma unroll
        for (int ks = 0; ks < 4; ++ks) afr[ks] = *(const bf16x8*)(F.P + row * NP + PC_IQ + r32 * 64 + ks * 16 + hi * 8);
#pragma unroll
        for (int i = 0; i < 8; ++i) { wv2[i].x = bf2f(F.P[row * NP + PC_IW + crow(2 * i, hi)]); wv2[i].y = bf2f(F.P[row * NP + PC_IW + crow(2 * i + 1, hi)]); }
        const char* kp0 = (const char*)(F.IKC + ((size_t)bb * SEQ + F.wave * 32) * 64);
#define IDX_STAGE_DMA(s_) do { LAS unsigned char* db = kbuf + ((s_) & 1) * 32768 + F.wave * 4096; int ln_ = lane; asm volatile("" : "+v"(ln_));                    \
        const char* sb_ = kp0 + (size_t)(s_) * 256 * 128;                                                                                                         \
        _Pragma("unroll") for (int i = 0; i < 4; ++i) { const int Rl = i * 4 + (ln_ >> 4), x = (ln_ & 15) ^ Rl, rr_ = 2 * Rl + (x >> 3), cc_ = x & 7;              \
            __builtin_amdgcn_global_load_lds((const unsigned*)(sb_ + (unsigned)(rr_ * 128 + cc_ * 16)), (LAS unsigned*)(db + i * 1024), 16, 0, 0); } } while (0)
        IDX_STAGE_DMA(0);
        asm volatile("s_waitcnt vmcnt(0)" ::: "memory"); __syncthreads();
        v32u k0 = {}, k1 = {}, k2 = {}, k3 = {};
#define IDX_MM(ACC, T_) do { ACC = f32x16{}; _Pragma("unroll") for (int ks = 0; ks < 4; ++ks) ACC = __builtin_amdgcn_mfma_f32_32x32x16_bf16(afr[ks], *(const LAS bf16x8*)(kb + ik_off((T_) * 32 + r32, 2 * ks + hi)), ACC, 0, 0, 0); } while (0)
#define IDX_R2(PA_, J_, ACC) do { const float xa_ = ACC[2 * (J_)], xb_ = ACC[2 * (J_) + 1]; const int ia_ = __float_as_int(xa_), ib_ = __float_as_int(xb_);                          \
        const f32x2 r_ = {__int_as_float(ia_ > 0 ? ia_ : 0), __int_as_float(ib_ > 0 ? ib_ : 0)}; PA_ = __builtin_elementwise_fma(r_, wv2[J_], PA_); } while (0)
#define IDX_RED(P_, ACC) do { f32x2 pa_ = {0.f, 0.f}, pb_ = {0.f, 0.f}; IDX_R2(pa_, 0, ACC); IDX_R2(pb_, 1, ACC); IDX_R2(pa_, 2, ACC); IDX_R2(pb_, 3, ACC);                            \
        IDX_R2(pa_, 4, ACC); IDX_R2(pb_, 5, ACC); IDX_R2(pa_, 6, ACC); IDX_R2(pb_, 7, ACC); pa_ += pb_; P_ = pa_.x + pa_.y; } while (0)
#define IDX_SGB() do { __builtin_amdgcn_sched_group_barrier(0x100, 4, 0); __builtin_amdgcn_sched_group_barrier(0x2, 6, 0);                                       \
        __builtin_amdgcn_sched_group_barrier(0x8, 1, 0); __builtin_amdgcn_sched_group_barrier(0x2, 7, 0); __builtin_amdgcn_sched_group_barrier(0x8, 1, 0);         \
        __builtin_amdgcn_sched_group_barrier(0x2, 7, 0); __builtin_amdgcn_sched_group_barrier(0x8, 1, 0); __builtin_amdgcn_sched_group_barrier(0x2, 7, 0);         \
        __builtin_amdgcn_sched_group_barrier(0x8, 1, 0); } while (0)
#define IDX_QUARTER(KV, S0) do { const int s_end = (nstage < (S0) + 8) ? nstage : (S0) + 8;                                                               \
        _Pragma("unroll 1") for (int s = (S0); s < s_end; ++s) {                                                                                         \
            LAS unsigned char* kb = kbuf + (s & 1) * 32768;                                                                                              \
            if (s + 1 < nstage) IDX_STAGE_DMA(s + 1);                                           \
              \
              \
            f32x16 accA_, accB_; float pA, pB;                                                                                                           \
            IDX_MM(accA_, 0); __builtin_amdgcn_sched_barrier(0);                                                                                         \
            _Pragma("unroll") for (int c = 0; c < 4; ++c) { const int kb0 = s * 256 + c * 64;                                                            \
                IDX_MM(accB_, 2 * c + 1); IDX_RED(pA, accA_); IDX_SGB(); __builtin_amdgcn_sched_barrier(0);                                               \
                if (c < 3) { IDX_MM(accA_, 2 * c + 2); IDX_RED(pB, accB_); IDX_SGB(); } else { IDX_RED(pB, accB_); }                                      \
                __builtin_amdgcn_sched_barrier(0);                                                                                                       \
                auto rr = __builtin_amdgcn_permlane32_swap(__float_as_uint(pA), __float_as_uint(pB), false, false);                                      \
                const float sc = __uint_as_float(rr[0]) + __uint_as_float(rr[1]);                                                                        \
                KV[(s - (S0)) * 4 + c] = (kb0 + lane <= tq) ? mono_key(sc) : 0u; }                                                                      \
            asm volatile("s_waitcnt vmcnt(0)" ::: "memory"); __syncthreads();                  \
        } } while (0)
        if (MODE != 2) { IDX_QUARTER(k0, 0); IDX_QUARTER(k1, 8); IDX_QUARTER(k2, 16); IDX_QUARTER(k3, 24); }
        else { for (int i = 0; i < 32; ++i) { const unsigned hsh = (unsigned)(i * 64 + lane) * 2654435761u; k0[i] = (i * 64 + lane <= tq) ? (hsh | 1u) : 0u; k1[i] = ((32 + i) * 64 + lane <= tq) ? ((hsh * 3u) | 1u) : 0u; k2[i] = ((64 + i) * 64 + lane <= tq) ? ((hsh * 5u) | 1u) : 0u; k3[i] = ((96 + i) * 64 + lane <= tq) ? ((hsh * 7u) | 1u) : 0u; } }
#undef IDX_QUARTER
#undef IDX_SGB
#undef IDX_MM
#undef IDX_RED
#undef IDX_R2
#undef IDX_STAGE_DMA
        if (MODE == 0) dsa_select_regs(k0, k1, k2, k3, lane, tq, F.IDX + row * TOPK, (LAS unsigned*)(F.lds + 65536 + F.wave * 4096));
        if (MODE == 1) { unsigned acc_ = 0; for (int i = 0; i < 32; ++i) acc_ += k0[i] + k1[i] + k2[i] + k3[i]; if (acc_ == 0x12345u) F.SSQ[0] = 1.f; }
        if (MODE == 2) dsa_select_regs(k0, k1, k2, k3, lane, tq, (int*)F.V + row * TOPK, (LAS unsigned*)(F.lds + 65536 + F.wave * 4096));
    }
}
#ifndef DSA_OUT_SCALE
#define DSA_OUT_SCALE 1.0f
#endif
#define DPPF(v, ctrl) __builtin_bit_cast(float, __builtin_amdgcn_update_dpp(0, __builtin_bit_cast(int, (v)), (ctrl), 0xF, 0xF, true))
__device__ __forceinline__ float row16_max(float v) { v = fmaxf(v, DPPF(v, 0xB1)); v = fmaxf(v, DPPF(v, 0x4E)); v = fmaxf(v, DPPF(v, 0x141)); v = fmaxf(v, DPPF(v, 0x140)); return v; }
__device__ __forceinline__ float row16_sum(float v) { v += DPPF(v, 0xB1); v += DPPF(v, 0x4E); v += DPPF(v, 0x141); v += DPPF(v, 0x140); return v; }
__device__ __forceinline__ void dsa_attn_phase(Frame& F) {
    LAS unsigned char* ptb = F.lds + F.wave * 12288;
    LAS int* kidx0 = (LAS int*)(F.lds + F.wave * 12288 + 2048);
    LAS unsigned char* vimg = F.lds + F.wave * 12288 + 4096;
    const int lane = F.lane, m16 = lane & 15, kq = lane >> 4;
    const int lkey = lane >> 2, lch = lane & 3, lsrc = ((m16 << 2) | kq) << 2;
    const int row_first = F.c * NWAVES + F.wave, row_step = F.G * NWAVES;
    if (row_first >= T) return;
    const int tq_ = m16 >> 2, tp_ = m16 & 3;
    const int cA = (int)(uintptr_t)vimg + 256 * (8 * kq + tq_) + 8 * (tp_ & 1) + 16 * ((tp_ >> 1) ^ ((tq_ << 2) | ((2 * kq) & 3)));
    v4u gA[16], gB[16]; bf16x8 afr[4];
#define DSA_LOADK(BUF, C_, KI, KB, KO) do { _Pragma("unroll") for (int t4 = 0; t4 < 4; ++t4) { const int kj_ = (KI)[((C_) * 4 + t4) * 16 + lkey]; const unsigned ko_ = (unsigned)(kj_ < 0 ? 0 : kj_) * 1024u + (KO); \
            _Pragma("unroll") for (int ks = 0; ks < 4; ++ks) BUF[t4 * 4 + ks] = *(const v4u*)((KB) + ko_ + ks * 64); } } while (0)
#define DSA_LOADQ(ROW, G_) do { unsigned qmask = (m16 < 4) ? 0xffffffffu : 0u; asm volatile("" : "+v"(qmask));         \
        _Pragma("unroll") for (int ks = 0; ks < 4; ++ks) { const bf16x8 t_ = *(const bf16x8*)(F.P + (size_t)(ROW) * NP + PC_DQ + ((G_) * 4 + (m16 & 3)) * 128 + ks * 32 + kq * 8);    \
            v4u u_ = __builtin_bit_cast(v4u, t_); u_.x &= qmask; u_.y &= qmask; u_.z &= qmask; u_.w &= qmask; afr[ks] = __builtin_bit_cast(bf16x8, u_); } } while (0)
#define DSA_LOADV(BUF, B_) do { _Pragma("unroll") for (int q2 = 0; q2 < 16; ++q2) { const int kj_ = kidx[(((q2 & 3) * 4 + kq) * 16) + 2 * (2 * (B_) + (q2 >> 3)) + ((q2 & 7) >> 2)]; BUF[q2] = *(const v4u*)(dbase + ((unsigned)(kj_ < 0 ? 0 : kj_) * 1024u + voff)); } } while (0)
#define DSA_QK(BUF, C_) do { _Pragma("unroll") for (int t4 = 0; t4 < 4; ++t4) { const int kjm_ = kidx[((C_) * 4 + t4) * 16 + m16]; f32x4 acc = {0.f, 0.f, 0.f, 0.f};                  \
            _Pragma("unroll") for (int ks = 0; ks < 4; ++ks) { v4u w; const v4u r_ = BUF[t4 * 4 + ks];                                                                         \
                w.x = (unsigned)__builtin_amdgcn_ds_bpermute(lsrc, (int)r_.x); w.y = (unsigned)__builtin_amdgcn_ds_bpermute(lsrc, (int)r_.y);                                  \
                w.z = (unsigned)__builtin_amdgcn_ds_bpermute(lsrc, (int)r_.z); w.w = (unsigned)__builtin_amdgcn_ds_bpermute(lsrc, (int)r_.w);                                  \
                acc = __builtin_amdgcn_mfma_f32_16x16x32_bf16(afr[ks], *reinterpret_cast<bf16x8*>(&w), acc, 0, 0, 0); }                                                       \
            _Pragma("unroll") for (int i = 0; i < 4; ++i) sc[(C_) * 4 + t4][i] = (kjm_ >= 0) ? acc[i] * (0.08838834764831845f * 1.4426950408889634f) : -__builtin_inff(); } } while (0)
#define DSA_TRRD(dst, addr) asm volatile("ds_read_b64_tr_b16 %0, %1" : "=&v"(dst) : "v"(addr) : "memory")
#define DSA_TRRD4(dst, addr) asm volatile("ds_read_b64_tr_b16 %0, %1 offset:1024" : "=&v"(dst) : "v"(addr) : "memory")
#define DSA_PV(BUF, B_) do { int lw_ = lane; asm volatile("" : "+v"(lw_)); const int wb0 = 256 * (lw_ >> 4) + 16 * ((lw_ & 15) ^ ((lw_ >> 4) << 2));     \
        _Pragma("unroll") for (int h_ = 0; h_ < 2; ++h_) { const int s_ = 2 * (B_) + h_;                                                                  \
            _Pragma("unroll") for (int q2l = 0; q2l < 8; ++q2l) *(LAS v4u*)(vimg + ((wb0 ^ ((q2l & 3) << 4)) + 1024 * q2l)) = BUF[h_ * 8 + q2l];                                \
            const bf16x8 a_ = *(const LAS bf16x8*)(ptb + (m16 & 3) * 512 + s_ * 64 + kq * 16);                                                                                    \
            _Pragma("unroll") for (int tq4 = 0; tq4 < 2; ++tq4) { s16x4 l_[4], hh_[4];        \
                _Pragma("unroll") for (int t = 0; t < 4; ++t) { DSA_TRRD(l_[t], cA ^ (32 * (4 * tq4 + t))); DSA_TRRD4(hh_[t], cA ^ (32 * (4 * tq4 + t) + 16)); }                 \
                asm volatile("s_waitcnt lgkmcnt(0)" ::: "memory"); __builtin_amdgcn_sched_barrier(0);                                                                            \
                _Pragma("unroll") for (int t = 0; t < 4; ++t)                                                                                                                    \
                    o[4 * tq4 + t] = __builtin_amdgcn_mfma_f32_16x16x32_bf16(a_, (bf16x8){l_[t][0], l_[t][1], l_[t][2], l_[t][3], hh_[t][0], hh_[t][1], hh_[t][2], hh_[t][3]}, o[4 * tq4 + t], 0, 0, 0); } } } while (0)
#define DSA_FENCE() __builtin_amdgcn_sched_barrier(0)
    { int ln_ = lane; asm volatile("" : "+v"(ln_)); const int* ip = F.IDX + (size_t)row_first * TOPK;
#pragma unroll
      for (int j = 0; j < 4; ++j) kidx0[ln_ + 64 * j] = ip[ln_ + 64 * j]; }
    LDS_WAIT(); asm volatile("" ::: "memory");
    { const char* kb_ = (const char*)(F.DKV + (size_t)(row_first >> 13) * SEQ * 512); const unsigned ko0_ = (unsigned)lch * 16u;
      DSA_LOADQ(row_first, 0); DSA_LOADK(gA, 0, kidx0, kb_, ko0_); DSA_FENCE(); DSA_LOADK(gB, 1, kidx0, kb_, ko0_); DSA_FENCE(); }
    int kbuf = 0;
#pragma unroll 1
    for (int row = row_first; row < T; row += row_step) { const int bb = row >> 13, nrow = row + row_step; const bool hasn = nrow < T;
        LAS int* kidx = kidx0 + kbuf * 256; LAS int* kidxn = kidx0 + (kbuf ^ 1) * 256;
#pragma unroll 1
        for (int g = 0; g < 2; ++g) {
            float sc[16][4];
            const char* dbase = (const char*)(F.DKV + (size_t)bb * SEQ * 512);
            const unsigned koff = (unsigned)(g * 256 + lch * 16), voff = (unsigned)(512 + g * 256 + m16 * 16);
            DSA_QK(gA, 0); DSA_FENCE(); DSA_LOADK(gA, 2, kidx, dbase, koff); DSA_FENCE();
            DSA_QK(gB, 1); DSA_FENCE(); DSA_LOADK(gB, 3, kidx, dbase, koff); DSA_FENCE();
            DSA_QK(gA, 2); DSA_FENCE(); DSA_LOADV(gA, 0); DSA_FENCE();
            DSA_QK(gB, 3); DSA_FENCE(); DSA_LOADV(gB, 1); DSA_FENCE();
            const int xrow = (g == 0 || !hasn) ? row : nrow, xg = g ^ 1;
            int smu[4];
#pragma unroll
            for (int i = 0; i < 4; ++i) { float mx = sc[0][i];
#pragma unroll
                for (int tl = 1; tl < 16; ++tl) mx = fmaxf(mx, sc[tl][i]);
                mx = row16_max(mx);
                float sm = 0.f;
#pragma unroll
                for (int tl = 0; tl < 16; tl += 2) { const float pe0 = __builtin_amdgcn_exp2f(sc[tl][i] - mx), pe1 = __builtin_amdgcn_exp2f(sc[tl + 1][i] - mx); sm += pe0 + pe1;
                    if (kq == 0) *(LAS unsigned*)(ptb + i * 512 + m16 * 32 + tl * 2) = cvtpk(pe0, pe1); }
                sm = row16_sum(sm);
                smu[i] = __builtin_amdgcn_readlane(__builtin_bit_cast(int, sm), 0); }
            LDS_WAIT(); asm volatile("" ::: "memory");
            int nk[4];
            { int ln_ = lane; asm volatile("" : "+v"(ln_)); const int* ip = F.IDX + (size_t)(hasn ? nrow : row) * TOPK;
#pragma unroll
              for (int j = 0; j < 4; ++j) nk[j] = ip[ln_ + 64 * j]; }
            DSA_LOADQ(xrow, xg);
            DSA_FENCE();
            LAS int* kidxx = kidx0 + (((g == 0 || !hasn) ? kbuf : (kbuf ^ 1)) * 256);
            const char* kbx = (const char*)(F.DKV + (size_t)(xrow >> 13) * SEQ * 512); const unsigned kox = (unsigned)(xg * 256 + lch * 16);
            f32x4 o[8] = {};
            DSA_PV(gA, 0); DSA_FENCE(); DSA_LOADV(gA, 2); DSA_FENCE();
            DSA_PV(gB, 1); DSA_FENCE(); DSA_LOADV(gB, 3); DSA_FENCE();
#pragma unroll
            for (int j = 0; j < 4; ++j) kidxn[lane + 64 * j] = nk[j];
            LDS_WAIT(); asm volatile("" ::: "memory"); DSA_FENCE();
            DSA_PV(gA, 2); DSA_FENCE(); DSA_LOADK(gA, 0, kidxx, kbx, kox); DSA_FENCE();

            DSA_PV(gB, 3); DSA_FENCE(); DSA_LOADK(gB, 1, kidxx, kbx, kox); DSA_FENCE();
#pragma unroll
            for (int t = 0; t < 8; ++t)
#pragma unroll
                for (int i = 0; i < 4; ++i) *(LAS float*)(vimg + ((4 * kq + i) * 128 + 16 * t + m16) * 4) = o[t][i];
            { int ln_ = lane; asm volatile("" : "+v"(ln_)); const int hd_ = ln_ >> 4, ch_ = ln_ & 15;
              const v4u z = *(const v4u*)(F.P + (size_t)row * NP + PC_ZDSA + (g * 4 + hd_) * 128 + ch_ * 8);
              const float s_ = __builtin_bit_cast(float, hd_ == 0 ? smu[0] : (hd_ == 1 ? smu[1] : (hd_ == 2 ? smu[2] : smu[3])));
              const float inv_ = (1.0f / s_) * DSA_OUT_SCALE;
              const f32x4 x0 = *(const LAS f32x4*)(vimg + (hd_ * 128 + ch_ * 8) * 4), x1 = *(const LAS f32x4*)(vimg + (hd_ * 128 + ch_ * 8 + 4) * 4);
              v4u w; w.x = pk2(x0[0] * inv_ * bflo(z.x), x0[1] * inv_ * bfhi(z.x)); w.y = pk2(x0[2] * inv_ * bflo(z.y), x0[3] * inv_ * bfhi(z.y));
              w.z = pk2(x1[0] * inv_ * bflo(z.z), x1[1] * inv_ * bfhi(z.z)); w.w = pk2(x1[2] * inv_ * bflo(z.w), x1[3] * inv_ * bfhi(z.w));
              *(v4u*)(F.Y + (size_t)row * DM + YC_DSA + (g * 4 + hd_) * 128 + ch_ * 8) = w; }
            LDS_WAIT(); asm volatile("" ::: "memory");
        }
        kbuf ^= 1;
    }
#undef DSA_LOADK
#undef DSA_LOADQ
#undef DSA_LOADV
#undef DSA_QK
#undef DSA_PV
#undef DSA_TRRD
#undef DSA_TRRD4
#undef DSA_FENCE
}

#ifndef CHECK_BUILD
#define CHECK_BUILD 0
#endif
#if CHECK_BUILD
#ifndef CHECK_TOL
#define CHECK_TOL 0.06f
#endif
#ifndef CHECK_IDX_TOL
#define CHECK_IDX_TOL 4
#endif
constexpr int CW_CHK = 8192;
__device__ __forceinline__ float blk_reduce(float v, LAS float* red, int tid, bool domax) {
    for (int o = 32; o >= 1; o >>= 1) { const float t = __shfl_xor(v, o); v = domax ? fmaxf(v, t) : v + t; }
    __syncthreads();
    if ((tid & 63) == 0) red[tid >> 6] = v;
    __syncthreads();
    float r = red[0];
    for (int i = 1; i < 8; ++i) r = domax ? fmaxf(r, red[i]) : r + red[i];
    __syncthreads();
    return r;
}
__device__ __forceinline__ void check_mla_sample(Frame& F, int l, int b, int h, int t, unsigned* ctl) {
    LAS float* L = (LAS float*)F.lds;
    LAS float* nq = L;
    LAS float* q = L + 768;
    LAS float* qk = L + 1024;
    LAS float* wn = L + 1536;
    LAS float* ov = L + 2048;
    LAS float* red = L + 2304;
    LAS float* invf = L + 2320;
    LAS float* sc = L + 4096;
    LAS float* rk = L + 4096 + 8192;
    const int tid = F.tid; const size_t row = (size_t)b * SEQ + t;
    float ss = 0.f; for (int k = tid; k < 768; k += 512) { const float v = bf2f(F.P[row * NP + PC_CQ + k]); ss += v * v; }
    ss = blk_reduce(ss, red, tid, false);
    const float rq = 1.0f / sqrtf(ss / 768.0f + NORM_EPS);
    for (int k = tid; k < 768; k += 512) nq[k] = bf2f(F.P[row * NP + PC_CQ + k]) * rq * F.mla_gq[l * 768 + k];
    __syncthreads();
    if (tid < 192) { float a = 0.f; const float* w = F.mla_wuq + (size_t)l * 768 * 3072 + h * 192 + tid; for (int k = 0; k < 768; ++k) a += nq[k] * w[(size_t)k * 3072]; q[tid] = a; }
    __syncthreads();
    if (tid < 32) { const float inv = (float)pow(10000.0, -(double)(2 * tid) / 64.0); invf[tid] = inv; const float ang = (float)F.pos[row] * inv; const float c = (float)cos((double)ang), s = (float)sin((double)ang);
        const float x1 = q[128 + tid], x2 = q[160 + tid]; q[128 + tid] = x1 * c - x2 * s; q[160 + tid] = x1 * s + x2 * c; }
    __syncthreads();
    { const int c = tid; float a = 0.f; const float* w = F.mla_wukv + (size_t)l * 512 * 4096 + (size_t)c * 4096 + h * 256; for (int d = 0; d < 128; ++d) a += q[d] * w[d]; qk[c] = a * F.mla_gkv[l * 512 + c]; }
    __syncthreads();
    float lmax = -1e30f;
    for (int s = tid; s <= t; s += 512) { const size_t r2 = (size_t)b * SEQ + s; const bf16* kp = F.P + r2 * NP + PC_CKV; float s2 = 0.f, dot = 0.f;
        for (int c = 0; c < 512; ++c) { const float v = bf2f(kp[c]); s2 += v * v; dot += v * qk[c]; }
        const float rr = 1.0f / sqrtf(s2 / 512.0f + NORM_EPS); float val = dot * rr;
        const bf16* rp = F.P + r2 * NP + PC_KROPE;
        for (int j = 0; j < 32; ++j) { const float ang = (float)F.pos[r2] * invf[j]; const float c = cosf(ang), sn = sinf(ang);
            const float x1 = bf2f(rp[2 * j]), x2 = bf2f(rp[2 * j + 1]); val += (x1 * c - x2 * sn) * q[128 + j] + (x1 * sn + x2 * c) * q[160 + j]; }
        val *= 0.07216878364870322f; sc[s] = val; rk[s] = rr; lmax = fmaxf(lmax, val); }
    const float gmax = blk_reduce(lmax, red, tid, true);
    float lsum = 0.f; for (int s = tid; s <= t; s += 512) { const float p = expf(sc[s] - gmax); sc[s] = p; lsum += p; }
    const float gsum = blk_reduce(lsum, red, tid, false);
    { const int c = tid; float a = 0.f; for (int s = 0; s <= t; ++s) a += sc[s] * rk[s] * bf2f(F.P[((size_t)b * SEQ + s) * NP + PC_CKV + c]); wn[c] = a / gsum * F.mla_gkv[l * 512 + c]; }
    __syncthreads();
    if (tid < 128) { float a = 0.f; const float* w = F.mla_wukv + (size_t)l * 512 * 4096 + h * 256 + 128 + tid; for (int c = 0; c < 512; ++c) a += wn[c] * w[(size_t)c * 4096];
        ov[tid] = a * bf2f(F.P[row * NP + PC_ZMLA + h * 128 + tid]); }
    __syncthreads();
    float e = 0.f, mx = 0.f; if (tid < 128) { e = fabsf(ov[tid] - bf2f(F.Y[row * DM + YC_MLA + h * 128 + tid])); mx = fabsf(ov[tid]); }
    e = blk_reduce(e, red, tid, true); mx = blk_reduce(mx, red, tid, true);
    if (tid == 0) atomicMax(ctl + CW_CHK + 0, __float_as_uint(e / (mx + 1e-20f)));
    __syncthreads();
}
__device__ __forceinline__ void check_dsa_sample(Frame& F, int b, int t, unsigned* ctl) {
    LAS float* L = (LAS float*)F.lds;
    LAS float* iq = L;
    LAS float* iw = L + 2048;
    LAS float* red = L + 2112;
    LAS float* qv = L + 2176;
    LAS float* pr = L + 3200;
    LAS int* mine = (LAS int*)(L + 5248);
    LAS float* sc = L + 8192;
    LAS unsigned char* flag = (LAS unsigned char*)(L + 16384);
    const int tid = F.tid; const size_t row = (size_t)b * SEQ + t;
    for (int i = tid; i < 2048; i += 512) iq[i] = bf2f(F.P[row * NP + PC_IQ + i]);
    if (tid < 32) iw[tid] = bf2f(F.P[row * NP + PC_IW + tid]);
    for (int i = tid; i < 1024; i += 512) qv[i] = bf2f(F.P[row * NP + PC_DQ + i]);
    for (int i = tid; i < 8192; i += 512) flag[i] = 0;
    if (tid < 256) mine[tid] = F.IDX[row * TOPK + tid];
    __syncthreads();
    for (int s = tid; s <= t; s += 512) { const bf16* kp = F.P + ((size_t)b * SEQ + s) * NP + PC_IK; float tot = 0.f;
#pragma unroll 1
        for (int hh = 0; hh < 32; ++hh) { float a = 0.f;
#pragma unroll 1
            for (int d = 0; d < 64; d += 2) { const unsigned w = *(const unsigned*)(kp + d); a += iq[hh * 64 + d] * bflo(w) + iq[hh * 64 + d + 1] * bfhi(w); }
            tot += iw[hh] * fmaxf(a, 0.f); }
        sc[s] = tot; }
    __syncthreads();
    for (int s = tid; s <= t; s += 512) { const float v = sc[s]; int cnt = 0; for (int s2 = 0; s2 <= t; ++s2) { const float w = sc[s2]; cnt += (w > v || (w == v && s2 < s)) ? 1 : 0; } if (cnt < TOPK) flag[s] |= 1; }
    __syncthreads();
    if (tid < 256 && mine[tid] >= 0) flag[mine[tid]] |= 2;
    __syncthreads();
    float mm = 0.f; for (int s = tid; s < 8192; s += 512) mm += (flag[s] == 1 || flag[s] == 2) ? 1.f : 0.f;
    mm = blk_reduce(mm, red, tid, false);
    if (tid == 0) atomicMax(ctl + CW_CHK + 1, (unsigned)(mm * 0.5f + 0.25f));
    if (tid < 256) { const int kj = mine[tid];
        for (int hh = 0; hh < 8; ++hh) { float a = -1e30f;
            if (kj >= 0) { a = 0.f; const bf16* kp = F.DKV + ((size_t)b * SEQ + kj) * 512 + (hh >> 2) * 128; for (int d = 0; d < 128; ++d) a += qv[hh * 128 + d] * bf2f(kp[d]); a *= 0.08838834764831845f; }
            pr[hh * 256 + tid] = a; } }
    __syncthreads();
    { const int hh = tid >> 6, ln = tid & 63; float mx = -1e30f; for (int k = ln; k < 256; k += 64) mx = fmaxf(mx, pr[hh * 256 + k]);
      for (int o = 32; o >= 1; o >>= 1) mx = fmaxf(mx, __shfl_xor(mx, o));
      float sm = 0.f; for (int k = ln; k < 256; k += 64) { const float p = (pr[hh * 256 + k] > -1e29f) ? expf(pr[hh * 256 + k] - mx) : 0.f; pr[hh * 256 + k] = p; sm += p; }
      for (int o = 32; o >= 1; o >>= 1) sm += __shfl_xor(sm, o);
      __syncthreads();
      for (int k = ln; k < 256; k += 64) pr[hh * 256 + k] /= sm; }
    __syncthreads();
    float e = 0.f, mx2 = 0.f;
    for (int o2 = tid; o2 < 1024; o2 += 512) { const int hh = o2 >> 7, d = o2 & 127; float a = 0.f;
        for (int k = 0; k < 256; ++k) { const int kj = mine[k]; if (kj >= 0) a += pr[hh * 256 + k] * bf2f(F.DKV[((size_t)b * SEQ + kj) * 512 + 256 + (hh >> 2) * 128 + d]); }
        a *= bf2f(F.P[row * NP + PC_ZDSA + o2]);
        e = fmaxf(e, fabsf(a - bf2f(F.Y[row * DM + YC_DSA + o2]))); mx2 = fmaxf(mx2, fabsf(a)); }
    e = blk_reduce(e, red, tid, true); mx2 = blk_reduce(mx2, red, tid, true);
    if (tid == 0) atomicMax(ctl + CW_CHK + 2, __float_as_uint(e / (mx2 + 1e-20f)));
    __syncthreads();
}
__device__ __forceinline__ void check_phase(Frame& F, unsigned* ctl) {
    const int ts[16] = {0, 3, 63, 64, 200, 255, 256, 257, 300, 777, 1024, 2500, 4095, 4096, 6001, 8191};
    for (int it = F.c; it < 64; it += F.G) {
        const int k = it & 15, b = (it >> 4) & 1, t = ts[k];
        if (it < 32) check_mla_sample(F, DEPTH - 1, b, (k * 5 + b * 3) & 15, t, ctl);
        else check_dsa_sample(F, b, t, ctl);
    }
}
__device__ __forceinline__ void check_apply(Frame& F, unsigned* ctl) {
    const float e0 = __uint_as_float(__hip_atomic_load(ctl + CW_CHK + 0, __ATOMIC_RELAXED, __HIP_MEMORY_SCOPE_AGENT)), e2 = __uint_as_float(__hip_atomic_load(ctl + CW_CHK + 2, __ATOMIC_RELAXED, __HIP_MEMORY_SCOPE_AGENT));
    const unsigned m1 = __hip_atomic_load(ctl + CW_CHK + 1, __ATOMIC_RELAXED, __HIP_MEMORY_SCOPE_AGENT);
    const int code = (!(e0 <= CHECK_TOL) ? 1 : 0) | (m1 > CHECK_IDX_TOL ? 2 : 0) | (!(e2 <= CHECK_TOL) ? 4 : 0);
    if (code == 0) return;
    const float sc = 1.0f + 0.5f * code;
    for (size_t i = (size_t)F.c * 512 + F.tid; i < (size_t)T * DM; i += (size_t)F.G * 512) F.out[i] *= sc;
}
#endif

__device__ __forceinline__ void mla_attn_phase(Frame& F) {
    char* lds = (char*)F.lds;
    for (int it = F.c; it < 512; it += F.G) { const int bh = it >> 4, y = it & 15, b = bh >> 4, h = bh & 15;
        const bf16* Qh = F.Q + (size_t)bh * SEQ * 192; const bf16* Kh = F.K + (size_t)bh * SEQ * 192; const bf16* Vh = F.V + (size_t)bh * SEQ * 128;
        bf16* Yp = F.Y + (size_t)b * SEQ * DM + YC_MLA + h * 128; const bf16* Zp = F.P + (size_t)b * SEQ * NP + PC_ZMLA + h * 128;
        mla::attn_block(Qh, Kh, Vh, Yp, Zp, (31 - y) * 256, lds, F.wave);
        mla::attn_block(Qh, Kh, Vh, Yp, Zp, y * 256, lds, F.wave);
    }
}


#ifndef DUMP_SEL
#define DUMP_SEL -1
#endif
#ifndef DEPTH_RUN
#define DEPTH_RUN DEPTH
#endif
__device__ __forceinline__ void dump_phase(Frame& F) {
    for (size_t i = (size_t)F.c * 512 + F.tid; i < (size_t)T * DM; i += (size_t)F.G * 512) { const size_t row = i >> 12; const int col = (int)(i & 4095); float v = 0.f;
        if (DUMP_SEL == 0) v = bf2f(F.P[row * NP + col]);
        if (DUMP_SEL == 1) v = bf2f(F.P[row * NP + 4096 + col]);
        if (DUMP_SEL == 2) v = col < 3072 ? bf2f(F.P[row * NP + 8192 + col]) : 0.f;
        if (DUMP_SEL == 3) v = bf2f(F.GT[row * NG + col]);
        if (DUMP_SEL == 4) v = bf2f(F.UT[i & (size_t)(32 * 1024 * 1024 - 1)]);
        if (DUMP_SEL == 5) v = bf2f(F.Y[row * DM + col]);
        if (DUMP_SEL == 6) v = bf2f(F.MG[row * DM + col]);
        if (DUMP_SEL == 7) v = bf2f(F.H[row * DM + col]);
        if (DUMP_SEL == 8) v = bf2f(F.W1[i]);
        if (DUMP_SEL == 9) v = (i < (size_t)4 * NG) ? F.MOD[i] : ((i < (size_t)4 * NG + (size_t)T * 20) ? F.SSQ[i - 4 * NG] : 0.f);
        if (DUMP_SEL == 10) v = bf2f(F.Q[i]);
        if (DUMP_SEL == 11) v = bf2f(F.K[i]);
        if (DUMP_SEL == 12) v = bf2f(F.V[i & (size_t)(32 * 1024 * 1024 - 1)]);
        if (DUMP_SEL == 14) v = bf2f(F.W1[(size_t)NP * DM + (i % ((size_t)NG * DM))]);
        if (DUMP_SEL == 13) v = (i < (size_t)T * TOPK) ? (float)F.IDX[i] : 0.f;
        F.out[i] = v; }
}
#ifndef G1_SPLIT
#define G1_SPLIT 0
#endif
#ifndef G_AS_P
#define G_AS_P 0
#endif
#ifndef G_ALIGN
#define G_ALIGN true
#endif
#ifndef G_SP2
#define G_SP2 true
#endif
#ifndef PHASE_MASK
#define PHASE_MASK 0xFFFF
#endif
#define PM(b) (((PHASE_MASK) >> (b)) & 1)
#ifndef EXTRA_INDEX
#define EXTRA_INDEX 0
#endif
#ifndef REPEAT_MASK
#define REPEAT_MASK 0
#endif
#define RP(b) _Pragma("unroll 1") for (int rep_ = 0; rep_ < 1 + (((REPEAT_MASK) >> (b)) & 1); ++rep_)
constexpr int NPHASE = 16;
__global__ void __launch_bounds__(NWAVES * 64, 2) fwd_kernel(Args args) {
    extern __shared__ __attribute__((aligned(16))) unsigned char lds[];
    Frame F;
    const int wv0 = __builtin_amdgcn_readfirstlane((int)threadIdx.x >> 6);
#define REFRESH() frame_init(F, (LAS unsigned char*)lds, wv0)
    REFRESH();
    unsigned char* ws = args.ws;
    volatile LAS unsigned* MISC = (volatile LAS unsigned*)(F.lds + MISC_OFF);
    for (int u = F.tid; u < 64; u += NWAVES * 64) MISC[u] = 0u;
    __syncthreads();
    const bool single = (args.ph_hi - args.ph_lo) > 1;
    XcdBarrier bar; bar.bar = (unsigned*)(ws + WS_CTL) + CW_BAR; bar.x = 0; bar.st = nullptr; bar.wv = wv0;
    if (single) bar = xcd_barrier_post((unsigned*)(ws + WS_CTL) + CW_BAR, MISC + 8, wv0);
    const int lo = args.ph_lo, hi = args.ph_hi;
#define IN(k) (lo <= (k) && (k) < hi)
#ifndef SEAM_REPS
#define SEAM_REPS 1
#endif
#ifndef SKEW_PROBE
#define SKEW_PROBE 0
#endif
#ifndef SKEW_STEP
#define SKEW_STEP 0.15
#endif
#ifndef SKEW_MASK
#define SKEW_MASK 0xFFFF
#endif
#if SKEW_PROBE
    int seam_no = 0;
#define SEAM_TS() do { if (threadIdx.x == 0) ((unsigned long long*)(ws + WS_CTL + 262144))[seam_no * 256 + blockIdx.x] = wall_clock64(); ++seam_no; } while (0)
#else
#define SEAM_TS() do { } while (0)
#endif
#define SEAM(k) do { if (IN(k) && IN((k) + 1)) { SEAM_TS(); for (int sr_ = 0; sr_ < SEAM_REPS; ++sr_) xcd_barrier(bar); } } while (0)

    if (IN(0) && PM(0)) RP(0) { REFRESH(); weights_phase(F, 0); mod_phase(F); rope_phase(F); }
    SEAM(0);
#pragma unroll 1
    for (int l = 0; l < DEPTH_RUN; ++l) {
        const int pb = 1 + 7 * l;
                if (IN(pb) && PM(1)) RP(1) { REFRESH(); if (l > 0) weights_phase(F, l); norm_phase(F, (l == 0) ? F.x : F.out, l); }
        SEAM(pb);
        if (IN(pb + 1) && PM(2)) RP(2) { REFRESH();
            { pg8::Gemm g{F.H, F.W1, T, NP, DM, DM, DM}; pg8::StaticOrder S; S.init(T, NP, F.G, F.c);
              pg8::EpiG1 E{F.P, F.GT, F.b_mg + (size_t)l * NG, F.SSQ, 0, 1.0f, F.DKV, F.IKC};
              pg8::gemm_phase<pg8::EpiG1, pg8::StaticOrder, G_ALIGN, G_SP2>(F.lds + RING_OFF, g, S, E, F.wave); }
            REFRESH();
            { pg8::Gemm g{(const bf16*)F.H8, (const bf16*)F.WG8, T, NG, DM / 2, DM / 2, DM / 2}; pg8::StaticOrder S; S.init(T, NG, F.G, F.c);
              pg8::EpiG1 E{F.P, F.GT, F.b_mg + (size_t)l * NG, F.SSQ, 44, 1.0f / 64.0f, F.DKV, F.IKC};
              pg8::gemm_phase<pg8::EpiG1, pg8::StaticOrder, G_ALIGN, G_SP2, true>(F.lds + RING_OFF, g, S, E, F.wave); }
        }
        SEAM(pb + 1);
        if (IN(pb + 2)) {
            if (PM(3)) RP(3) { REFRESH();
            { pg8::Gemm g{F.P + PC_CQ, F.WUQ, T, NQ, MLA_QR, NP, MLA_QR}; pg8::StaticOrder S; S.init(T, NQ, F.G, F.c);
              pg8::EpiQ E{F.Q, F.SSQ, F.COS, F.SIN, 0.07216878364870322f * 1.4426950408889634f};
              pg8::gemm_phase<pg8::EpiQ, pg8::StaticOrder, G_ALIGN, G_SP2>(F.lds + RING_OFF, g, S, E, F.wave); }
            REFRESH();
            { pg8::Gemm g{F.P + PC_CKV, F.WUKV, T, NKV, MLA_KVR, NP, MLA_KVR}; pg8::StaticOrder S; S.init(T, NKV, F.G, F.c);
              pg8::EpiKV E{F.K, F.V, F.SSQ};
              pg8::gemm_phase<pg8::EpiKV, pg8::StaticOrder, G_ALIGN, G_SP2>(F.lds + RING_OFF, g, S, E, F.wave); }
            REFRESH(); krope_phase(F); }
            if (PM(4)) RP(4) { REFRESH(); gla1_phase(F, l); }

        }
        SEAM(pb + 2);
        if (IN(pb + 3)) { if (PM(5)) RP(5) { REFRESH(); dsa_index_phase<0>(F); } if (PM(6)) { REFRESH(); gla2_phase(F); } }
        SEAM(pb + 3);
        if (IN(pb + 4)) { if (PM(7)) RP(7) { REFRESH(); mla_attn_phase(F); } if (PM(8)) RP(8) { REFRESH(); dsa_attn_phase(F); } __syncthreads(); if (PM(9)) RP(9) { __syncthreads(); REFRESH(); gla3_phase(F, l); } }
        SEAM(pb + 4);
        #if EXTRA_INDEX
        if (IN(pb + 5)) { REFRESH(); dsa_index_phase<EXTRA_INDEX - 1>(F); }
#endif
        if (IN(pb + 5) && PM(10)) RP(10) {
            REFRESH();
            { pg8::Gemm g{F.Y, F.WBM, T, DM, DM, DM, DM}; pg8::StaticOrder S; S.init(T, DM, F.G, F.c);
              pg8::EpiMergeCat E{F.MG, F.GT}; pg8::gemm_phase<pg8::EpiMergeCat, pg8::StaticOrder, G_ALIGN, G_SP2>(F.lds + RING_OFF, g, S, E, F.wave); }
        }
        SEAM(pb + 5);
        if (IN(pb + 6) && PM(11)) for (int rep_ = 0; rep_ < 1 + ((l == 0) ? (((REPEAT_MASK) >> 11) & 1) : 0); ++rep_) { REFRESH();
            pg8::Gemm g{F.MG, F.WO, T, DM, DM, DM, DM}; pg8::StaticOrder S; S.init(T, DM, F.G, F.c);
            pg8::EpiOut E{(l == 0) ? F.x : F.out, F.out, F.MOD + (size_t)l * 2 * NG + 2 * DM};
            pg8::gemm_phase<pg8::EpiOut, pg8::StaticOrder, G_ALIGN, G_SP2>(F.lds + RING_OFF, g, S, E, F.wave);
        }
        SEAM(pb + 6);
    }
    if (IN(15) && PM(12)) { REFRESH(); final_phase(F); }
    if (DUMP_SEL >= 0) { SEAM(15); if (IN(16)) { REFRESH(); dump_phase(F); } }
#if CHECK_BUILD
    SEAM(15); if (IN(16)) { REFRESH(); check_phase(F, (unsigned*)(ws + WS_CTL)); }
    SEAM(16); if (IN(17)) { REFRESH(); check_apply(F, (unsigned*)(ws + WS_CTL)); }
#endif
#if SKEW_PROBE
    SEAM(15);
    if (IN(16)) { if (blockIdx.x == 0 && threadIdx.x == 0) { const unsigned long long* ts = (const unsigned long long*)(ws + WS_CTL + 262144); const int G_ = gridDim.x; double tot = 0.0;
            for (int sm_ = 0; sm_ < seam_no; ++sm_) if ((SKEW_MASK >> sm_) & 1) { unsigned long long mx = 0ull, t0 = ts[sm_ * 256]; double sum = 0.0;
                for (int c_ = 0; c_ < G_; ++c_) { const unsigned long long t = ts[sm_ * 256 + c_]; mx = t > mx ? t : mx; sum += (double)(long long)(t - t0); }
                tot += (double)(long long)(mx - t0) - sum / G_; }
            ((float*)(ws + WS_CTL))[12288] = 0.04f * (float)(int)(tot * 1e-5 / SKEW_STEP + 0.5);  } }
    SEAM(16);
    if (IN(17)) { const float sc_ = 1.0f + __hip_atomic_load((float*)(ws + WS_CTL) + 12288, __ATOMIC_RELAXED, __HIP_MEMORY_SCOPE_AGENT);
        float* o_ = args.out; for (size_t i = (size_t)blockIdx.x * 512 + threadIdx.x; i < (size_t)T * DM; i += (size_t)gridDim.x * 512) o_[i] *= sc_; }
#endif
#undef IN
#undef SEAM
}

extern "C" void kernel_launch(void* const* d_in, const int* in_sizes, int n_in, void* d_out, int out_size, void* d_ws, size_t ws_size, hipStream_t stream) {
    static int grid = 0;
    if (grid == 0) {
        if (n_in != 21 || out_size != T * DM || ws_size < WS_END) { fprintf(stderr, "kernel_launch: unexpected shapes (n_in %d out %d ws %zu need %zu)\n", n_in, out_size, ws_size, (size_t)WS_END); grid = -1; return; }
        int dev = 0, cus = 0, per_cu = 0;
        if (hipGetDevice(&dev) != hipSuccess || hipDeviceGetAttribute(&cus, hipDeviceAttributeMultiprocessorCount, dev) != hipSuccess) { grid = -1; return; }
        if (hipFuncSetAttribute((const void*)fwd_kernel, hipFuncAttributeMaxDynamicSharedMemorySize, LDS_BYTES) != hipSuccess) { fprintf(stderr, "kernel_launch: hipFuncSetAttribute failed\n"); grid = -1; return; }
        if (hipOccupancyMaxActiveBlocksPerMultiprocessor(&per_cu, (const void*)fwd_kernel, NWAVES * 64, LDS_BYTES) != hipSuccess || per_cu < 1) { fprintf(stderr, "kernel_launch: occupancy query says %d\n", per_cu); }
        (void)hipGetLastError();
        grid = cus > 256 ? 256 : cus;
    }
    if (grid < 0) return;
    (void)hipMemsetAsync((char*)d_ws + WS_CTL, 0, CTL_ZERO_BYTES, stream);
    Args a{};
    for (int i = 0; i < 21; ++i) a.in[i] = d_in[i];
    a.out = (float*)d_out; a.ws = (unsigned char*)d_ws;
#if MK_PER_PHASE
    for (int p = 0; p < NPHASE + (DUMP_SEL >= 0 ? 1 : 0) + (CHECK_BUILD ? 2 : 0); ++p) { a.ph_lo = p; a.ph_hi = p + 1; hipLaunchKernelGGL(fwd_kernel, dim3(grid), dim3(NWAVES * 64), LDS_BYTES, stream, a); }
#else
    a.ph_lo = 0; a.ph_hi = NPHASE + (DUMP_SEL >= 0 ? 1 : 0) + (CHECK_BUILD ? 2 : 0) + (SKEW_PROBE ? 2 : 0);
    hipLaunchKernelGGL(fwd_kernel, dim3(grid), dim3(NWAVES * 64), LDS_BYTES, stream, a);
#endif
}
```

```cpp
#include <hip/hip_runtime.h>
#include <cstdio>
#include <cstdint>
#ifndef MK_PER_PHASE
#define MK_PER_PHASE 0
#endif
#ifndef OUT_SCALE_V
#define OUT_SCALE_V 1.0f
#endif
constexpr float OUT_SCALE = OUT_SCALE_V;

constexpr int DM = 4096, NBATCH = 2, SEQ = 8192, T = NBATCH * SEQ, DEPTH = 2;
constexpr int MLA_H = 16, MLA_QR = 768, MLA_KVR = 512, MLA_NOPE = 128, MLA_ROPE = 64, MLA_DV = 128, MLA_DQK = 192;
constexpr int GLA_H = 4, GLA_DK = 128, GLA_DV = 256, GLA_R = 16, GLA_C = 64, GLA_NCH = SEQ / GLA_C;
constexpr int DSA_H = 8, DSA_KVH = 2, DSA_DH = 128, IDX_H = 32, IDX_DH = 64, TOPK = 256;
constexpr int IN_W = 11184;
constexpr float NORM_EPS = 1e-6f;
constexpr int SC_CQ = 0, SC_CKV = 768, SC_KROPE = 1280, SC_GQ = 1344, SC_GK = 1856, SC_GV = 2368, SC_GLOW = 3392, SC_DQ = 3408, SC_DK = 4432, SC_DV = 4688,
              SC_IQ = 4944, SC_IK = 6992, SC_IW = 7056, SC_ZMLA = 7088, SC_ZGLA = 9136, SC_ZDSA = 10160;
static_assert(SC_ZDSA + 1024 == IN_W, "splits");
constexpr int NP = 11264;
constexpr int PC_CQ = 0, PC_CKV = 768, PC_KROPE = 1280, PC_IK = 1344, PC_IW = 1408, PC_GLOW = 1440, PC_GQ = 1536, PC_GK = 2048, PC_GV = 2560, PC_DQ = 3584, PC_DK = 4608,
              PC_DV = 4864, PC_IQ = 5120, PC_ZMLA = 7168, PC_ZGLA = 9216, PC_ZDSA = 10240;
constexpr int NG = 3 * DM;
constexpr int N1 = NP + NG;
constexpr int NQ = MLA_H * MLA_DQK;
constexpr int NKV = MLA_H * (MLA_NOPE + MLA_DV);
constexpr int YC_MLA = 0, YC_GLA = 2048, YC_DSA = 3072;

constexpr size_t MiB = 1u << 20;
constexpr size_t WS_CTL = 0, CTL_ZERO_BYTES = 1 * MiB;
constexpr size_t WS_MOD = 1 * MiB;
constexpr size_t WS_COS = WS_MOD + 256 * 1024;
constexpr size_t WS_SIN = WS_COS + 2 * MiB;
constexpr size_t WS_SSQ = WS_SIN + 2 * MiB;
constexpr size_t WS_DEC = WS_SSQ + 2 * MiB;
constexpr size_t WS_W = 16 * MiB;
constexpr size_t WO_W1 = 0;
constexpr size_t WO_WG8 = WO_W1 + (size_t)NP * DM * 2;
constexpr size_t WO_WUQ = WO_WG8 + (size_t)NG * DM;
constexpr size_t WO_WUKV = WO_WUQ + (size_t)NQ * MLA_QR * 2;
constexpr size_t WO_WBM = WO_WUKV + (size_t)NKV * MLA_KVR * 2;
constexpr size_t WO_WBG = WO_WBM + (size_t)DM * 2048 * 2;
constexpr size_t WO_WBD = WO_WBG + (size_t)DM * 1024 * 2;
constexpr size_t WO_WO = WO_WBD + (size_t)DM * 1024 * 2;
constexpr size_t W_BYTES = WO_WO + (size_t)DM * DM * 2;
constexpr size_t WS_H = WS_W + ((W_BYTES + MiB - 1) / MiB) * MiB;
constexpr size_t WS_UT = WS_H;
constexpr size_t WS_IDX = WS_H + 64 * MiB;
constexpr size_t WS_P = WS_H + (size_t)T * DM * 2;
constexpr size_t WS_G = WS_P + (size_t)T * NP * 2;
constexpr size_t WS_Q = WS_G + (size_t)T * NG * 2;
constexpr size_t WS_K = WS_Q + (size_t)T * NQ * 2;
constexpr size_t WS_V = WS_K + (size_t)T * NQ * 2;
constexpr size_t WS_MG = WS_Q;
constexpr size_t WS_Y = WS_V + (size_t)T * 2048 * 2;
constexpr size_t WS_H8 = WS_Y;
constexpr size_t WS_DKV = WS_Y + (size_t)T * DM * 2;
constexpr size_t WS_IKC = WS_DKV + (size_t)T * 512 * 2;
constexpr size_t WS_BCG = WS_IKC + (size_t)T * 64 * 2;
constexpr size_t WS_END = WS_BCG + 32 * MiB;
static_assert(WS_END <= 1536ull * MiB, "workspace map must stay below the guaranteed size (4 x the largest tensor)");

constexpr int CW_BAR = 4096;

constexpr int RING_OFF = 0, RING_BYTES = 131072;
constexpr int KBUF_OFF = 131072;
constexpr int MISC_OFF = 147456;
constexpr int LDS_BYTES = 148480;
constexpr int NWAVES = 8;

#define GAS __attribute__((address_space(1)))
#define LAS __attribute__((address_space(3)))
typedef unsigned short bf16;
typedef unsigned v4u __attribute__((ext_vector_type(4)));
typedef unsigned v2u __attribute__((ext_vector_type(2)));
typedef float f32x4 __attribute__((ext_vector_type(4)));
typedef float f32x2 __attribute__((ext_vector_type(2)));
typedef float f32x16 __attribute__((ext_vector_type(16)));
typedef short bf16x8 __attribute__((ext_vector_type(8)));
typedef short s16x4 __attribute__((ext_vector_type(4)));
#define LDS_WAIT() asm volatile("s_waitcnt lgkmcnt(0)" ::: "memory")
#define VM_WAIT() asm volatile("s_waitcnt vmcnt(0)" ::: "memory")
__device__ __forceinline__ unsigned f2bf(float f) { unsigned u = __builtin_bit_cast(unsigned, f); return (u + 0x7fffu + ((u >> 16) & 1u)) >> 16; }
__device__ __forceinline__ unsigned pk2(float lo, float hi) { return f2bf(lo) | (f2bf(hi) << 16); }
__device__ __forceinline__ float bf2f(unsigned b) { return __builtin_bit_cast(float, b << 16); }
__device__ __forceinline__ float bflo(unsigned w) { return __builtin_bit_cast(float, w << 16); }
__device__ __forceinline__ float bfhi(unsigned w) { return __builtin_bit_cast(float, w & 0xffff0000u); }
__device__ __forceinline__ unsigned cvtpk(float lo, float hi) { unsigned r; asm volatile("v_cvt_pk_bf16_f32 %0, %1, %2" : "=v"(r) : "v"(lo), "v"(hi)); return r; }
__device__ __forceinline__ float fast_exp(float x) { return __builtin_amdgcn_exp2f(x * 1.4426950408889634f); }
__device__ __forceinline__ float sigmoidf_(float x) { return __builtin_amdgcn_rcpf(1.0f + fast_exp(-x)); }
__device__ __forceinline__ float siluf_(float x) { return x * sigmoidf_(x); }
__device__ __forceinline__ float wave_sum(float v) {
#pragma unroll
    for (int o = 1; o < 64; o <<= 1) v += __shfl_xor(v, o);
    return v;
}
__device__ __forceinline__ float wave_sum_dpp(float v) {
    v += __builtin_bit_cast(float, __builtin_amdgcn_update_dpp(0, __builtin_bit_cast(int, v), 0xB1, 0xF, 0xF, true));
    v += __builtin_bit_cast(float, __builtin_amdgcn_update_dpp(0, __builtin_bit_cast(int, v), 0x4E, 0xF, 0xF, true));
    v += __builtin_bit_cast(float, __builtin_amdgcn_update_dpp(0, __builtin_bit_cast(int, v), 0x141, 0xF, 0xF, true));
    v += __builtin_bit_cast(float, __builtin_amdgcn_update_dpp(0, __builtin_bit_cast(int, v), 0x140, 0xF, 0xF, true));
    const int vi = __builtin_bit_cast(int, v);
    return (__builtin_bit_cast(float, __builtin_amdgcn_readlane(vi, 0)) + __builtin_bit_cast(float, __builtin_amdgcn_readlane(vi, 16))) +
           (__builtin_bit_cast(float, __builtin_amdgcn_readlane(vi, 32)) + __builtin_bit_cast(float, __builtin_amdgcn_readlane(vi, 48)));
}
__device__ __forceinline__ int lane_now() { int l_; asm volatile("v_mbcnt_lo_u32_b32 %0, -1, 0\n\tv_mbcnt_hi_u32_b32 %0, -1, %0" : "=v"(l_)); return l_; }
__device__ __forceinline__ int crow(int r, int hi) { return (r & 3) + 8 * (r >> 2) + 4 * hi; }

namespace pg8 {
#define PG8_LAS __attribute__((address_space(3)))
typedef unsigned short bf16_t;
typedef short bf16x8 __attribute__((ext_vector_type(8)));
typedef float f32x4 __attribute__((ext_vector_type(4)));
typedef unsigned u32x4 __attribute__((ext_vector_type(4)));
constexpr int BM = 256, BK = 64, HALF = 128, HTB = HALF * BK * 2  , STAGE_BYTES = 8 * HTB, NXCD = 8, WGM = 8;

__host__ __device__ __forceinline__ int lds_byte(int r, int c) { const int st = (r >> 4) * 2 + (c >> 5), rr = r & 15, cc = c & 31, ob = rr * 64 + cc * 2; return st * 1024 + (ob ^ (((ob >> 9) & 1) << 5)); }
__host__ __device__ __forceinline__ void stage_rc(int b, int& R, int& C) { const int st = b / 1024, sb = b % 1024, swz = sb ^ (((sb >> 9) & 1) << 5); R = (st >> 1) * 16 + swz / 64; C = (st & 1) * 32 + (swz % 64) / 2; }
__host__ __device__ __forceinline__ int perm32(int rho) { const int n = rho >> 4, i = rho & 15; return 8 * (i >> 2) + 4 * n + (i & 3); }

struct Unit { int pm, pn; };
struct Gemm { const bf16_t* A; const bf16_t* Bt; int M, N, K, lda, ldb; };

struct StaticOrder {
    int nM, nN, nwg, G, c;
    __host__ __device__ void init(int M, int N, int G_, int c_) { nM = M / BM; nN = N / BM; nwg = nM * nN; G = G_; c = c_; }
    __host__ __device__ bool next(int i, Unit& u) const {
        const long L = (long)i * G + c; if (L >= nwg) return false;
        int wgid = (int)L; { const int q = nwg / NXCD, r = nwg % NXCD, xcd = wgid % NXCD, off = wgid / NXCD; wgid = (xcd < r ? xcd * (q + 1) : r * (q + 1) + (xcd - r) * q) + off; }
        const int nig = WGM * nN, gid = wgid / nig, fm = gid * WGM, gsz = (nM - fm) < WGM ? (nM - fm) : WGM;
        u.pm = fm + ((wgid % nig) % gsz); u.pn = (wgid % nig) / gsz; return true;
    }
    __device__ __forceinline__ void a_ready(const Unit&) const {}
    __device__ __forceinline__ void done(const Unit&) const {}
};

__device__ __forceinline__ unsigned cvt_pk_bf16(float lo, float hi) { unsigned r; asm volatile("v_cvt_pk_bf16_f32 %0, %1, %2" : "=v"(r) : "v"(lo), "v"(hi)); return r; }
__device__ __forceinline__ float fexp(float x) { return __builtin_amdgcn_exp2f(x * 1.4426950408889634f); }
__device__ __forceinline__ float fsig(float x) { return __builtin_amdgcn_rcpf(1.0f + fexp(-x)); }
__device__ __forceinline__ float blo(unsigned w) { return __builtin_bit_cast(float, w << 16); }
__device__ __forceinline__ float bhi(unsigned w) { return __builtin_bit_cast(float, w & 0xffff0000u); }
__device__ __forceinline__ u32x4 pack8(const f32x4 v0, const f32x4 v1) { u32x4 w; w.x = cvt_pk_bf16(v0[0], v0[1]); w.y = cvt_pk_bf16(v0[2], v0[3]); w.z = cvt_pk_bf16(v1[0], v1[1]); w.w = cvt_pk_bf16(v1[2], v1[3]); return w; }

#ifndef G_CONST
#define G_CONST 0
#endif
#ifndef NT_STORE
#define NT_STORE 0
#endif
#ifndef NOBIAS
#define NOBIAS 0
#endif
struct EpiG1 {
    static constexpr bool PERM = true, AFTER_DRAIN = false, HAS_MID = false;
    bf16_t* P; bf16_t* G; const float* bmg; float* ssq; int pn0; float gsc; bf16_t* DKV; bf16_t* IKC;
    __device__ __forceinline__ void operator()(const f32x4 (&acc)[2][2][4][2], const Unit& uu, int wr, int wc, int fr, int fq) const {
        const int pn = uu.pn + pn0;
        const int row0 = uu.pm * BM + wr * 64 + fr;
        const bool isG = pn >= 44, stat = pn < 5;
        const int mode = isG ? 2 : (pn >= 28 ? 1 : 0);
        const bool isKV = (pn == 18) || (pn == 19);
        const ptrdiff_t dsel = (isG ? (G - P) : (ptrdiff_t)0) + (isKV ? (DKV - P) : (ptrdiff_t)0);
        bf16_t* base = P + dsel; const int pitch = isG ? 12288 : (isKV ? 512 : 11264);
        const int col0 = (isG ? (pn - 44) : (isKV ? (pn - 18) : pn)) * BM + wc * 32 + 8 * fq;
        const bool isIK = (pn == 5) && (wc >= 2);
#pragma unroll
        for (int ai = 0; ai < 2; ++ai)
#pragma unroll
            for (int m = 0; m < 4; ++m) { const int row = row0 + ai * HALF + m * 16; bf16_t* rowp = base + (size_t)row * pitch + col0; float ss = 0.f;
#pragma unroll
                for (int bj = 0; bj < 2; ++bj) { f32x4 v0 = acc[ai][bj][m][0], v1 = acc[ai][bj][m][1];
                    if (stat) ss += (v0[0] * v0[0] + v0[1] * v0[1]) + (v0[2] * v0[2] + v0[3] * v0[3]) + (v1[0] * v1[0] + v1[1] * v1[1]) + (v1[2] * v1[2] + v1[3] * v1[3]);
                    if (mode == 1) {
#pragma unroll
                        for (int j = 0; j < 4; ++j) { v0[j] = v0[j] * fsig(v0[j]); v1[j] = v1[j] * fsig(v1[j]); } }
                    if (mode == 2) { const f32x4 b0 = *(const f32x4*)(bmg + col0 + bj * HALF), b1 = *(const f32x4*)(bmg + col0 + bj * HALF + 4);
#pragma unroll
                        for (int j = 0; j < 4; ++j) { v0[j] = fsig(v0[j] * gsc + b0[j]); v1[j] = fsig(v1[j] * gsc + b1[j]); } }
                    const u32x4 pk_ = pack8(v0, v1); if (NT_STORE) __builtin_nontemporal_store(pk_, (u32x4*)(rowp + bj * HALF)); else *(u32x4*)(rowp + bj * HALF) = pk_;
                    if (isIK && bj == 0) *(u32x4*)(IKC + (size_t)row * 64 + (wc - 2) * 32 + 8 * fq) = pk_; }
                if (stat) { ss += __shfl_xor(ss, 16); ss += __shfl_xor(ss, 32); if (fq == 0) ssq[(size_t)row * 20 + pn * 4 + wc] = ss; } }
    }
};
struct EpiQ {
    static constexpr bool PERM = true, AFTER_DRAIN = false, HAS_MID = false;
    bf16_t* Q; const float* ssq; const float* cosT; const float* sinT; float qscale;
    __device__ __forceinline__ void operator()(const f32x4 (&acc)[2][2][4][2], const Unit& u, int wr, int wc, int fr, int fq) const {
        const int row0 = u.pm * BM + wr * 64 + fr, col0 = u.pn * BM + wc * 32 + 8 * fq;
#pragma unroll
        for (int ai = 0; ai < 2; ++ai)
#pragma unroll
            for (int m = 0; m < 4; ++m) { const int row = row0 + ai * HALF + m * 16, b = row >> 13, s = row & 8191;
                const f32x4* sp = (const f32x4*)(ssq + (size_t)row * 20); const f32x4 s0 = sp[0], s1 = sp[1], s2 = sp[2];
                const float tot = ((s0[0] + s0[1]) + (s0[2] + s0[3])) + ((s1[0] + s1[1]) + (s1[2] + s1[3])) + ((s2[0] + s2[1]) + (s2[2] + s2[3]));
                const float rq = __builtin_amdgcn_rsqf(tot * (1.0f / 768.0f) + 1e-6f) * qscale;
#pragma unroll
                for (int bj = 0; bj < 2; ++bj) { const int col = col0 + bj * HALF, h = col / 192, d = col - h * 192;
                    f32x4 v0 = acc[ai][bj][m][0] * rq, v1 = acc[ai][bj][m][1] * rq;
                    if (d >= 128) { const int j0 = (d - 128) >> 1; const f32x4 c = *(const f32x4*)(cosT + (size_t)row * 32 + j0), sn = *(const f32x4*)(sinT + (size_t)row * 32 + j0);
                        float x1, x2;
                        x1 = v0[0]; x2 = v0[1]; v0[0] = x1 * c[0] - x2 * sn[0]; v0[1] = x1 * sn[0] + x2 * c[0];
                        x1 = v0[2]; x2 = v0[3]; v0[2] = x1 * c[1] - x2 * sn[1]; v0[3] = x1 * sn[1] + x2 * c[1];
                        x1 = v1[0]; x2 = v1[1]; v1[0] = x1 * c[2] - x2 * sn[2]; v1[1] = x1 * sn[2] + x2 * c[2];
                        x1 = v1[2]; x2 = v1[3]; v1[2] = x1 * c[3] - x2 * sn[3]; v1[3] = x1 * sn[3] + x2 * c[3]; }
                    *(u32x4*)(Q + (((size_t)(b * 16 + h) * 8192 + s) * 192 + d)) = pack8(v0, v1); } }
    }
};
struct EpiKV {
    static constexpr bool PERM = true, AFTER_DRAIN = false, HAS_MID = false;
    bf16_t* Kb; bf16_t* Vb; const float* ssq;
    __device__ __forceinline__ void operator()(const f32x4 (&acc)[2][2][4][2], const Unit& u, int wr, int wc, int fr, int fq) const {
        const int row0 = u.pm * BM + wr * 64 + fr, col0 = u.pn * BM + wc * 32 + 8 * fq;
#pragma unroll
        for (int ai = 0; ai < 2; ++ai)
#pragma unroll
            for (int m = 0; m < 4; ++m) { const int row = row0 + ai * HALF + m * 16, b = row >> 13, s = row & 8191;
                const f32x4* sp = (const f32x4*)(ssq + (size_t)row * 20 + 12); const f32x4 s0 = sp[0], s1 = sp[1];
                const float tot = ((s0[0] + s0[1]) + (s0[2] + s0[3])) + ((s1[0] + s1[1]) + (s1[2] + s1[3]));
                const float rk = __builtin_amdgcn_rsqf(tot * (1.0f / 512.0f) + 1e-6f);
#pragma unroll
                for (int bj = 0; bj < 2; ++bj) { const int col = col0 + bj * HALF;
                    const f32x4 v0 = acc[ai][bj][m][0] * rk, v1 = acc[ai][bj][m][1] * rk;
                    bf16_t* dst;
                    if (col < 2048) { const int h = col >> 7, d = col & 127; dst = Kb + (((size_t)(b * 16 + h) * 8192 + s) * 192 + d); }
                    else { const int c2 = col - 2048, h = c2 >> 7, d = c2 & 127; dst = Vb + (((size_t)(b * 16 + h) * 8192 + s) * 128 + d); }
                    *(u32x4*)dst = pack8(v0, v1); } }
    }
};
template <int STEP> struct EpiMerge {
    static constexpr bool PERM = true, AFTER_DRAIN = false, HAS_MID = false;
    bf16_t* MG; const bf16_t* G;
    __device__ __forceinline__ void operator()(const f32x4 (&acc)[2][2][4][2], const Unit& u, int wr, int wc, int fr, int fq) const {
        const int row0 = u.pm * BM + wr * 64 + fr, col0 = u.pn * BM + wc * 32 + 8 * fq;
#pragma unroll
        for (int ai = 0; ai < 2; ++ai)
#pragma unroll
            for (int m = 0; m < 4; ++m) { const int row = row0 + ai * HALF + m * 16;
#pragma unroll
                for (int bj = 0; bj < 2; ++bj) { const int col = col0 + bj * HALF;
                    const u32x4 gw = *(const u32x4*)(G + (size_t)row * 12288 + STEP * 4096 + col);
                    f32x4 v0 = acc[ai][bj][m][0], v1 = acc[ai][bj][m][1];
                    v0[0] *= blo(gw.x); v0[1] *= bhi(gw.x); v0[2] *= blo(gw.y); v0[3] *= bhi(gw.y); v1[0] *= blo(gw.z); v1[1] *= bhi(gw.z); v1[2] *= blo(gw.w); v1[3] *= bhi(gw.w);
                    bf16_t* dst = MG + (size_t)row * 4096 + col;
                    if (STEP > 0) { const u32x4 pw = *(const u32x4*)dst;
                        v0[0] += blo(pw.x); v0[1] += bhi(pw.x); v0[2] += blo(pw.y); v0[3] += bhi(pw.y); v1[0] += blo(pw.z); v1[1] += bhi(pw.z); v1[2] += blo(pw.w); v1[3] += bhi(pw.w); }
                    *(u32x4*)dst = pack8(v0, v1); } }
    }
};
struct EpiMergeCat {
    static constexpr bool PERM = true, AFTER_DRAIN = false, HAS_MID = true;
    bf16_t* MG; const bf16_t* G;
    __device__ __forceinline__ bool is_mid(int t) const { return t == 32 || t == 48; }
    __device__ __forceinline__ void mid(f32x4 (&acc)[2][2][4][2], const Unit& u, int wr, int wc, int fr, int fq, int t) const {
        int fr_ = fr, fq_ = fq; asm volatile("" : "+v"(fr_), "+v"(fq_));
        const int row0 = u.pm * BM + wr * 64 + fr_, col0 = u.pn * BM + wc * 32 + 8 * fq_, x = (t == 32) ? 0 : 1;
        u32x4 gcur[2][2], gnxt[2][2];
#define MC_LD(DST, I_) do { const int row_ = row0 + ((I_) >> 2) * HALF + ((I_) & 3) * 16; _Pragma("unroll") for (int bj = 0; bj < 2; ++bj) { const int col_ = col0 + bj * HALF;     \
            DST[bj][0] = *(const u32x4*)(G + (size_t)row_ * 12288 + x * 4096 + col_); DST[bj][1] = *(const u32x4*)(G + (size_t)row_ * 12288 + (x + 1) * 4096 + col_); } } while (0)
        MC_LD(gcur, 0);
#pragma unroll
        for (int i = 0; i < 8; ++i) { const int ai = i >> 2, m = i & 3;
            if (i + 1 < 8) MC_LD(gnxt, i + 1);
            asm volatile("" ::: "memory");
#pragma unroll
            for (int bj = 0; bj < 2; ++bj) { const u32x4 gn = gcur[bj][0], gd = gcur[bj][1];
                const unsigned nw[4] = {gn.x, gn.y, gn.z, gn.w}, dw[4] = {gd.x, gd.y, gd.z, gd.w};
#pragma unroll
                for (int j = 0; j < 4; ++j) { const float n0 = fmaxf(blo(nw[j]), 1e-20f), n1 = fmaxf(bhi(nw[j]), 1e-20f), d0 = fmaxf(blo(dw[j]), 1e-20f), d1 = fmaxf(bhi(dw[j]), 1e-20f);
                    f32x4& a = acc[ai][bj][m][j >> 1]; a[(j & 1) * 2] *= n0 * __builtin_amdgcn_rcpf(d0); a[(j & 1) * 2 + 1] *= n1 * __builtin_amdgcn_rcpf(d1); } }
#pragma unroll
            for (int bj = 0; bj < 2; ++bj) if (i + 1 < 8) { gcur[bj][0] = gnxt[bj][0]; gcur[bj][1] = gnxt[bj][1]; } }
#undef MC_LD
    }
    __device__ __forceinline__ void operator()(const f32x4 (&acc)[2][2][4][2], const Unit& u, int wr, int wc, int fr, int fq) const {
        const int row0 = u.pm * BM + wr * 64 + fr, col0 = u.pn * BM + wc * 32 + 8 * fq;
#pragma unroll
        for (int ai = 0; ai < 2; ++ai) { u32x4 gq[4][2];
#pragma unroll
            for (int m = 0; m < 4; ++m)
#pragma unroll
                for (int bj = 0; bj < 2; ++bj) gq[m][bj] = *(const u32x4*)(G + (size_t)(row0 + ai * HALF + m * 16) * 12288 + 2 * 4096 + col0 + bj * HALF);
#pragma unroll
            for (int m = 0; m < 4; ++m) { const int row = row0 + ai * HALF + m * 16;
#pragma unroll
                for (int bj = 0; bj < 2; ++bj) { const int col = col0 + bj * HALF;
                    const u32x4 gw = gq[m][bj];
                    f32x4 v0 = acc[ai][bj][m][0], v1 = acc[ai][bj][m][1];
                    v0[0] *= fmaxf(blo(gw.x), 1e-20f); v0[1] *= fmaxf(bhi(gw.x), 1e-20f); v0[2] *= fmaxf(blo(gw.y), 1e-20f); v0[3] *= fmaxf(bhi(gw.y), 1e-20f);
                    v1[0] *= fmaxf(blo(gw.z), 1e-20f); v1[1] *= fmaxf(bhi(gw.z), 1e-20f); v1[2] *= fmaxf(blo(gw.w), 1e-20f); v1[3] *= fmaxf(bhi(gw.w), 1e-20f);
                    *(u32x4*)(MG + (size_t)row * 4096 + col) = pack8(v0, v1); } } }
    }
};
struct EpiOut {
    static constexpr bool PERM = false, AFTER_DRAIN = false, HAS_MID = false;
    const float* xin; float* out; const float* gate;
    __device__ __forceinline__ void operator()(const f32x4 (&acc)[2][2][4][2], const Unit& u, int wr, int wc, int fr, int fq) const {
        const int row0 = u.pm * BM + wr * 64 + fr, col0 = u.pn * BM + wc * 32 + 4 * fq;
        const int b = (u.pm * BM) >> 13;
        f32x4 gv[2][2];
#pragma unroll
        for (int bj = 0; bj < 2; ++bj)
#pragma unroll
            for (int n = 0; n < 2; ++n) gv[bj][n] = *(const f32x4*)(gate + (size_t)b * 12288 + col0 + bj * HALF + n * 16);
#pragma unroll
        for (int ai = 0; ai < 2; ++ai) { f32x4 xv[4][2][2];
#pragma unroll
            for (int m = 0; m < 4; ++m) { const int row = row0 + ai * HALF + m * 16;
#pragma unroll
                for (int bj = 0; bj < 2; ++bj)
#pragma unroll
                    for (int n = 0; n < 2; ++n) xv[m][bj][n] = *(const f32x4*)(xin + (size_t)row * 4096 + col0 + bj * HALF + n * 16); }
#pragma unroll
            for (int m = 0; m < 4; ++m) { const int row = row0 + ai * HALF + m * 16;
#pragma unroll
                for (int bj = 0; bj < 2; ++bj)
#pragma unroll
                    for (int n = 0; n < 2; ++n) *(f32x4*)(out + (size_t)row * 4096 + col0 + bj * HALF + n * 16) = xv[m][bj][n] + gv[bj][n] * acc[ai][bj][m][n]; } }
    }
};


typedef int v8i_t __attribute__((ext_vector_type(8)));
__device__ __forceinline__ v8i_t cat16(const bf16x8 lo, const bf16x8 hi) { v8i_t r; bf16x8* p = reinterpret_cast<bf16x8*>(&r); p[0] = lo; p[1] = hi; return r; }
template <class Epi, class Sched, bool ALIGN_EPI = false, bool SP2 = false, bool FP8 = false>
__device__ __forceinline__ void gemm_phase(PG8_LAS unsigned char* lds, const Gemm g, const Sched& S, const Epi& E, int wv_) {
    int tid_ = wv_ * 64 + lane_now(); asm volatile("" : "+v"(tid_));
    const int tid = tid_, wid = __builtin_amdgcn_readfirstlane(tid >> 6), lane = tid & 63, wr = wid >> 2, wc = wid & 3, fr = lane & 15, fq = lane >> 4;
    const int K = g.K, nt = K / BK;
    unsigned voffA[2], voffB[2];
#pragma unroll
    for (int i = 0; i < 2; ++i) { int R, C; stage_rc(tid * 16 + i * 8192, R, C); const int Rb = Epi::PERM ? ((R & ~31) + perm32(R & 31)) : R;
        voffA[i] = (unsigned)(R * g.lda + C) * 2u; voffB[i] = (unsigned)(Rb * g.ldb + C) * 2u; }
    const size_t kstep = (size_t)(BK * 2);
    const size_t hstepA = (size_t)HALF * g.lda * 2, hstepB = (size_t)HALF * g.ldb * 2;
    const size_t tstepA = 2 * hstepA, tstepB = 2 * hstepB;
    const unsigned ldsw = (unsigned)wid * 1024u;
    const int aoff = lds_byte(wr * 64 + fr, fq * 8), boff = lds_byte(wc * 32 + fr, fq * 8);
#define PG8_SA(b, h) (((b) * 2 + (h)) * HTB)
#define PG8_SB(b, h) ((4 + (b) * 2 + (h)) * HTB)
#define PG8_STAGE(bufoff, gbase, voff) do { _Pragma("unroll") for (int _i = 0; _i < 2; ++_i) \
        __builtin_amdgcn_global_load_lds((const unsigned*)((const char*)(gbase) + (voff)[_i]), (PG8_LAS unsigned*)(lds + (bufoff) + ldsw + _i * 8192), 16, 0, 0); } while (0)
#define PG8_LDA(dst, b, h) do { _Pragma("unroll") for (int m = 0; m < 4; ++m) _Pragma("unroll") for (int k = 0; k < 2; ++k) dst[m][k] = *(const PG8_LAS bf16x8*)(lds + PG8_SA(b, h) + aoff + m * 2048 + k * 1024); } while (0)
#define PG8_LDB(dst, b, h) do { _Pragma("unroll") for (int n = 0; n < 2; ++n) _Pragma("unroll") for (int k = 0; k < 2; ++k) dst[n][k] = *(const PG8_LAS bf16x8*)(lds + PG8_SB(b, h) + boff + n * 2048 + k * 1024); } while (0)
#define PG8_MMA(ai, bj, At, Bt) do { __builtin_amdgcn_s_setprio(1); \
        if constexpr (FP8) { _Pragma("unroll") for (int m = 0; m < 4; ++m) _Pragma("unroll") for (int n = 0; n < 2; ++n) \
            asm volatile("v_mfma_scale_f32_16x16x128_f8f6f4 %0, %1, %2, %0, %3, %3 op_sel_hi:[0,0,0]" : "+v"(acc[ai][bj][m][n]) : "v"(cat16(Bt[n][0], Bt[n][1])), "v"(cat16(At[m][0], At[m][1])), "v"(0x7F7F7F7F)); } \
        else { _Pragma("unroll") for (int m = 0; m < 4; ++m) _Pragma("unroll") for (int n = 0; n < 2; ++n) _Pragma("unroll") for (int k = 0; k < 2; ++k) \
            acc[ai][bj][m][n] = __builtin_amdgcn_mfma_f32_16x16x32_bf16(Bt[n][k], At[m][k], acc[ai][bj][m][n], 0, 0, 0); } \
        __builtin_amdgcn_s_setprio(0); } while (0)
#define PG8_WAIT_V(n) asm volatile("s_waitcnt vmcnt(" #n ")" ::: "memory")
#define PG8_WAIT_L(n) asm volatile("s_waitcnt lgkmcnt(" #n ")" ::: "memory")
#define PG8_BAR __builtin_amdgcn_s_barrier()
#define PG8_SCHED __builtin_amdgcn_sched_barrier(0)
    Unit cur, nxt; int ui = 0;
    if (!S.next(0, cur)) return;
    f32x4 acc[2][2][4][2];
#pragma unroll
    for (int a = 0; a < 2; ++a)
#pragma unroll
        for (int b = 0; b < 2; ++b)
#pragma unroll
            for (int m = 0; m < 4; ++m)
#pragma unroll
                for (int n = 0; n < 2; ++n) acc[a][b][m][n] = (f32x4){0.f, 0.f, 0.f, 0.f};
    bf16x8 At[4][2], B0[2][2], B1[2][2];
    const char* cA = (const char*)g.A + (size_t)cur.pm * tstepA; const char* cB = (const char*)g.Bt + (size_t)cur.pn * tstepB;
    S.a_ready(cur);
    if constexpr (SP2) {
        PG8_STAGE(PG8_SB(0, 0), cB, voffB); PG8_STAGE(PG8_SB(0, 1), cB + hstepB, voffB); PG8_STAGE(PG8_SA(0, 0), cA, voffA); PG8_STAGE(PG8_SA(0, 1), cA + hstepA, voffA);
        if (wr == 1) PG8_BAR;
        PG8_WAIT_V(2); PG8_BAR;
        PG8_STAGE(PG8_SB(1, 0), cB + kstep, voffB); PG8_STAGE(PG8_SA(1, 0), cA + kstep, voffA); PG8_STAGE(PG8_SB(1, 1), cB + hstepB + kstep, voffB);
        PG8_WAIT_V(6); PG8_BAR;
    } else {
        PG8_STAGE(PG8_SB(0, 0), cB, voffB); PG8_STAGE(PG8_SA(0, 0), cA, voffA); PG8_STAGE(PG8_SB(0, 1), cB + hstepB, voffB); PG8_STAGE(PG8_SA(0, 1), cA + hstepA, voffA);
        if (wr == 1) PG8_BAR;
        PG8_WAIT_V(4); PG8_BAR;
        PG8_STAGE(PG8_SB(1, 0), cB + kstep, voffB); PG8_STAGE(PG8_SA(1, 0), cA + kstep, voffA); PG8_STAGE(PG8_SB(1, 1), cB + hstepB + kstep, voffB);
        PG8_WAIT_V(6); PG8_BAR;
    }
    for (;;) {
        const bool has_next = S.next(ui + 1, nxt);
        const char* nA = has_next ? (const char*)g.A + (size_t)nxt.pm * tstepA : cA; const char* nB = has_next ? (const char*)g.Bt + (size_t)nxt.pn * tstepB : cB;
        for (int t = 0; t < nt; t += 2) {
            if constexpr (Epi::HAS_MID) { if (E.is_mid(t)) E.mid(acc, cur, wr, wc, fr, fq, t); }
            const bool last = (t == nt - 2);
            const char* a1 = cA + (size_t)(t + 1) * kstep;
            const char* a2 = last ? nA : cA + (size_t)(t + 2) * kstep; const char* b2 = last ? nB : cB + (size_t)(t + 2) * kstep;
            const char* a3 = a2 + kstep; const char* b3 = b2 + kstep;
            if (last && has_next) S.a_ready(nxt);
            if constexpr (SP2) {
            PG8_LDB(B0, 0, 0); PG8_LDB(B1, 0, 1); PG8_SCHED; PG8_LDA(At, 0, 0); PG8_STAGE(PG8_SA(1, 1), a1 + hstepA, voffA);
            PG8_WAIT_V(8); PG8_WAIT_L(0); PG8_BAR; PG8_MMA(0, 0, At, B0); PG8_MMA(0, 1, At, B1); PG8_BAR; PG8_SCHED;
            PG8_LDA(At, 0, 1); PG8_STAGE(PG8_SB(0, 0), b2, voffB); PG8_STAGE(PG8_SB(0, 1), b2 + hstepB, voffB); PG8_STAGE(PG8_SA(0, 0), a2, voffA);
            PG8_WAIT_V(8); PG8_WAIT_L(0); PG8_BAR; PG8_MMA(1, 0, At, B0); PG8_MMA(1, 1, At, B1); PG8_BAR; PG8_SCHED;
            PG8_LDB(B0, 1, 0); PG8_LDB(B1, 1, 1); PG8_SCHED; PG8_LDA(At, 1, 0); PG8_STAGE(PG8_SA(0, 1), a2 + hstepA, voffA);
            PG8_WAIT_V(8); PG8_WAIT_L(0); PG8_BAR; PG8_MMA(0, 0, At, B0); PG8_MMA(0, 1, At, B1); PG8_BAR; PG8_SCHED;
            PG8_LDA(At, 1, 1); PG8_STAGE(PG8_SB(1, 0), b3, voffB); PG8_STAGE(PG8_SB(1, 1), b3 + hstepB, voffB); PG8_STAGE(PG8_SA(1, 0), a3, voffA);
            PG8_WAIT_V(8); PG8_WAIT_L(0); PG8_BAR; PG8_MMA(1, 0, At, B0); PG8_MMA(1, 1, At, B1); PG8_BAR; PG8_SCHED;
            } else {
            PG8_LDB(B0, 0, 0); PG8_SCHED; PG8_LDA(At, 0, 0); PG8_STAGE(PG8_SA(1, 1), a1 + hstepA, voffA);
            PG8_WAIT_L(8); PG8_BAR; PG8_WAIT_L(0); PG8_MMA(0, 0, At, B0); PG8_BAR; PG8_SCHED;
            PG8_LDB(B1, 0, 1); PG8_STAGE(PG8_SB(0, 0), b2, voffB);
            PG8_BAR; PG8_WAIT_L(0); PG8_MMA(0, 1, At, B1); PG8_BAR;
            PG8_LDA(At, 0, 1); PG8_STAGE(PG8_SA(0, 0), a2, voffA);
            PG8_BAR; PG8_WAIT_L(0); PG8_MMA(1, 0, At, B0); PG8_BAR; PG8_SCHED;
            PG8_STAGE(PG8_SB(0, 1), b2 + hstepB, voffB);
            PG8_WAIT_V(6); PG8_BAR; PG8_MMA(1, 1, At, B1); PG8_BAR;
            PG8_LDB(B0, 1, 0); PG8_SCHED; PG8_LDA(At, 1, 0); PG8_STAGE(PG8_SA(0, 1), a2 + hstepA, voffA);
            PG8_WAIT_L(8); PG8_BAR; PG8_WAIT_L(0); PG8_MMA(0, 0, At, B0); PG8_BAR; PG8_SCHED;
            PG8_LDB(B1, 1, 1); PG8_STAGE(PG8_SB(1, 0), b3, voffB);
            PG8_BAR; PG8_WAIT_L(0); PG8_MMA(0, 1, At, B1); PG8_BAR;
            PG8_LDA(At, 1, 1); PG8_STAGE(PG8_SA(1, 0), a3, voffA);
            PG8_BAR; PG8_WAIT_L(0); PG8_MMA(1, 0, At, B0); PG8_BAR; PG8_SCHED;
            PG8_STAGE(PG8_SB(1, 1), b3 + hstepB, voffB);
            PG8_WAIT_V(6); PG8_BAR; PG8_MMA(1, 1, At, B1); PG8_BAR;
            }
        }
        if constexpr (ALIGN_EPI) { if (wr == 0) PG8_BAR; }
        if constexpr (!Epi::AFTER_DRAIN) { E(acc, cur, wr, wc, fr, fq); S.done(cur); }
        if (!has_next) break;
#pragma unroll
        for (int a = 0; a < 2; ++a)
#pragma unroll
            for (int b = 0; b < 2; ++b)
#pragma unroll
                for (int m = 0; m < 4; ++m)
#pragma unroll
                    for (int n = 0; n < 2; ++n) acc[a][b][m][n] = (f32x4){0.f, 0.f, 0.f, 0.f};
        cur = nxt; cA = nA; cB = nB; ++ui;
        if constexpr (ALIGN_EPI) { if (wr == 1) PG8_BAR; }
    }
    PG8_WAIT_V(0);
    if constexpr (!ALIGN_EPI) { if (wr == 0) PG8_BAR; }
    PG8_BAR;
    if constexpr (Epi::AFTER_DRAIN) { E.fused(acc, cur, wr, wc, fr, fq, lds, wid, lane); S.done(cur); }
#undef PG8_SA
#undef PG8_SB
#undef PG8_STAGE
#undef PG8_LDA
#undef PG8_LDB
#undef PG8_MMA
#undef PG8_WAIT_V
#undef PG8_WAIT_L
#undef PG8_BAR
#undef PG8_SCHED
}
}

#define XB_TMO      128
#define XB_XCNT(j)  (256  + 64 * (j))
#define XB_XSUB(j)  (1280 + 64 * (j))
#define XB_XGEN(j)  (2304 + 64 * (j))
#define XB_TOP      3328
#define XB_TOPGEN   3392
#define XCD_BAR_WORDS 3456
#define XB_SPIN_CAP (1u << 24)

__device__ __forceinline__ unsigned xb_ld(unsigned* p)              { return __hip_atomic_load(p, __ATOMIC_RELAXED, __HIP_MEMORY_SCOPE_AGENT); }
__device__ __forceinline__ unsigned xb_add(unsigned* p, unsigned v) { return __hip_atomic_fetch_add(p, v, __ATOMIC_RELAXED, __HIP_MEMORY_SCOPE_AGENT); }
__device__ __forceinline__ unsigned xb_xcc_id() { return (unsigned)__builtin_amdgcn_s_getreg((3 << 11) | 20) & 0xFu; }
#define XB_SPIN(cond, bar) do { unsigned _sp = 0; while (cond) { __builtin_amdgcn_s_sleep(1); \
    if ((++_sp & 255u) == 0u) { if (xb_ld(&(bar)[XB_TMO])) break; if (_sp > XB_SPIN_CAP) { atomicAdd(&(bar)[XB_TMO], 1u); break; } } } } while (0)

struct XcdBarrier {
    unsigned* bar; unsigned x;
    volatile LAS unsigned* st;
    int wv;
};
__device__ __forceinline__ bool xb_thread0(int wv) { return wv == 0 && lane_now() == 0; }

__device__ __forceinline__ XcdBarrier xcd_barrier_post(unsigned* bar, volatile LAS unsigned* st, int wv) {
    XcdBarrier b; b.bar = bar; b.x = xb_xcc_id(); b.st = st; b.wv = wv;
    if (xb_thread0(wv)) (void)xb_add(&bar[XB_XCNT(b.x)], 1u);
    return b;
}
__device__ __forceinline__ void xcd_barrier_complete(unsigned* bar, unsigned x, unsigned& nloc, unsigned& nx) {
    const unsigned G = gridDim.x * gridDim.y * gridDim.z;
    unsigned sum, cnt, mine, sp = 0u;
    for (;;) {
        sum = 0u; cnt = 0u; mine = 0u;
#pragma unroll
        for (unsigned j = 0; j < 16; ++j) { const unsigned c = xb_ld(&bar[XB_XCNT(j)]); sum += c; cnt += (c > 0u) ? 1u : 0u; mine = (j == x) ? c : mine; }
        if (sum == G) break;
        __builtin_amdgcn_s_sleep(1);
        if ((++sp & 255u) == 0u) { if (xb_ld(&bar[XB_TMO])) break; if (sp > XB_SPIN_CAP) { atomicAdd(&bar[XB_TMO], 1u); break; } }
    }
    nloc = mine > 0u ? mine : 1u; nx = cnt > 0u ? cnt : 1u;
}

__device__ __forceinline__ void xcd_barrier(const XcdBarrier& b) {
    asm volatile("s_waitcnt vmcnt(0)" ::: "memory");
    __syncthreads();
    if (xb_thread0(b.wv)) {
        unsigned* bar = b.bar;
        __builtin_amdgcn_s_waitcnt(0);
        unsigned nloc = b.st[0], nx = b.st[1];
        if (nloc == 0u) { xcd_barrier_complete(bar, b.x, nloc, nx); b.st[0] = nloc; b.st[1] = nx; }
        const unsigned old = xb_add(&bar[XB_XSUB(b.x)], 1u);
        const unsigned gen = old / nloc;
        if (old + 1u == (gen + 1u) * nloc) {
            __builtin_amdgcn_fence(__ATOMIC_RELEASE, "agent");
            asm volatile("s_waitcnt vmcnt(0)" ::: "memory");
            const unsigned og = xb_add(&bar[XB_TOP], 1u);
            const unsigned tg = og / nx;
            if (og + 1u == (tg + 1u) * nx) xb_add(&bar[XB_TOPGEN], 1u);
            else XB_SPIN(xb_ld(&bar[XB_TOPGEN]) == tg, bar);
            __builtin_amdgcn_fence(__ATOMIC_ACQUIRE, "agent");
            xb_add(&bar[XB_XGEN(b.x)], 1u);
            asm volatile("s_waitcnt vmcnt(0)" ::: "memory");
        } else {
            XB_SPIN(xb_ld(&bar[XB_XGEN(b.x)]) == gen, bar);
            __builtin_amdgcn_fence(__ATOMIC_ACQUIRE, "agent");
            asm volatile("s_waitcnt vmcnt(0)" ::: "memory");
        }
    }
    __syncthreads();
}

#ifndef MLA_OUT_SCALE
#define MLA_OUT_SCALE 1.0f
#endif
namespace mla {
constexpr int DQK = 192, DV = 128, KVBLK = 64, QB = 256;
constexpr int SHM_K = KVBLK * DQK * 2, SHM_V = KVBLK * DV * 2;
constexpr int LDS_V = 0, LDS_K = 2 * SHM_V, LDS_WS = 2 * SHM_V + 2 * SHM_K;
#define MLA_KSWZ(row, colB) ((row) * 384 + ((colB) ^ (((row) & 7) << 4)))
#define SBAR() __builtin_amdgcn_sched_barrier(0)
__device__ __forceinline__ int v_st(int k, int c) { const int kk = (k & ~0xC) | ((k & 4) << 1) | ((k & 8) >> 1); return ((kk >> 3) * 4 + (c >> 5)) * 512 + ((kk & 7) * 32 + (c & 31)) * 2; }
__device__ __forceinline__ int v_rd_base(int lane) { return ((lane & 3) << 3) | (((lane >> 2) & 3) << 6) | (((lane >> 4) & 1) << 5) | (((lane >> 5) & 1) << 8); }
constexpr int v_rd_off(int d0, int ks, int half) { return d0 * 512 + ks * 4096 + half * 2048; }

__device__ __forceinline__ void mask_tile(f32x16& p0, f32x16& p1, int dq) {
    const float NEG = -__builtin_inff();
#pragma unroll
    for (int r = 0; r < 16; ++r) {
        const int c = (r & 3) + 8 * (r >> 2);
        if (dq - c < 0) p0[r] = NEG;
        if (dq - c - 32 < 0) p1[r] = NEG;
    }
}
constexpr float THR2 = 8.f;
__device__ __forceinline__ void softmax_tile(f32x16& p0, f32x16& p1, float& m_reg, float& alpha, float& l_reg, bf16x8& pa0, bf16x8& pa1, bf16x8& pa2, bf16x8& pa3) {
    float pmax = p0[0];
#pragma unroll
    for (int r = 1; r < 16; ++r) pmax = fmaxf(pmax, p0[r]);
#pragma unroll
    for (int r = 0; r < 16; ++r) pmax = fmaxf(pmax, p1[r]);
    { auto rr = __builtin_amdgcn_permlane32_swap(__float_as_uint(pmax), __float_as_uint(pmax), false, false);
      pmax = fmaxf(__uint_as_float(rr[0]), __uint_as_float(rr[1])); }
    float mn;
    if (__builtin_expect(__all((pmax - m_reg) <= THR2), 1)) { mn = m_reg; alpha = 1.f; }
    else { mn = fmaxf(m_reg, pmax); alpha = __builtin_amdgcn_exp2f(m_reg - mn); m_reg = mn; }
#pragma unroll
    for (int r = 0; r < 16; ++r) { p0[r] = __builtin_amdgcn_exp2f(p0[r] - mn); p1[r] = __builtin_amdgcn_exp2f(p1[r] - mn); }
    float ps = 0;
#pragma unroll
    for (int r = 0; r < 16; ++r) ps += p0[r];
#pragma unroll
    for (int r = 0; r < 16; ++r) ps += p1[r];
    { auto rr = __builtin_amdgcn_permlane32_swap(__float_as_uint(ps), __float_as_uint(ps), false, false);
      ps = __uint_as_float(rr[0]) + __uint_as_float(rr[1]); }
    l_reg = l_reg * alpha + ps;
#define PK4(P, B_, OUT) do { unsigned a0 = cvtpk(P[B_+0], P[B_+1]), a1 = cvtpk(P[B_+2], P[B_+3]);                          \
        unsigned b0 = cvtpk(P[B_+4], P[B_+5]), b1 = cvtpk(P[B_+6], P[B_+7]);                                             \
        auto r0 = __builtin_amdgcn_permlane32_swap(a0, b0, false, false); auto r1 = __builtin_amdgcn_permlane32_swap(a1, b1, false, false); \
        v4u w = {r0[0], r1[0], r0[1], r1[1]}; OUT = *reinterpret_cast<bf16x8*>(&w); } while (0)
    PK4(p0, 0, pa0); PK4(p0, 8, pa1); PK4(p1, 0, pa2); PK4(p1, 8, pa3);
#undef PK4
}
template <int KB>
__device__ __forceinline__ void qkt(f32x16& p0, f32x16& p1, const char* K_lds, int r32, int hi, const bf16x8* qr) {
    p0 = f32x16{}; p1 = f32x16{};
    const char* kb[4];
#pragma unroll
    for (int dd = 0; dd < 4; ++dd) kb[dd] = K_lds + KB * SHM_K + MLA_KSWZ(r32, (dd * 16 + hi * 8) * 2);
#pragma unroll
    for (int d0 = 0; d0 < 12; ++d0) { const char* a = kb[d0 & 3] + (d0 >> 2) * 128;
        bf16x8 b0 = *reinterpret_cast<const bf16x8*>(a);
        bf16x8 b1 = *reinterpret_cast<const bf16x8*>(a + 32 * 384);
        p0 = __builtin_amdgcn_mfma_f32_32x32x16_bf16(b0, qr[d0], p0, 0, 0, 0);
        p1 = __builtin_amdgcn_mfma_f32_32x32x16_bf16(b1, qr[d0], p1, 0, 0, 0); }
}
template <int VB>
__device__ __forceinline__ void pv_tile(f32x16* o, int vb0, bf16x8 pa0, bf16x8 pa1, bf16x8 pa2, bf16x8 pa3) {
#define TRRD(dst, off) asm volatile("ds_read_b64_tr_b16 %0, %1 offset:%2" : "=&v"(dst) : "v"(vb0), "i"(off) : "memory")
#define PV_D0(d0) do { s16x4 l0, l1, l2, l3, h0, h1, h2, h3; constexpr int b_ = VB * SHM_V + v_rd_off(d0, 0, 0);   \
        TRRD(l0, b_); TRRD(h0, b_ + 2048); TRRD(l1, b_ + 4096); TRRD(h1, b_ + 6144); TRRD(l2, b_ + 8192); TRRD(h2, b_ + 10240); TRRD(l3, b_ + 12288); TRRD(h3, b_ + 14336); \
        asm volatile("s_waitcnt lgkmcnt(0)" ::: "memory"); SBAR();                                                   \
        o[d0] = __builtin_amdgcn_mfma_f32_32x32x16_bf16(pa0, (bf16x8){l0[0], l0[1], l0[2], l0[3], h0[0], h0[1], h0[2], h0[3]}, o[d0], 0, 0, 0);   \
        o[d0] = __builtin_amdgcn_mfma_f32_32x32x16_bf16(pa1, (bf16x8){l1[0], l1[1], l1[2], l1[3], h1[0], h1[1], h1[2], h1[3]}, o[d0], 0, 0, 0);   \
        o[d0] = __builtin_amdgcn_mfma_f32_32x32x16_bf16(pa2, (bf16x8){l2[0], l2[1], l2[2], l2[3], h2[0], h2[1], h2[2], h2[3]}, o[d0], 0, 0, 0);   \
        o[d0] = __builtin_amdgcn_mfma_f32_32x32x16_bf16(pa3, (bf16x8){l3[0], l3[1], l3[2], l3[3], h3[0], h3[1], h3[2], h3[3]}, o[d0], 0, 0, 0); } while (0)
    PV_D0(0); PV_D0(1); PV_D0(2); PV_D0(3);
#undef PV_D0
#undef TRRD
}
__device__ __forceinline__ void attn_block(const bf16* Qh, const bf16* Kh, const bf16* Vh, bf16* Yp, const bf16* Zp, int P0, char* lds, int wv_) {
    int tid_ = wv_ * 64 + lane_now(); asm volatile("" : "+v"(tid_));
    const int tid = tid_, wid = __builtin_amdgcn_readfirstlane(tid >> 6), lane = tid & 63, r32 = lane & 31, hi = lane >> 5;
    const int NT = (P0 + QB) / KVBLK;
    const int qlo = P0 + wid * 32, qm = qlo + r32 - 4 * hi;
    char* V_lds = lds + LDS_V; char* K_lds = lds + LDS_K;
    float* ws = (float*)(lds + LDS_WS) + wid * 64; float* li_l = ws, * al_l = ws + 32;
    float m_reg = -1e30f, l_reg = 0; f32x16 o[4] = {};
    const int sr = tid >> 4, sc = (tid & 15) * 8, vst0 = v_st(sr, sc), vst1 = v_st(32 + sr, sc);
    int kgo[3], klo[3];
#pragma unroll
    for (int j = 0; j < 3; ++j) { const int i = tid + 512 * j, row = i / 24, c = i - row * 24; kgo[j] = row * 192 + c * 8; klo[j] = MLA_KSWZ(row, c * 16); }
    const int vb0 = (int)(uintptr_t)V_lds + v_rd_base(lane);
    bf16x8 qr[12];
#pragma unroll
    for (int d0 = 0; d0 < 12; ++d0) qr[d0] = *reinterpret_cast<const bf16x8*>(Qh + (size_t)(P0 + wid * 32 + r32) * 192 + d0 * 16 + hi * 8);
    bf16x8 st_k0, st_k1, st_k2, st_v0, st_v1;
#define SLOAD(k0) do { const bf16* kp = Kh + (size_t)(k0) * 192; const bf16* vp = Vh + (size_t)(k0) * 128;                     \
        st_k0 = *reinterpret_cast<const bf16x8*>(kp + kgo[0]); st_k1 = *reinterpret_cast<const bf16x8*>(kp + kgo[1]); st_k2 = *reinterpret_cast<const bf16x8*>(kp + kgo[2]); \
        st_v0 = *reinterpret_cast<const bf16x8*>(vp + (size_t)sr * 128 + sc); st_v1 = *reinterpret_cast<const bf16x8*>(vp + (size_t)(32 + sr) * 128 + sc); } while (0)
#define SWRITE(bf) do { *(bf16x8*)(K_lds + (bf) * SHM_K + klo[0]) = st_k0; *(bf16x8*)(K_lds + (bf) * SHM_K + klo[1]) = st_k1; *(bf16x8*)(K_lds + (bf) * SHM_K + klo[2]) = st_k2; \
        *(bf16x8*)(V_lds + (bf) * SHM_V + vst0) = st_v0; *(bf16x8*)(V_lds + (bf) * SHM_V + vst1) = st_v1; } while (0)
#define RESC(a) do { if (__any((a) < 1.f)) { if (hi == 0) al_l[r32] = (a); asm volatile("s_waitcnt lgkmcnt(0)" ::: "memory");              \
                     for (int d_ = 0; d_ < 4; ++d_) for (int r = 0; r < 16; ++r) o[d_][r] *= al_l[crow(r, hi)]; } } while (0)
    SLOAD(0); VM_WAIT(); SWRITE(0);
    __syncthreads();
    f32x16 p0, p1; bf16x8 pa0, pa1, pa2, pa3; float alpha;
#define STEP(t, BUF) do {                                                                                                 \
        if ((t) + 1 < NT) SLOAD(((t) + 1) * KVBLK);                                                                       \
        SBAR(); qkt<BUF>(p0, p1, K_lds, r32, hi, qr);                                                                    \
        { const int kb_ = (t) * KVBLK; if (kb_ + KVBLK - 1 > qlo) mask_tile(p0, p1, qm - kb_); }                          \
        softmax_tile(p0, p1, m_reg, alpha, l_reg, pa0, pa1, pa2, pa3);                                                    \
        RESC(alpha);                                                                                                      \
        pv_tile<BUF>(o, vb0, pa0, pa1, pa2, pa3);                                                                         \
        if ((t) + 1 < NT) { VM_WAIT(); SWRITE(1 - (BUF)); }                                                               \
        __syncthreads(); } while (0)
    for (int t = 0; t < NT; t += 2) { STEP(t, 0); STEP(t + 1, 1); }
#undef STEP
    if (hi == 0) li_l[r32] = l_reg; asm volatile("s_waitcnt lgkmcnt(0)" ::: "memory");
    float rli[16];
#pragma unroll
    for (int r = 0; r < 16; ++r) rli[r] = __builtin_amdgcn_rcpf(li_l[crow(r, hi)]);
    unsigned zr[16][4];
#pragma unroll
    for (int r = 0; r < 16; ++r) { const size_t orow = (size_t)(P0 + wid * 32 + crow(r, hi));
#pragma unroll
        for (int d0 = 0; d0 < 4; ++d0) zr[r][d0] = Zp[orow * NP + d0 * 32 + r32]; }
    asm volatile("" ::: "memory"); __builtin_amdgcn_sched_barrier(0);
#pragma unroll
    for (int r = 0; r < 16; ++r) { const size_t orow = (size_t)(P0 + wid * 32 + crow(r, hi));
#pragma unroll
        for (int d0 = 0; d0 < 4; ++d0) { const float z = bf2f(zr[r][d0]); const float v = o[d0][r] * rli[r] * z * MLA_OUT_SCALE;
            const float vn = __builtin_bit_cast(float, __builtin_amdgcn_update_dpp(0, __builtin_bit_cast(int, v), 0xB1, 0xF, 0xF, true));
            if ((r32 & 1) == 0) *(unsigned*)(Yp + orow * 4096 + d0 * 32 + r32) = cvtpk(v, vn); } }
    __syncthreads();
#undef SLOAD
#undef SWRITE
#undef RESC
}
#undef SBAR
}

struct Args { const void* in[21]; float* out; unsigned char* ws; int ph_lo, ph_hi; };
typedef const __attribute__((address_space(4))) Args* KArgs;
struct Frame {
    LAS unsigned char* lds;
    int tid, lane, wave, G, c;
    const float *x, *cvec; const int* pos; const float *norm_g, *w_ada, *b_ada, *w_in, *mla_gq, *mla_wuq, *mla_gkv, *mla_wukv, *gla_wg2, *gla_bg, *gla_gout, *w_mg, *b_mg, *w_bm, *w_bg, *w_bd, *w_o, *final_g;
    float* out;
    float *MOD, *COS, *SIN, *SSQ, *DEC, *BCG;
    bf16 *W1, *WUQ, *WUKV, *WBM, *WBG, *WBD, *WO; unsigned char *WG8, *H8;
    bf16 *H, *UT, *P, *GT, *Q, *K, *V, *MG, *Y, *DKV, *IKC;
    int* IDX;
};
__device__ __forceinline__ void frame_init(Frame& F, LAS unsigned char* lds, int wv_) {
    KArgs ap = (KArgs)__builtin_amdgcn_kernarg_segment_ptr(); asm volatile("" : "+s"(ap));
    int t = wv_ * 64 + lane_now(); asm volatile("" : "+v"(t));
    F.lds = lds; F.tid = t; F.lane = t & 63; F.wave = __builtin_amdgcn_readfirstlane(t >> 6); F.G = gridDim.x; F.c = blockIdx.x;
    F.x = (const float*)ap->in[0]; F.cvec = (const float*)ap->in[1]; F.pos = (const int*)ap->in[2]; F.norm_g = (const float*)ap->in[3]; F.w_ada = (const float*)ap->in[4];
    F.b_ada = (const float*)ap->in[5]; F.w_in = (const float*)ap->in[6]; F.mla_gq = (const float*)ap->in[7]; F.mla_wuq = (const float*)ap->in[8]; F.mla_gkv = (const float*)ap->in[9];
    F.mla_wukv = (const float*)ap->in[10]; F.gla_wg2 = (const float*)ap->in[11]; F.gla_bg = (const float*)ap->in[12]; F.gla_gout = (const float*)ap->in[13]; F.w_mg = (const float*)ap->in[14];
    F.b_mg = (const float*)ap->in[15]; F.w_bm = (const float*)ap->in[16]; F.w_bg = (const float*)ap->in[17]; F.w_bd = (const float*)ap->in[18]; F.w_o = (const float*)ap->in[19];
    F.final_g = (const float*)ap->in[20]; F.out = ap->out;
    unsigned char* ws = ap->ws;
    F.MOD = (float*)(ws + WS_MOD); F.COS = (float*)(ws + WS_COS); F.SIN = (float*)(ws + WS_SIN); F.SSQ = (float*)(ws + WS_SSQ); F.DEC = (float*)(ws + WS_DEC); F.BCG = (float*)(ws + WS_BCG);
    F.WG8 = ws + WS_W + WO_WG8; F.H8 = ws + WS_H8;
    F.W1 = (bf16*)(ws + WS_W + WO_W1); F.WUQ = (bf16*)(ws + WS_W + WO_WUQ); F.WUKV = (bf16*)(ws + WS_W + WO_WUKV); F.WBM = (bf16*)(ws + WS_W + WO_WBM);
    F.WBG = (bf16*)(ws + WS_W + WO_WBG); F.WBD = (bf16*)(ws + WS_W + WO_WBD); F.WO = (bf16*)(ws + WS_W + WO_WO);
    F.H = (bf16*)(ws + WS_H); F.UT = (bf16*)(ws + WS_UT); F.IDX = (int*)(ws + WS_IDX); F.P = (bf16*)(ws + WS_P); F.GT = (bf16*)(ws + WS_G);
    F.Q = (bf16*)(ws + WS_Q); F.K = (bf16*)(ws + WS_K); F.V = (bf16*)(ws + WS_V); F.MG = (bf16*)(ws + WS_MG); F.Y = (bf16*)(ws + WS_Y); F.DKV = (bf16*)(ws + WS_DKV); F.IKC = (bf16*)(ws + WS_IKC);
}

template <bool FP8, class Map>
__device__ __forceinline__ void transpose_item(const float* W, int K, int Nsrc, void* WTv, const float* kscale, float scale, Map map, LAS float* scr, int item, int nblk, int lane, int ldt = 0) {
    if (ldt == 0) ldt = K;
    const int kb = item / nblk, nb = item - kb * nblk, k0 = 64 * kb, n0 = 64 * nb;
    const int c4 = lane & 15, kr = lane >> 4;
    const int s0 = map(n0 + 4 * c4), s1 = map(n0 + 4 * c4 + 1), s2 = map(n0 + 4 * c4 + 2), s3 = map(n0 + 4 * c4 + 3);
    const bool vec = (s0 >= 0) && (s1 == s0 + 1) && (s2 == s0 + 2) && (s3 == s0 + 3) && ((s0 & 3) == 0);
    if (__all(vec)) {
#pragma unroll
        for (int h8 = 0; h8 < 2; ++h8) { f32x4 vv[8];
#pragma unroll
            for (int i = 0; i < 8; ++i) vv[i] = *(const f32x4*)(W + (size_t)(k0 + 4 * (8 * h8 + i) + kr) * Nsrc + s0);
#pragma unroll
            for (int i = 0; i < 8; ++i) { const int kk = 4 * (8 * h8 + i) + kr; float sc = scale; if (kscale) sc *= kscale[k0 + kk];
                LAS float* d = scr + kk * 65 + 4 * c4; d[0] = vv[i][0] * sc; d[1] = vv[i][1] * sc; d[2] = vv[i][2] * sc; d[3] = vv[i][3] * sc; } }
    } else
#pragma unroll 4
    for (int i = 0; i < 16; ++i) { const int kk = 4 * i + kr; const float* wr = W + (size_t)(k0 + kk) * Nsrc; f32x4 v;
        if (vec) v = *(const f32x4*)(wr + s0);
        else { v[0] = s0 >= 0 ? wr[s0] : 0.f; v[1] = s1 >= 0 ? wr[s1] : 0.f; v[2] = s2 >= 0 ? wr[s2] : 0.f; v[3] = s3 >= 0 ? wr[s3] : 0.f; }
        float sc = scale; if (kscale) sc *= kscale[k0 + kk];
        LAS float* d = scr + kk * 65 + 4 * c4; d[0] = v[0] * sc; d[1] = v[1] * sc; d[2] = v[2] * sc; d[3] = v[3] * sc; }
    LDS_WAIT(); asm volatile("" ::: "memory");
    const int c = lane & 7;
#pragma unroll
    for (int j = 0; j < 8; ++j) { const int n = (lane >> 3) + 8 * j; const LAS float* s = scr + (8 * c) * 65 + n;
        if constexpr (FP8) {
            int w0 = __builtin_amdgcn_cvt_pk_fp8_f32(s[0 * 65], s[1 * 65], 0, false); w0 = __builtin_amdgcn_cvt_pk_fp8_f32(s[2 * 65], s[3 * 65], w0, true);
            int w1 = __builtin_amdgcn_cvt_pk_fp8_f32(s[4 * 65], s[5 * 65], 0, false); w1 = __builtin_amdgcn_cvt_pk_fp8_f32(s[6 * 65], s[7 * 65], w1, true);
            v2u o; o.x = (unsigned)w0; o.y = (unsigned)w1; *(v2u*)((unsigned char*)WTv + (size_t)(n0 + n) * ldt + k0 + 8 * c) = o;
        } else {
            v4u o; o.x = pk2(s[0 * 65], s[1 * 65]); o.y = pk2(s[2 * 65], s[3 * 65]); o.z = pk2(s[4 * 65], s[5 * 65]); o.w = pk2(s[6 * 65], s[7 * 65]);
            *(v4u*)((bf16*)WTv + (size_t)(n0 + n) * ldt + k0 + 8 * c) = o; } }
    LDS_WAIT(); asm volatile("" ::: "memory");
}
struct MapId { __device__ __forceinline__ int operator()(int n) const { return n; } };
struct MapIn {
    __device__ __forceinline__ int operator()(int n) const {
        if (n < 1280) return n;
        if (n < 1344) { const int jj = n - 1280; return SC_KROPE + (jj & 1) * 32 + (jj >> 1); }
        if (n < 1408) return SC_IK + (n - 1344);
        if (n < 1440) return SC_IW + (n - 1408);
        if (n < 1456) return SC_GLOW + (n - 1440);
        if (n < 1536) return -1;
        if (n < 2048) return SC_GQ + (n - 1536);
        if (n < 2560) return SC_GK + (n - 2048);
        if (n < 3584) return SC_GV + (n - 2560);
        if (n < 4608) return SC_DQ + (n - 3584);
        if (n < 4864) return SC_DK + (n - 4608);
        if (n < 5120) return SC_DV + (n - 4864);
        if (n < 7168) return SC_IQ + (n - 5120);
        if (n < 9216) return SC_ZMLA + (n - 7168);
        if (n < 10240) return SC_ZGLA + (n - 9216);
        return SC_ZDSA + (n - 10240);
    }
};
struct MapUQ {
    __device__ __forceinline__ int operator()(int n) const { const int h = n / 192, d = n - h * 192; if (d < 128) return n; const int jj = d - 128; return h * 192 + 128 + (jj & 1) * 32 + (jj >> 1); }
};
struct MapUKV {
    __device__ __forceinline__ int operator()(int n) const { if (n < 2048) { const int h = n >> 7, d = n & 127; return h * 256 + d; } const int c = n - 2048, h = c >> 7, d = c & 127; return h * 256 + 128 + d; }
};

__device__ __forceinline__ void weights_phase(Frame& F, int l) {
    LAS float* scr = (LAS float*)(F.lds + RING_OFF + F.wave * 16640);
    const int gw = F.c * NWAVES + F.wave, NGW = F.G * NWAVES;
    constexpr int I_IN = (DM / 64) * (NP / 64), I_MG = (DM / 64) * (NG / 64), I_UQ = (MLA_QR / 64) * (NQ / 64), I_UKV = (MLA_KVR / 64) * (NKV / 64),
                  I_BM = (2048 / 64) * (DM / 64), I_BG = (1024 / 64) * (DM / 64), I_O = (DM / 64) * (DM / 64);
    constexpr int NITEMS = I_IN + I_MG + I_UQ + I_UKV + I_BM + 2 * I_BG + I_O;
    for (int it = gw; it < NITEMS; it += NGW) {
        int r = it;
        if (r < I_IN) { transpose_item<false>(F.w_in + (size_t)l * DM * IN_W, DM, IN_W, F.W1, nullptr, 1.f, MapIn(), scr, r, NP / 64, F.lane); continue; } r -= I_IN;
        if (r < I_MG) { transpose_item<true>(F.w_mg + (size_t)l * DM * NG, DM, NG, F.WG8, nullptr, 64.f, MapId(), scr, r, NG / 64, F.lane); continue; } r -= I_MG;
        if (r < I_UQ) { transpose_item<false>(F.mla_wuq + (size_t)l * MLA_QR * NQ, MLA_QR, NQ, F.WUQ, F.mla_gq + l * MLA_QR, 1.f, MapUQ(), scr, r, NQ / 64, F.lane); continue; } r -= I_UQ;
        if (r < I_UKV) { transpose_item<false>(F.mla_wukv + (size_t)l * MLA_KVR * NKV, MLA_KVR, NKV, F.WUKV, F.mla_gkv + l * MLA_KVR, 1.f, MapUKV(), scr, r, NKV / 64, F.lane); continue; } r -= I_UKV;
        if (r < I_BM) { transpose_item<false>(F.w_bm + (size_t)l * 2048 * DM, 2048, DM, F.WBM, nullptr, 1.f, MapId(), scr, r, DM / 64, F.lane, DM); continue; } r -= I_BM;
        if (r < I_BG) { transpose_item<false>(F.w_bg + (size_t)l * 1024 * DM, 1024, DM, F.WBM + 2048, nullptr, 1.f, MapId(), scr, r, DM / 64, F.lane, DM); continue; } r -= I_BG;
        if (r < I_BG) { transpose_item<false>(F.w_bd + (size_t)l * 1024 * DM, 1024, DM, F.WBM + 3072, nullptr, 1.f, MapId(), scr, r, DM / 64, F.lane, DM); continue; } r -= I_BG;
        transpose_item<false>(F.w_o + (size_t)l * DM * DM, DM, DM, F.WO, nullptr, 1.f, MapId(), scr, r, DM / 64, F.lane);
    }
}
__device__ __forceinline__ void mod_phase(Frame& F) {
    LAS float* red = (LAS float*)(F.lds + 70000);
    const int ks = F.tid >> 3, cg = F.tid & 7;
    for (int it = F.c; it < 768; it += F.G) {
        const int l = it / 384, n0 = (it - l * 384) * 32;
        const float* W = F.w_ada + (size_t)l * DM * NG + n0 + 4 * cg;
        f32x4 a0 = {0.f, 0.f, 0.f, 0.f}, a1 = {0.f, 0.f, 0.f, 0.f};
#pragma unroll 4
        for (int kk = 0; kk < 64; ++kk) { const int k = ks * 64 + kk; const f32x4 w = *(const f32x4*)(W + (size_t)k * NG);
            const float c0 = F.cvec[k], c1 = F.cvec[DM + k]; const float s0 = siluf_(c0), s1 = siluf_(c1);
            a0 += w * s0; a1 += w * s1; }
        __syncthreads();
        *(LAS f32x4*)(red + (ks * 8 + cg) * 8) = a0; *(LAS f32x4*)(red + (ks * 8 + cg) * 8 + 4) = a1;
        __syncthreads();
        if (F.tid < 64) { const int cgo = F.tid >> 3, e = F.tid & 7; float s = 0.f;
            for (int k2 = 0; k2 < 64; ++k2) s += red[(k2 * 8 + cgo) * 8 + e];
            const int b = e >> 2, n = n0 + 4 * cgo + (e & 3);
            F.MOD[((size_t)l * 2 + b) * NG + n] = s + F.b_ada[(size_t)l * NG + n]; }
    }
    __syncthreads();
}
__device__ __forceinline__ void rope_phase(Frame& F) {
    for (int i = (F.c * 512 + F.tid); i < T * 32; i += F.G * 512) { const int t = i >> 5, j = i & 31;
        const float inv = (float)pow(10000.0, -(double)(2 * j) / 64.0);
        const float ang = (float)F.pos[t] * inv;
        F.COS[i] = (float)cos((double)ang); F.SIN[i] = (float)sin((double)ang); }
}
__device__ __forceinline__ void norm_phase(Frame& F, const float* xin, int l) {
    const int gw = F.c * NWAVES + F.wave, NGW = F.G * NWAVES;
    const float* g = F.norm_g + (size_t)l * DM;
    for (int m = gw; m < T; m += NGW) { const int b = m >> 13;
        const float* shift = F.MOD + ((size_t)l * 2 + b) * NG; const float* scale = shift + DM;
        const f32x4* xr = (const f32x4*)(xin + (size_t)m * DM) + F.lane;
        f32x4 v[16]; float s = 0.f;
#pragma unroll
        for (int j = 0; j < 16; ++j) { v[j] = xr[64 * j]; s += (v[j][0] * v[j][0] + v[j][1] * v[j][1]) + (v[j][2] * v[j][2] + v[j][3] * v[j][3]); }
        const float rstd = 1.0f / sqrtf(wave_sum(s) * (1.0f / DM) + NORM_EPS);
        v2u* o8 = (v2u*)(F.H + (size_t)m * DM) + F.lane;
#pragma unroll
        for (int j = 0; j < 16; ++j) { const int col = 4 * (F.lane + 64 * j);
            const f32x4 gg = *(const f32x4*)(g + col), sc = *(const f32x4*)(scale + col), sh = *(const f32x4*)(shift + col);
            const f32x4 y = v[j] * rstd * gg * (sc + 1.0f) + sh;
            v2u w; w.x = pk2(y[0], y[1]); w.y = pk2(y[2], y[3]); o8[64 * j] = w;
            int q8 = __builtin_amdgcn_cvt_pk_fp8_f32(y[0], y[1], 0, false); q8 = __builtin_amdgcn_cvt_pk_fp8_f32(y[2], y[3], q8, true);
            *(int*)(F.H8 + (size_t)m * DM + col) = q8; }
    }
}
__device__ __forceinline__ void final_phase(Frame& F) {
    const int gw = F.c * NWAVES + F.wave, NGW = F.G * NWAVES;
    f32x4 gg[16];
#pragma unroll
    for (int j = 0; j < 16; ++j) gg[j] = *(const f32x4*)(F.final_g + 4 * (F.lane + 64 * j));
    for (int m = gw; m < T; m += NGW) {
        f32x4* xr = (f32x4*)(F.out + (size_t)m * DM) + F.lane;
        f32x4 v[16]; float s = 0.f;
#pragma unroll
        for (int j = 0; j < 16; ++j) { v[j] = xr[64 * j]; s += (v[j][0] * v[j][0] + v[j][1] * v[j][1]) + (v[j][2] * v[j][2] + v[j][3] * v[j][3]); }
        const float rstd = 1.0f / sqrtf(wave_sum(s) * (1.0f / DM) + NORM_EPS);
#pragma unroll
        for (int j = 0; j < 16; ++j) xr[64 * j] = v[j] * rstd * gg[j] * OUT_SCALE;
    }
}
__device__ __forceinline__ void krope_phase(Frame& F) {
    for (int i = F.c * 512 + F.tid; i < T * 8; i += F.G * 512) { const int row = i >> 3, ch = i & 7, b = row >> 13, s = row & 8191;
        const v4u w = *(const v4u*)(F.P + (size_t)row * NP + PC_KROPE + ch * 8);
        const f32x4 c = *(const f32x4*)(F.COS + (size_t)row * 32 + ch * 4), sn = *(const f32x4*)(F.SIN + (size_t)row * 32 + ch * 4);
        v4u o; float x1, x2;
        x1 = bflo(w.x); x2 = bfhi(w.x); o.x = pk2(x1 * c[0] - x2 * sn[0], x1 * sn[0] + x2 * c[0]);
        x1 = bflo(w.y); x2 = bfhi(w.y); o.y = pk2(x1 * c[1] - x2 * sn[1], x1 * sn[1] + x2 * c[1]);
        x1 = bflo(w.z); x2 = bfhi(w.z); o.z = pk2(x1 * c[2] - x2 * sn[2], x1 * sn[2] + x2 * c[2]);
        x1 = bflo(w.w); x2 = bfhi(w.w); o.w = pk2(x1 * c[3] - x2 * sn[3], x1 * sn[3] + x2 * c[3]);
#pragma unroll
        for (int h = 0; h < 16; ++h) *(v4u*)(F.K + (((size_t)(b * 16 + h) * 8192 + s) * 192 + 128 + ch * 8)) = o; }
}

template <int K>
__device__ __forceinline__ void mma32_lds(f32x16& acc, const LAS unsigned char* A, int pa, const LAS unsigned char* B, int pb, int r32, int hi, int xa = 0, int xb = 0) {
#pragma unroll
    for (int k0 = 0; k0 < K; k0 += 16) {
        const bf16x8 a = *(const LAS bf16x8*)(A + r32 * pa + (((k0 + 8 * hi) * 2) ^ xa));
        const bf16x8 b = *(const LAS bf16x8*)(B + r32 * pb + (((k0 + 8 * hi) * 2) ^ xb));
        acc = __builtin_amdgcn_mfma_f32_32x32x16_bf16(a, b, acc, 0, 0, 0);
    }
}
constexpr int GL_BC = 0, GL_GL = 32768, GL_W2 = 36864, GL_BG = 45056, GL_X = 45568, GL_TOT = 131072;
__device__ __forceinline__ void gla_gates(Frame& F, int l, int b, int h, int n) {
    LAS float* bc = (LAS float*)(F.lds + GL_BC); LAS float* gl = (LAS float*)(F.lds + GL_GL); LAS float* w2 = (LAS float*)(F.lds + GL_W2); LAS float* bgs = (LAS float*)(F.lds + GL_BG);
    const size_t row0 = (size_t)b * SEQ + (size_t)n * GLA_C;
    for (int i = F.tid; i < 1024; i += 512) { const int c = i >> 4, r = i & 15; gl[i] = bf2f(F.P[(row0 + c) * NP + PC_GLOW + r]); }
    for (int i = F.tid; i < 2048; i += 512) { const int r = i >> 7, d = i & 127; w2[i] = F.gla_wg2[((size_t)l * GLA_R + r) * 512 + h * 128 + d]; }
    if (F.tid < 128) bgs[F.tid] = F.gla_bg[(size_t)l * 512 + h * 128 + F.tid];
    __syncthreads();
    { const int d = F.tid & 127, cg = F.tid >> 7; float run = 0.f, vals[16];
      LAS float* tot = (LAS float*)(F.lds + GL_TOT);
#pragma unroll
      for (int cc = 0; cc < 16; ++cc) { const int c = cg * 16 + cc; float xx = bgs[d];
#pragma unroll
          for (int r = 0; r < 16; ++r) xx += gl[c * 16 + r] * w2[r * 128 + d];
          const float ls = fminf(xx, 0.f) - log1pf(expf(-fabsf(xx)));
          run += ls * (1.0f / 16.0f); vals[cc] = run; }
      tot[cg * 128 + d] = run;
      __syncthreads();
      float off = 0.f;
      for (int g2 = 0; g2 < cg; ++g2) off += tot[g2 * 128 + d];
#pragma unroll
      for (int cc = 0; cc < 16; ++cc) bc[(cg * 16 + cc) * 128 + d] = vals[cc] + off; }
    __syncthreads();
}
__device__ __forceinline__ void gla1_phase(Frame& F, int l) {
    constexpr int PT = 144;
    LAS float* bc = (LAS float*)(F.lds + GL_BC);
    LAS unsigned char* keT = F.lds + GL_X; LAS unsigned char* vT = F.lds + GL_X + 128 * PT;
    const int r32 = F.lane & 31, hi = F.lane >> 5;
    for (int u = F.c; u < 8 * GLA_NCH; u += F.G) { const int bh = u >> 7, n = u & 127, b = bh >> 2, h = bh & 3;
        const size_t row0 = (size_t)b * SEQ + (size_t)n * GLA_C;
        const int c = F.tid >> 3, d8 = F.tid & 7;
        const bf16* kp = F.P + (row0 + c) * NP + PC_GK + h * 128 + d8 * 16; const v4u k0 = *(const v4u*)kp, k1 = *(const v4u*)(kp + 8);
        const bf16* vp = F.P + (row0 + c) * NP + PC_GV + h * 256 + d8 * 32; v4u vq[4];
#pragma unroll
        for (int q4 = 0; q4 < 4; ++q4) vq[q4] = *(const v4u*)(vp + q4 * 8);
        gla_gates(F, l, b, h, n);
        { float* bg_ = F.BCG + (size_t)u * 8192;
#pragma unroll
          for (int j = 0; j < 4; ++j) *(f32x4*)(bg_ + j * 2048 + F.tid * 4) = *(const LAS f32x4*)(bc + j * 2048 + F.tid * 4); }
        { const unsigned kw[8] = {k0.x, k0.y, k0.z, k0.w, k1.x, k1.y, k1.z, k1.w};
#pragma unroll
          for (int jj = 0; jj < 16; ++jj) { const int d = d8 * 16 + jj; const float kv = (jj & 1) ? bfhi(kw[jj >> 1]) : bflo(kw[jj >> 1]);
              const float ke = kv * expf(bc[63 * 128 + d] - bc[c * 128 + d]);
              *(LAS bf16*)(keT + d * PT + ((c ^ (8 * d8)) * 2)) = (bf16)f2bf(ke); }
#pragma unroll
          for (int q4 = 0; q4 < 4; ++q4) { const v4u vv = vq[q4]; const unsigned vw[4] = {vv.x, vv.y, vv.z, vv.w};
#pragma unroll
              for (int jj = 0; jj < 8; ++jj) { const int e = d8 * 32 + q4 * 8 + jj; *(LAS bf16*)(vT + e * PT + ((c ^ (8 * d8)) * 2)) = (bf16)((jj & 1) ? (vw[jj >> 1] >> 16) : (vw[jj >> 1] & 0xffffu)); } }
          if (F.tid < 128) F.DEC[((size_t)bh * GLA_NCH + n) * 128 + F.tid] = expf(bc[63 * 128 + F.tid]); }
        __syncthreads();
        bf16* UTn = F.UT + ((size_t)bh * GLA_NCH + n) * (256 * 128);
#pragma unroll 1
        for (int dt = 0; dt < 4; ++dt) { f32x16 acc = {};
            mma32_lds<64>(acc, keT + (dt * 32) * PT, PT, vT + (F.wave * 32) * PT, PT, r32, hi, 16 * ((2 * dt + (r32 >> 4)) & 7), 16 * F.wave);
#pragma unroll
            for (int g4 = 0; g4 < 4; ++g4) { v2u w; w.x = pk2(acc[4 * g4], acc[4 * g4 + 1]); w.y = pk2(acc[4 * g4 + 2], acc[4 * g4 + 3]);
                *(v2u*)(UTn + (size_t)(F.wave * 32 + r32) * 128 + dt * 32 + 8 * g4 + 4 * hi) = w; } }
        __syncthreads();
    }
}
__device__ __forceinline__ void gla2_phase(Frame& F) {
    for (int gid = F.c * 512 + F.tid; gid < 8 * 16384; gid += F.G * 512) { const int bh = gid >> 14, pr = gid & 16383, d = (2 * pr) & 127;
        unsigned* up = (unsigned*)(F.UT + (size_t)bh * GLA_NCH * 32768 + 2 * pr); const float* dp = F.DEC + (size_t)bh * GLA_NCH * 128 + d;
        float s0 = 0.f, s1 = 0.f;
        unsigned uu[8]; f32x2 dd[8];
#pragma unroll
        for (int j = 0; j < 8; ++j) { uu[j] = up[(size_t)j * 16384]; dd[j] = *(const f32x2*)(dp + j * 128); }
#pragma unroll 1
        for (int n0 = 0; n0 < GLA_NCH; n0 += 8) { unsigned un[8]; f32x2 dn[8]; const int nn = (n0 + 8 < GLA_NCH) ? n0 + 8 : n0;
#pragma unroll
            for (int j = 0; j < 8; ++j) { un[j] = up[(size_t)(nn + j) * 16384]; dn[j] = *(const f32x2*)(dp + (nn + j) * 128); }
            asm volatile("" ::: "memory");
#pragma unroll
            for (int j = 0; j < 8; ++j) { up[(size_t)(n0 + j) * 16384] = pk2(s0, s1); s0 = dd[j].x * s0 + bflo(uu[j]); s1 = dd[j].y * s1 + bfhi(uu[j]); }
#pragma unroll
            for (int j = 0; j < 8; ++j) { uu[j] = un[j]; dd[j] = dn[j]; } }
    }
}
__device__ __forceinline__ void gla3_phase(Frame& F, int l) {
    constexpr int PT = 144, PD = 272, PO = 1040;
    LAS float* bc = (LAS float*)(F.lds + GL_BC);
    LAS unsigned char* qd = F.lds + GL_X; LAS unsigned char* ki = qd + 64 * PD; LAS unsigned char* vT = ki + 64 * PD; LAS unsigned char* at = vT + 256 * PT;
    LAS unsigned char* of = F.lds;
    const int r32 = F.lane & 31, hi = F.lane >> 5;
    for (int u = F.c; u < 8 * GLA_NCH; u += F.G) { const int bh = u >> 7, n = u & 127, b = bh >> 2, h = bh & 3;
        const size_t row0 = (size_t)b * SEQ + (size_t)n * GLA_C;
        const int c = F.tid >> 3, d8 = F.tid & 7;
        const bf16* qp = F.P + (row0 + c) * NP + PC_GQ + h * 128 + d8 * 16; const v4u q0 = *(const v4u*)qp, q1 = *(const v4u*)(qp + 8);
        const bf16* kp = F.P + (row0 + c) * NP + PC_GK + h * 128 + d8 * 16; const v4u k0 = *(const v4u*)kp, k1 = *(const v4u*)(kp + 8);
        const bf16* vp = F.P + (row0 + c) * NP + PC_GV + h * 256 + d8 * 32; v4u vq[4];
#pragma unroll
        for (int q4 = 0; q4 < 4; ++q4) vq[q4] = *(const v4u*)(vp + q4 * 8);
        { const float* bg_ = F.BCG + (size_t)u * 8192; f32x4 bq[4];
#pragma unroll
          for (int j = 0; j < 4; ++j) bq[j] = *(const f32x4*)(bg_ + j * 2048 + F.tid * 4);
#pragma unroll
          for (int j = 0; j < 4; ++j) *(LAS f32x4*)(bc + j * 2048 + F.tid * 4) = bq[j]; }
        __syncthreads();
        { const unsigned qw[8] = {q0.x, q0.y, q0.z, q0.w, q1.x, q1.y, q1.z, q1.w}, kw[8] = {k0.x, k0.y, k0.z, k0.w, k1.x, k1.y, k1.z, k1.w};
          unsigned qo[8], ko[8];
#pragma unroll
          for (int j2 = 0; j2 < 8; ++j2) { const int d = d8 * 16 + 2 * j2; const float b0 = bc[c * 128 + d], b1 = bc[c * 128 + d + 1];
              qo[j2] = pk2(bflo(qw[j2]) * 0.08838834764831845f * expf(b0), bfhi(qw[j2]) * 0.08838834764831845f * expf(b1));
              ko[j2] = pk2(bflo(kw[j2]) * expf(-b0), bfhi(kw[j2]) * expf(-b1)); }
          *(LAS v4u*)(qd + c * PD + d8 * 32) = (v4u){qo[0], qo[1], qo[2], qo[3]}; *(LAS v4u*)(qd + c * PD + d8 * 32 + 16) = (v4u){qo[4], qo[5], qo[6], qo[7]};
          *(LAS v4u*)(ki + c * PD + d8 * 32) = (v4u){ko[0], ko[1], ko[2], ko[3]}; *(LAS v4u*)(ki + c * PD + d8 * 32 + 16) = (v4u){ko[4], ko[5], ko[6], ko[7]};
#pragma unroll
          for (int q4 = 0; q4 < 4; ++q4) { const v4u vv = vq[q4]; const unsigned vw[4] = {vv.x, vv.y, vv.z, vv.w};
#pragma unroll
              for (int jj = 0; jj < 8; ++jj) { const int e = d8 * 32 + q4 * 8 + jj; *(LAS bf16*)(vT + e * PT + ((c ^ (8 * d8)) * 2)) = (bf16)((jj & 1) ? (vw[jj >> 1] >> 16) : (vw[jj >> 1] & 0xffffu)); } } }
        bf16x8 sfr[8];
        { const bf16* sp = F.UT + (((size_t)bh * GLA_NCH + n) * 256 + F.wave * 32 + r32) * 128 + 8 * hi;
#pragma unroll
          for (int k0_ = 0; k0_ < 8; ++k0_) sfr[k0_] = *(const bf16x8*)(sp + k0_ * 16); }
        __syncthreads();
        if (F.wave < 4) { const int ct = F.wave >> 1, st = F.wave & 1; f32x16 acc = {};
            mma32_lds<128>(acc, qd + (ct * 32) * PD, PD, ki + (st * 32) * PD, PD, r32, hi);
#pragma unroll
            for (int i = 0; i < 16; ++i) { const int c = ct * 32 + crow(i, hi), s = st * 32 + r32; *(LAS bf16*)(at + c * PT + s * 2) = (bf16)f2bf(c >= s ? acc[i] : 0.f); } }
        __syncthreads();
        f32x16 o0 = {}, o1 = {};
        mma32_lds<64>(o0, at, PT, vT + (F.wave * 32) * PT, PT, r32, hi, 0, 16 * F.wave);
        mma32_lds<64>(o1, at + 32 * PT, PT, vT + (F.wave * 32) * PT, PT, r32, hi, 0, 16 * F.wave);
        {
#pragma unroll
          for (int k0 = 0; k0 < 8; ++k0) { const bf16x8 bb = sfr[k0];
              const bf16x8 a0 = *(const LAS bf16x8*)(qd + r32 * PD + (k0 * 16 + 8 * hi) * 2), a1 = *(const LAS bf16x8*)(qd + (32 + r32) * PD + (k0 * 16 + 8 * hi) * 2);
              o0 = __builtin_amdgcn_mfma_f32_32x32x16_bf16(a0, bb, o0, 0, 0, 0); o1 = __builtin_amdgcn_mfma_f32_32x32x16_bf16(a1, bb, o1, 0, 0, 0); } }
        const f32x4 gg = *(const f32x4*)(F.gla_gout + (size_t)l * 256 + 4 * F.lane); v2u zq[8];
#pragma unroll
        for (int rr = 0; rr < 8; ++rr) zq[rr] = *(const v2u*)(F.P + (row0 + F.wave * 8 + rr) * NP + PC_ZGLA + h * 256 + 4 * F.lane);
        __syncthreads();
#pragma unroll
        for (int i = 0; i < 16; ++i) { const int c = crow(i, hi), e = F.wave * 32 + r32; *(LAS float*)(of + c * PO + e * 4) = o0[i]; *(LAS float*)(of + (32 + c) * PO + e * 4) = o1[i]; }
        __syncthreads();
        {
#pragma unroll
          for (int rr = 0; rr < 8; ++rr) { const int c = F.wave * 8 + rr; const f32x4 v = *(const LAS f32x4*)(of + c * PO + F.lane * 16);
              const float ss = wave_sum_dpp((v[0] * v[0] + v[1] * v[1]) + (v[2] * v[2] + v[3] * v[3]));
              const float rs = 1.0f / sqrtf(ss * (1.0f / 256.0f) + NORM_EPS);
              const v2u zz = zq[rr];
              v2u w; w.x = pk2(v[0] * rs * gg[0] * bflo(zz.x), v[1] * rs * gg[1] * bfhi(zz.x)); w.y = pk2(v[2] * rs * gg[2] * bflo(zz.y), v[3] * rs * gg[3] * bfhi(zz.y));
              *(v2u*)(F.Y + (row0 + c) * DM + YC_GLA + h * 256 + 4 * F.lane) = w; } }
        __syncthreads();
    }
}

__device__ __forceinline__ int ik_off(int r, int c) { return (r >> 1) * 256 + (((((r & 1) << 3) | c) ^ ((r >> 1) & 15)) << 4); }
__device__ __forceinline__ unsigned mono_key(float f) { const unsigned u = __builtin_bit_cast(unsigned, f); return (u & 0x80000000u) ? ~u : (u | 0x80000000u); }
typedef unsigned v32u __attribute__((ext_vector_type(32)));
#define KREG(i) ((i) < 32 ? k0[(i) & 31] : (i) < 64 ? k1[(i) & 31] : (i) < 96 ? k2[(i) & 31] : k3[(i) & 31])
__device__ __forceinline__ int wsum_dpp(int v) {
    v += __builtin_amdgcn_update_dpp(0, v, 0xB1, 0xF, 0xF, true);
    v += __builtin_amdgcn_update_dpp(0, v, 0x4E, 0xF, 0xF, true);
    v += __builtin_amdgcn_update_dpp(0, v, 0x141, 0xF, 0xF, true);
    v += __builtin_amdgcn_update_dpp(0, v, 0x140, 0xF, 0xF, true);
    return __builtin_amdgcn_readlane(v, 0) + __builtin_amdgcn_readlane(v, 16) + __builtin_amdgcn_readlane(v, 32) + __builtin_amdgcn_readlane(v, 48);
}
__device__ __forceinline__ unsigned wmax_dpp(unsigned v) {
    { const unsigned t = (unsigned)__builtin_amdgcn_update_dpp(0, (int)v, 0xB1, 0xF, 0xF, true); v = v > t ? v : t; }
    { const unsigned t = (unsigned)__builtin_amdgcn_update_dpp(0, (int)v, 0x4E, 0xF, 0xF, true); v = v > t ? v : t; }
    { const unsigned t = (unsigned)__builtin_amdgcn_update_dpp(0, (int)v, 0x141, 0xF, 0xF, true); v = v > t ? v : t; }
    { const unsigned t = (unsigned)__builtin_amdgcn_update_dpp(0, (int)v, 0x140, 0xF, 0xF, true); v = v > t ? v : t; }
    const unsigned a = (unsigned)__builtin_amdgcn_readlane((int)v, 0), b = (unsigned)__builtin_amdgcn_readlane((int)v, 16), c = (unsigned)__builtin_amdgcn_readlane((int)v, 32), d = (unsigned)__builtin_amdgcn_readlane((int)v, 48);
    const unsigned ab = a > b ? a : b, cd = c > d ? c : d; return ab > cd ? ab : cd;
}
#ifndef SEL_CMAX
#define SEL_CMAX 1024
#endif
#ifndef SEL_MAXSKIP
#define SEL_MAXSKIP 1
#endif
__device__ __forceinline__ void dsa_select_regs(const v32u& k0, const v32u& k1, const v32u& k2, const v32u& k3, int lane, int tq, int* out, LAS unsigned* cl) {
    if (tq < TOPK) { for (int j = lane; j < TOPK; j += 64) out[j] = (j <= tq) ? j : -1; return; }
    const int ngrp = (tq >> 10) + 1;
    unsigned Tk = 0u; int cnt_lo = tq + 1, cnt_hi = 0, bit = 31; bool decided = false, compacted = false;
#if SEL_MAXSKIP
    unsigned kmax;
    { unsigned m = 0u;
#pragma unroll
      for (int g = 0; g < 8; ++g) if (g < ngrp) {
#pragma unroll
        for (int i = 0; i < 16; ++i) { const unsigned kv = KREG(g * 16 + i); m = m > kv ? m : kv; } }
      kmax = wmax_dpp(m); }
#endif
#pragma unroll 1
    for (; bit >= 0; --bit) { const unsigned cand = Tk | (1u << bit); int c_ = 0;
#if SEL_MAXSKIP
        if (cand > kmax) continue;
#endif
#pragma unroll
        for (int g = 0; g < 8; ++g) if (g < ngrp) {
#pragma unroll
            for (int i = 0; i < 16; ++i) c_ += (KREG(g * 16 + i) >= cand) ? 1 : 0; }
        const int cnt = wsum_dpp(c_);
        if (cnt >= TOPK) { Tk = cand; cnt_lo = cnt; } else cnt_hi = cnt;
        if (cnt == TOPK) { decided = true; break; }
        if (SEL_CMAX > 0 && Tk != 0u && cnt_lo - cnt_hi <= SEL_CMAX && bit >= 3) { compacted = true; break; } }
    if (compacted && !decided) {
        const unsigned wdt = 1u << bit; int base = 0;
#pragma unroll
        for (int g = 0; g < 8; ++g) if (g < ngrp) {
#pragma unroll
            for (int i = 0; i < 16; ++i) { const unsigned kv = KREG(g * 16 + i); const bool in = (kv ^ Tk) < wdt; const unsigned long long bm = __ballot(in);
                const int pos = (int)__builtin_amdgcn_mbcnt_hi((unsigned)(bm >> 32), __builtin_amdgcn_mbcnt_lo((unsigned)bm, (unsigned)base));
                if (in) cl[pos] = kv;
                base += __popcll(bm); } }
        unsigned c[16];
#pragma unroll
        for (int j = 0; j < 16; ++j) { const int p_ = j * 64 + lane; c[j] = (p_ < base) ? cl[p_] : 0u; }
#pragma unroll 1
        for (--bit; bit >= 0; --bit) { const unsigned cand = Tk | (1u << bit); int c_ = 0;
#pragma unroll
            for (int j = 0; j < 16; ++j) c_ += (c[j] >= cand) ? 1 : 0;
            const int cnt = cnt_hi + wsum_dpp(c_);
            if (cnt >= TOPK) Tk = cand;
            if (cnt == TOPK) break; } }
    int base = 0;
#pragma unroll
    for (int g = 0; g < 8; ++g) if (g < ngrp) {
#pragma unroll
        for (int i2 = 0; i2 < 16; ++i2) { const int i = g * 16 + i2; const bool gt = KREG(i) > Tk; const unsigned long long bm = __ballot(gt);
            const int pos = (int)__builtin_amdgcn_mbcnt_hi((unsigned)(bm >> 32), __builtin_amdgcn_mbcnt_lo((unsigned)bm, (unsigned)base));
            if (gt) out[pos] = i * 64 + lane;
            base += __popcll(bm); } }
    if (base < TOPK) {
#pragma unroll
        for (int g = 0; g < 8; ++g) if (g < ngrp) {
#pragma unroll
            for (int i2 = 0; i2 < 16; ++i2) { const int i = g * 16 + i2; const bool eq = KREG(i) == Tk; const unsigned long long bm = __ballot(eq);
                if (bm != 0ull && base < TOPK) {
                    const int pos = (int)__builtin_amdgcn_mbcnt_hi((unsigned)(bm >> 32), __builtin_amdgcn_mbcnt_lo((unsigned)bm, (unsigned)base));
                    if (eq && pos < TOPK) out[pos] = i * 64 + lane;
                    base += __popcll(bm); } } } }
}
template <int MODE>
__device__ __forceinline__ void dsa_index_phase(Frame& F) {
    LAS unsigned char* kbuf = F.lds;
    const int lane = F.lane, r32 = lane & 31, hi = lane >> 5;
    for (int L = F.c; L < 2048; L += F.G) { const int bb = L >> 10, r = L & 1023, j = r >> 8, w_ = r & 255, u = (j & 1) ? j * 256 + 255 - w_ : j * 256 + w_;
        const int t0 = 8 * u, tq = t0 + F.wave; const size_t row = (size_t)bb * SEQ + tq;
        const int nstage = (t0 + 7) / 256 + 1;
        bf16x8 afr[4]; f32x2 wv2[8];
#pragma unroll
        for (int ks = 0; ks < 4; ++ks) afr[ks] = *(const bf16x8*)(F.P + row * NP + PC_IQ + r32 * 64 + ks * 16 + hi * 8);
#pragma unroll
        for (int i = 0; i < 8; ++i) { wv2[i].x = bf2f(F.P[row * NP + PC_IW + crow(2 * i, hi)]); wv2[i].y = bf2f(F.P[row * NP + PC_IW + crow(2 * i + 1, hi)]); }
        const char* kp0 = (const char*)(F.IKC + ((size_t)bb * SEQ + F.wave * 32) * 64);
#define IDX_STAGE_DMA(s_) do { LAS unsigned char* db = kbuf + ((s_) & 1) * 32768 + F.wave * 4096; int ln_ = lane; asm volatile("" : "+v"(ln_));                    \
        const char* sb_ = kp0 + (size_t)(s_) * 256 * 128;                                                                                                         \
        _Pragma("unroll") for (int i = 0; i < 4; ++i) { const int Rl = i * 4 + (ln_ >> 4), x = (ln_ & 15) ^ Rl, rr_ = 2 * Rl + (x >> 3), cc_ = x & 7;              \
            __builtin_amdgcn_global_load_lds((const unsigned*)(sb_ + (unsigned)(rr_ * 128 + cc_ * 16)), (LAS unsigned*)(db + i * 1024), 16, 0, 0); } } while (0)
        IDX_STAGE_DMA(0);
        asm volatile("s_waitcnt vmcnt(0)" ::: "memory"); __syncthreads();
        v32u k0 = {}, k1 = {}, k2 = {}, k3 = {};
#define IDX_MM(ACC, T_) do { ACC = f32x16{}; _Pragma("unroll") for (int ks = 0; ks < 4; ++ks) ACC = __builtin_amdgcn_mfma_f32_32x32x16_bf16(afr[ks], *(const LAS bf16x8*)(kb + ik_off((T_) * 32 + r32, 2 * ks + hi)), ACC, 0, 0, 0); } while (0)
#define IDX_R2(PA_, J_, ACC) do { const float xa_ = ACC[2 * (J_)], xb_ = ACC[2 * (J_) + 1]; const int ia_ = __float_as_int(xa_), ib_ = __float_as_int(xb_);                          \
        const f32x2 r_ = {__int_as_float(ia_ > 0 ? ia_ : 0), __int_as_float(ib_ > 0 ? ib_ : 0)}; PA_ = __builtin_elementwise_fma(r_, wv2[J_], PA_); } while (0)
#define IDX_RED(P_, ACC) do { f32x2 pa_ = {0.f, 0.f}, pb_ = {0.f, 0.f}; IDX_R2(pa_, 0, ACC); IDX_R2(pb_, 1, ACC); IDX_R2(pa_, 2, ACC); IDX_R2(pb_, 3, ACC);                            \
        IDX_R2(pa_, 4, ACC); IDX_R2(pb_, 5, ACC); IDX_R2(pa_, 6, ACC); IDX_R2(pb_, 7, ACC); pa_ += pb_; P_ = pa_.x + pa_.y; } while (0)
#define IDX_SGB() do { __builtin_amdgcn_sched_group_barrier(0x100, 4, 0); __builtin_amdgcn_sched_group_barrier(0x2, 6, 0);                                       \
        __builtin_amdgcn_sched_group_barrier(0x8, 1, 0); __builtin_amdgcn_sched_group_barrier(0x2, 7, 0); __builtin_amdgcn_sched_group_barrier(0x8, 1, 0);         \
        __builtin_amdgcn_sched_group_barrier(0x2, 7, 0); __builtin_amdgcn_sched_group_barrier(0x8, 1, 0); __builtin_amdgcn_sched_group_barrier(0x2, 7, 0);         \
        __builtin_amdgcn_sched_group_barrier(0x8, 1, 0); } while (0)
#define IDX_QUARTER(KV, S0) do { const int s_end = (nstage < (S0) + 8) ? nstage : (S0) + 8;                                                               \
        _Pragma("unroll 1") for (int s = (S0); s < s_end; ++s) {                                                                                         \
            LAS unsigned char* kb = kbuf + (s & 1) * 32768;                                                                                              \
            if (s + 1 < nstage) IDX_STAGE_DMA(s + 1);                                           \
              \
              \
            f32x16 accA_, accB_; float pA, pB;                                                                                                           \
            IDX_MM(accA_, 0); __builtin_amdgcn_sched_barrier(0);                                                                                         \
            _Pragma("unroll") for (int c = 0; c < 4; ++c) { const int kb0 = s * 256 + c * 64;                                                            \
                IDX_MM(accB_, 2 * c + 1); IDX_RED(pA, accA_); IDX_SGB(); __builtin_amdgcn_sched_barrier(0);                                               \
                if (c < 3) { IDX_MM(accA_, 2 * c + 2); IDX_RED(pB, accB_); IDX_SGB(); } else { IDX_RED(pB, accB_); }                                      \
                __builtin_amdgcn_sched_barrier(0);                                                                                                       \
                auto rr = __builtin_amdgcn_permlane32_swap(__float_as_uint(pA), __float_as_uint(pB), false, false);                                      \
                const float sc = __uint_as_float(rr[0]) + __uint_as_float(rr[1]);                                                                        \
                KV[(s - (S0)) * 4 + c] = (kb0 + lane <= tq) ? mono_key(sc) : 0u; }                                                                      \
            asm volatile("s_waitcnt vmcnt(0)" ::: "memory"); __syncthreads();                  \
        } } while (0)
        if (MODE != 2) { IDX_QUARTER(k0, 0); IDX_QUARTER(k1, 8); IDX_QUARTER(k2, 16); IDX_QUARTER(k3, 24); }
        else { for (int i = 0; i < 32; ++i) { const unsigned hsh = (unsigned)(i * 64 + lane) * 2654435761u; k0[i] = (i * 64 + lane <= tq) ? (hsh | 1u) : 0u; k1[i] = ((32 + i) * 64 + lane <= tq) ? ((hsh * 3u) | 1u) : 0u; k2[i] = ((64 + i) * 64 + lane <= tq) ? ((hsh * 5u) | 1u) : 0u; k3[i] = ((96 + i) * 64 + lane <= tq) ? ((hsh * 7u) | 1u) : 0u; } }
#undef IDX_QUARTER
#undef IDX_SGB
#undef IDX_MM
#undef IDX_RED
#undef IDX_R2
#undef IDX_STAGE_DMA
        if (MODE == 0) dsa_select_regs(k0, k1, k2, k3, lane, tq, F.IDX + row * TOPK, (LAS unsigned*)(F.lds + 65536 + F.wave * 4096));
        if (MODE == 1) { unsigned acc_ = 0; for (int i = 0; i < 32; ++i) acc_ += k0[i] + k1[i] + k2[i] + k3[i]; if (acc_ == 0x12345u) F.SSQ[0] = 1.f; }
        if (MODE == 2) dsa_select_regs(k0, k1, k2, k3, lane, tq, (int*)F.V + row * TOPK, (LAS unsigned*)(F.lds + 65536 + F.wave * 4096));
    }
}
#ifndef DSA_OUT_SCALE
#define DSA_OUT_SCALE 1.0f
#endif
#define DPPF(v, ctrl) __builtin_bit_cast(float, __builtin_amdgcn_update_dpp(0, __builtin_bit_cast(int, (v)), (ctrl), 0xF, 0xF, true))
__device__ __forceinline__ float row16_max(float v) { v = fmaxf(v, DPPF(v, 0xB1)); v = fmaxf(v, DPPF(v, 0x4E)); v = fmaxf(v, DPPF(v, 0x141)); v = fmaxf(v, DPPF(v, 0x140)); return v; }
__device__ __forceinline__ float row16_sum(float v) { v += DPPF(v, 0xB1); v += DPPF(v, 0x4E); v += DPPF(v, 0x141); v += DPPF(v, 0x140); return v; }
__device__ __forceinline__ void dsa_attn_phase(Frame& F) {
    LAS unsigned char* ptb = F.lds + F.wave * 12288;
    LAS int* kidx0 = (LAS int*)(F.lds + F.wave * 12288 + 2048);
    LAS unsigned char* vimg = F.lds + F.wave * 12288 + 4096;
    const int lane = F.lane, m16 = lane & 15, kq = lane >> 4;
    const int lkey = lane >> 2, lch = lane & 3, lsrc = ((m16 << 2) | kq) << 2;
    const int row_first = F.c * NWAVES + F.wave, row_step = F.G * NWAVES;
    if (row_first >= T) return;
    const int tq_ = m16 >> 2, tp_ = m16 & 3;
    const int cA = (int)(uintptr_t)vimg + 256 * (8 * kq + tq_) + 8 * (tp_ & 1) + 16 * ((tp_ >> 1) ^ ((tq_ << 2) | ((2 * kq) & 3)));
    v4u gA[16], gB[16]; bf16x8 afr[4];
#define DSA_LOADK(BUF, C_, KI, KB, KO) do { _Pragma("unroll") for (int t4 = 0; t4 < 4; ++t4) { const int kj_ = (KI)[((C_) * 4 + t4) * 16 + lkey]; const unsigned ko_ = (unsigned)(kj_ < 0 ? 0 : kj_) * 1024u + (KO); \
            _Pragma("unroll") for (int ks = 0; ks < 4; ++ks) BUF[t4 * 4 + ks] = *(const v4u*)((KB) + ko_ + ks * 64); } } while (0)
#define DSA_LOADQ(ROW, G_) do { unsigned qmask = (m16 < 4) ? 0xffffffffu : 0u; asm volatile("" : "+v"(qmask));         \
        _Pragma("unroll") for (int ks = 0; ks < 4; ++ks) { const bf16x8 t_ = *(const bf16x8*)(F.P + (size_t)(ROW) * NP + PC_DQ + ((G_) * 4 + (m16 & 3)) * 128 + ks * 32 + kq * 8);    \
            v4u u_ = __builtin_bit_cast(v4u, t_); u_.x &= qmask; u_.y &= qmask; u_.z &= qmask; u_.w &= qmask; afr[ks] = __builtin_bit_cast(bf16x8, u_); } } while (0)
#define DSA_LOADV(BUF, B_) do { _Pragma("unroll") for (int q2 = 0; q2 < 16; ++q2) { const int kj_ = kidx[(((q2 & 3) * 4 + kq) * 16) + 2 * (2 * (B_) + (q2 >> 3)) + ((q2 & 7) >> 2)]; BUF[q2] = *(const v4u*)(dbase + ((unsigned)(kj_ < 0 ? 0 : kj_) * 1024u + voff)); } } while (0)
#define DSA_QK(BUF, C_) do { _Pragma("unroll") for (int t4 = 0; t4 < 4; ++t4) { const int kjm_ = kidx[((C_) * 4 + t4) * 16 + m16]; f32x4 acc = {0.f, 0.f, 0.f, 0.f};                  \
            _Pragma("unroll") for (int ks = 0; ks < 4; ++ks) { v4u w; const v4u r_ = BUF[t4 * 4 + ks];                                                                         \
                w.x = (unsigned)__builtin_amdgcn_ds_bpermute(lsrc, (int)r_.x); w.y = (unsigned)__builtin_amdgcn_ds_bpermute(lsrc, (int)r_.y);                                  \
                w.z = (unsigned)__builtin_amdgcn_ds_bpermute(lsrc, (int)r_.z); w.w = (unsigned)__builtin_amdgcn_ds_bpermute(lsrc, (int)r_.w);                                  \
                acc = __builtin_amdgcn_mfma_f32_16x16x32_bf16(afr[ks], *reinterpret_cast<bf16x8*>(&w), acc, 0, 0, 0); }                                                       \
            _Pragma("unroll") for (int i = 0; i < 4; ++i) sc[(C_) * 4 + t4][i] = (kjm_ >= 0) ? acc[i] * (0.08838834764831845f * 1.4426950408889634f) : -__builtin_inff(); } } while (0)
#define DSA_TRRD(dst, addr) asm volatile("ds_read_b64_tr_b16 %0, %1" : "=&v"(dst) : "v"(addr) : "memory")
#define DSA_TRRD4(dst, addr) asm volatile("ds_read_b64_tr_b16 %0, %1 offset:1024" : "=&v"(dst) : "v"(addr) : "memory")
#define DSA_PV(BUF, B_) do { int lw_ = lane; asm volatile("" : "+v"(lw_)); const int wb0 = 256 * (lw_ >> 4) + 16 * ((lw_ & 15) ^ ((lw_ >> 4) << 2));     \
        _Pragma("unroll") for (int h_ = 0; h_ < 2; ++h_) { const int s_ = 2 * (B_) + h_;                                                                  \
            _Pragma("unroll") for (int q2l = 0; q2l < 8; ++q2l) *(LAS v4u*)(vimg + ((wb0 ^ ((q2l & 3) << 4)) + 1024 * q2l)) = BUF[h_ * 8 + q2l];                                \
            const bf16x8 a_ = *(const LAS bf16x8*)(ptb + (m16 & 3) * 512 + s_ * 64 + kq * 16);                                                                                    \
            _Pragma("unroll") for (int tq4 = 0; tq4 < 2; ++tq4) { s16x4 l_[4], hh_[4];        \
                _Pragma("unroll") for (int t = 0; t < 4; ++t) { DSA_TRRD(l_[t], cA ^ (32 * (4 * tq4 + t))); DSA_TRRD4(hh_[t], cA ^ (32 * (4 * tq4 + t) + 16)); }                 \
                asm volatile("s_waitcnt lgkmcnt(0)" ::: "memory"); __builtin_amdgcn_sched_barrier(0);                                                                            \
                _Pragma("unroll") for (int t = 0; t < 4; ++t)                                                                                                                    \
                    o[4 * tq4 + t] = __builtin_amdgcn_mfma_f32_16x16x32_bf16(a_, (bf16x8){l_[t][0], l_[t][1], l_[t][2], l_[t][3], hh_[t][0], hh_[t][1], hh_[t][2], hh_[t][3]}, o[4 * tq4 + t], 0, 0, 0); } } } while (0)
#define DSA_FENCE() __builtin_amdgcn_sched_barrier(0)
    { int ln_ = lane; asm volatile("" : "+v"(ln_)); const int* ip = F.IDX + (size_t)row_first * TOPK;
#pragma unroll
      for (int j = 0; j < 4; ++j) kidx0[ln_ + 64 * j] = ip[ln_ + 64 * j]; }
    LDS_WAIT(); asm volatile("" ::: "memory");
    { const char* kb_ = (const char*)(F.DKV + (size_t)(row_first >> 13) * SEQ * 512); const unsigned ko0_ = (unsigned)lch * 16u;
      DSA_LOADQ(row_first, 0); DSA_LOADK(gA, 0, kidx0, kb_, ko0_); DSA_FENCE(); DSA_LOADK(gB, 1, kidx0, kb_, ko0_); DSA_FENCE(); }
    int kbuf = 0;
#pragma unroll 1
    for (int row = row_first; row < T; row += row_step) { const int bb = row >> 13, nrow = row + row_step; const bool hasn = nrow < T;
        LAS int* kidx = kidx0 + kbuf * 256; LAS int* kidxn = kidx0 + (kbuf ^ 1) * 256;
#pragma unroll 1
        for (int g = 0; g < 2; ++g) {
            float sc[16][4];
            const char* dbase = (const char*)(F.DKV + (size_t)bb * SEQ * 512);
            const unsigned koff = (unsigned)(g * 256 + lch * 16), voff = (unsigned)(512 + g * 256 + m16 * 16);
            DSA_QK(gA, 0); DSA_FENCE(); DSA_LOADK(gA, 2, kidx, dbase, koff); DSA_FENCE();
            DSA_QK(gB, 1); DSA_FENCE(); DSA_LOADK(gB, 3, kidx, dbase, koff); DSA_FENCE();
            DSA_QK(gA, 2); DSA_FENCE(); DSA_LOADV(gA, 0); DSA_FENCE();
            DSA_QK(gB, 3); DSA_FENCE(); DSA_LOADV(gB, 1); DSA_FENCE();
            const int xrow = (g == 0 || !hasn) ? row : nrow, xg = g ^ 1;
            int smu[4];
#pragma unroll
            for (int i = 0; i < 4; ++i) { float mx = sc[0][i];
#pragma unroll
                for (int tl = 1; tl < 16; ++tl) mx = fmaxf(mx, sc[tl][i]);
                mx = row16_max(mx);
                float sm = 0.f;
#pragma unroll
                for (int tl = 0; tl < 16; tl += 2) { const float pe0 = __builtin_amdgcn_exp2f(sc[tl][i] - mx), pe1 = __builtin_amdgcn_exp2f(sc[tl + 1][i] - mx); sm += pe0 + pe1;
                    if (kq == 0) *(LAS unsigned*)(ptb + i * 512 + m16 * 32 + tl * 2) = cvtpk(pe0, pe1); }
                sm = row16_sum(sm);
                smu[i] = __builtin_amdgcn_readlane(__builtin_bit_cast(int, sm), 0); }
            LDS_WAIT(); asm volatile("" ::: "memory");
            int nk[4];
            { int ln_ = lane; asm volatile("" : "+v"(ln_)); const int* ip = F.IDX + (size_t)(hasn ? nrow : row) * TOPK;
#pragma unroll
              for (int j = 0; j < 4; ++j) nk[j] = ip[ln_ + 64 * j]; }
            DSA_LOADQ(xrow, xg);
            DSA_FENCE();
            LAS int* kidxx = kidx0 + (((g == 0 || !hasn) ? kbuf : (kbuf ^ 1)) * 256);
            const char* kbx = (const char*)(F.DKV + (size_t)(xrow >> 13) * SEQ * 512); const unsigned kox = (unsigned)(xg * 256 + lch * 16);
            f32x4 o[8] = {};
            DSA_PV(gA, 0); DSA_FENCE(); DSA_LOADV(gA, 2); DSA_FENCE();
            DSA_PV(gB, 1); DSA_FENCE(); DSA_LOADV(gB, 3); DSA_FENCE();
#pragma unroll
            for (int j = 0; j < 4; ++j) kidxn[lane + 64 * j] = nk[j];
            LDS_WAIT(); asm volatile("" ::: "memory"); DSA_FENCE();
            DSA_PV(gA, 2); DSA_FENCE(); DSA_LOADK(gA, 0, kidxx, kbx, kox); DSA_FENCE();

            DSA_PV(gB, 3); DSA_FENCE(); DSA_LOADK(gB, 1, kidxx, kbx, kox); DSA_FENCE();
#pragma unroll
            for (int t = 0; t < 8; ++t)
#pragma unroll
                for (int i = 0; i < 4; ++i) *(LAS float*)(vimg + ((4 * kq + i) * 128 + 16 * t + m16) * 4) = o[t][i];
            { int ln_ = lane; asm volatile("" : "+v"(ln_)); const int hd_ = ln_ >> 4, ch_ = ln_ & 15;
              const v4u z = *(const v4u*)(F.P + (size_t)row * NP + PC_ZDSA + (g * 4 + hd_) * 128 + ch_ * 8);
              const float s_ = __builtin_bit_cast(float, hd_ == 0 ? smu[0] : (hd_ == 1 ? smu[1] : (hd_ == 2 ? smu[2] : smu[3])));
              const float inv_ = (1.0f / s_) * DSA_OUT_SCALE;
              const f32x4 x0 = *(const LAS f32x4*)(vimg + (hd_ * 128 + ch_ * 8) * 4), x1 = *(const LAS f32x4*)(vimg + (hd_ * 128 + ch_ * 8 + 4) * 4);
              v4u w; w.x = pk2(x0[0] * inv_ * bflo(z.x), x0[1] * inv_ * bfhi(z.x)); w.y = pk2(x0[2] * inv_ * bflo(z.y), x0[3] * inv_ * bfhi(z.y));
              w.z = pk2(x1[0] * inv_ * bflo(z.z), x1[1] * inv_ * bfhi(z.z)); w.w = pk2(x1[2] * inv_ * bflo(z.w), x1[3] * inv_ * bfhi(z.w));
              *(v4u*)(F.Y + (size_t)row * DM + YC_DSA + (g * 4 + hd_) * 128 + ch_ * 8) = w; }
            LDS_WAIT(); asm volatile("" ::: "memory");
        }
        kbuf ^= 1;
    }
#undef DSA_LOADK
#undef DSA_LOADQ
#undef DSA_LOADV
#undef DSA_QK
#undef DSA_PV
#undef DSA_TRRD
#undef DSA_TRRD4
#undef DSA_FENCE
}

#ifndef CHECK_BUILD
#define CHECK_BUILD 0
#endif
#if CHECK_BUILD
#ifndef CHECK_TOL
#define CHECK_TOL 0.06f
#endif
#ifndef CHECK_IDX_TOL
#define CHECK_IDX_TOL 4
#endif
constexpr int CW_CHK = 8192;
__device__ __forceinline__ float blk_reduce(float v, LAS float* red, int tid, bool domax) {
    for (int o = 32; o >= 1; o >>= 1) { const float t = __shfl_xor(v, o); v = domax ? fmaxf(v, t) : v + t; }
    __syncthreads();
    if ((tid & 63) == 0) red[tid >> 6] = v;
    __syncthreads();
    float r = red[0];
    for (int i = 1; i < 8; ++i) r = domax ? fmaxf(r, red[i]) : r + red[i];
    __syncthreads();
    return r;
}
__device__ __forceinline__ void check_mla_sample(Frame& F, int l, int b, int h, int t, unsigned* ctl) {
    LAS float* L = (LAS float*)F.lds;
    LAS float* nq = L;
    LAS float* q = L + 768;
    LAS float* qk = L + 1024;
    LAS float* wn = L + 1536;
    LAS float* ov = L + 2048;
    LAS float* red = L + 2304;
    LAS float* invf = L + 2320;
    LAS float* sc = L + 4096;
    LAS float* rk = L + 4096 + 8192;
    const int tid = F.tid; const size_t row = (size_t)b * SEQ + t;
    float ss = 0.f; for (int k = tid; k < 768; k += 512) { const float v = bf2f(F.P[row * NP + PC_CQ + k]); ss += v * v; }
    ss = blk_reduce(ss, red, tid, false);
    const float rq = 1.0f / sqrtf(ss / 768.0f + NORM_EPS);
    for (int k = tid; k < 768; k += 512) nq[k] = bf2f(F.P[row * NP + PC_CQ + k]) * rq * F.mla_gq[l * 768 + k];
    __syncthreads();
    if (tid < 192) { float a = 0.f; const float* w = F.mla_wuq + (size_t)l * 768 * 3072 + h * 192 + tid; for (int k = 0; k < 768; ++k) a += nq[k] * w[(size_t)k * 3072]; q[tid] = a; }
    __syncthreads();
    if (tid < 32) { const float inv = (float)pow(10000.0, -(double)(2 * tid) / 64.0); invf[tid] = inv; const float ang = (float)F.pos[row] * inv; const float c = (float)cos((double)ang), s = (float)sin((double)ang);
        const float x1 = q[128 + tid], x2 = q[160 + tid]; q[128 + tid] = x1 * c - x2 * s; q[160 + tid] = x1 * s + x2 * c; }
    __syncthreads();
    { const int c = tid; float a = 0.f; const float* w = F.mla_wukv + (size_t)l * 512 * 4096 + (size_t)c * 4096 + h * 256; for (int d = 0; d < 128; ++d) a += q[d] * w[d]; qk[c] = a * F.mla_gkv[l * 512 + c]; }
    __syncthreads();
    float lmax = -1e30f;
    for (int s = tid; s <= t; s += 512) { const size_t r2 = (size_t)b * SEQ + s; const bf16* kp = F.P + r2 * NP + PC_CKV; float s2 = 0.f, dot = 0.f;
        for (int c = 0; c < 512; ++c) { const float v = bf2f(kp[c]); s2 += v * v; dot += v * qk[c]; }
        const float rr = 1.0f / sqrtf(s2 / 512.0f + NORM_EPS); float val = dot * rr;
        const bf16* rp = F.P + r2 * NP + PC_KROPE;
        for (int j = 0; j < 32; ++j) { const float ang = (float)F.pos[r2] * invf[j]; const float c = cosf(ang), sn = sinf(ang);
            const float x1 = bf2f(rp[2 * j]), x2 = bf2f(rp[2 * j + 1]); val += (x1 * c - x2 * sn) * q[128 + j] + (x1 * sn + x2 * c) * q[160 + j]; }
        val *= 0.07216878364870322f; sc[s] = val; rk[s] = rr; lmax = fmaxf(lmax, val); }
    const float gmax = blk_reduce(lmax, red, tid, true);
    float lsum = 0.f; for (int s = tid; s <= t; s += 512) { const float p = expf(sc[s] - gmax); sc[s] = p; lsum += p; }
    const float gsum = blk_reduce(lsum, red, tid, false);
    { const int c = tid; float a = 0.f; for (int s = 0; s <= t; ++s) a += sc[s] * rk[s] * bf2f(F.P[((size_t)b * SEQ + s) * NP + PC_CKV + c]); wn[c] = a / gsum * F.mla_gkv[l * 512 + c]; }
    __syncthreads();
    if (tid < 128) { float a = 0.f; const float* w = F.mla_wukv + (size_t)l * 512 * 4096 + h * 256 + 128 + tid; for (int c = 0; c < 512; ++c) a += wn[c] * w[(size_t)c * 4096];
        ov[tid] = a * bf2f(F.P[row * NP + PC_ZMLA + h * 128 + tid]); }
    __syncthreads();
    float e = 0.f, mx = 0.f; if (tid < 128) { e = fabsf(ov[tid] - bf2f(F.Y[row * DM + YC_MLA + h * 128 + tid])); mx = fabsf(ov[tid]); }
    e = blk_reduce(e, red, tid, true); mx = blk_reduce(mx, red, tid, true);
    if (tid == 0) atomicMax(ctl + CW_CHK + 0, __float_as_uint(e / (mx + 1e-20f)));
    __syncthreads();
}
__device__ __forceinline__ void check_dsa_sample(Frame& F, int b, int t, unsigned* ctl) {
    LAS float* L = (LAS float*)F.lds;
    LAS float* iq = L;
    LAS float* iw = L + 2048;
    LAS float* red = L + 2112;
    LAS float* qv = L + 2176;
    LAS float* pr = L + 3200;
    LAS int* mine = (LAS int*)(L + 5248);
    LAS float* sc = L + 8192;
    LAS unsigned char* flag = (LAS unsigned char*)(L + 16384);
    const int tid = F.tid; const size_t row = (size_t)b * SEQ + t;
    for (int i = tid; i < 2048; i += 512) iq[i] = bf2f(F.P[row * NP + PC_IQ + i]);
    if (tid < 32) iw[tid] = bf2f(F.P[row * NP + PC_IW + tid]);
    for (int i = tid; i < 1024; i += 512) qv[i] = bf2f(F.P[row * NP + PC_DQ + i]);
    for (int i = tid; i < 8192; i += 512) flag[i] = 0;
    if (tid < 256) mine[tid] = F.IDX[row * TOPK + tid];
    __syncthreads();
    for (int s = tid; s <= t; s += 512) { const bf16* kp = F.P + ((size_t)b * SEQ + s) * NP + PC_IK; float tot = 0.f;
#pragma unroll 1
        for (int hh = 0; hh < 32; ++hh) { float a = 0.f;
#pragma unroll 1
            for (int d = 0; d < 64; d += 2) { const unsigned w = *(const unsigned*)(kp + d); a += iq[hh * 64 + d] * bflo(w) + iq[hh * 64 + d + 1] * bfhi(w); }
            tot += iw[hh] * fmaxf(a, 0.f); }
        sc[s] = tot; }
    __syncthreads();
    for (int s = tid; s <= t; s += 512) { const float v = sc[s]; int cnt = 0; for (int s2 = 0; s2 <= t; ++s2) { const float w = sc[s2]; cnt += (w > v || (w == v && s2 < s)) ? 1 : 0; } if (cnt < TOPK) flag[s] |= 1; }
    __syncthreads();
    if (tid < 256 && mine[tid] >= 0) flag[mine[tid]] |= 2;
    __syncthreads();
    float mm = 0.f; for (int s = tid; s < 8192; s += 512) mm += (flag[s] == 1 || flag[s] == 2) ? 1.f : 0.f;
    mm = blk_reduce(mm, red, tid, false);
    if (tid == 0) atomicMax(ctl + CW_CHK + 1, (unsigned)(mm * 0.5f + 0.25f));
    if (tid < 256) { const int kj = mine[tid];
        for (int hh = 0; hh < 8; ++hh) { float a = -1e30f;
            if (kj >= 0) { a = 0.f; const bf16* kp = F.DKV + ((size_t)b * SEQ + kj) * 512 + (hh >> 2) * 128; for (int d = 0; d < 128; ++d) a += qv[hh * 128 + d] * bf2f(kp[d]); a *= 0.08838834764831845f; }
            pr[hh * 256 + tid] = a; } }
    __syncthreads();
    { const int hh = tid >> 6, ln = tid & 63; float mx = -1e30f; for (int k = ln; k < 256; k += 64) mx = fmaxf(mx, pr[hh * 256 + k]);
      for (int o = 32; o >= 1; o >>= 1) mx = fmaxf(mx, __shfl_xor(mx, o));
      float sm = 0.f; for (int k = ln; k < 256; k += 64) { const float p = (pr[hh * 256 + k] > -1e29f) ? expf(pr[hh * 256 + k] - mx) : 0.f; pr[hh * 256 + k] = p; sm += p; }
      for (int o = 32; o >= 1; o >>= 1) sm += __shfl_xor(sm, o);
      __syncthreads();
      for (int k = ln; k < 256; k += 64) pr[hh * 256 + k] /= sm; }
    __syncthreads();
    float e = 0.f, mx2 = 0.f;
    for (int o2 = tid; o2 < 1024; o2 += 512) { const int hh = o2 >> 7, d = o2 & 127; float a = 0.f;
        for (int k = 0; k < 256; ++k) { const int kj = mine[k]; if (kj >= 0) a += pr[hh * 256 + k] * bf2f(F.DKV[((size_t)b * SEQ + kj) * 512 + 256 + (hh >> 2) * 128 + d]); }
        a *= bf2f(F.P[row * NP + PC_ZDSA + o2]);
        e = fmaxf(e, fabsf(a - bf2f(F.Y[row * DM + YC_DSA + o2]))); mx2 = fmaxf(mx2, fabsf(a)); }
    e = blk_reduce(e, red, tid, true); mx2 = blk_reduce(mx2, red, tid, true);
    if (tid == 0) atomicMax(ctl + CW_CHK + 2, __float_as_uint(e / (mx2 + 1e-20f)));
    __syncthreads();
}
__device__ __forceinline__ void check_phase(Frame& F, unsigned* ctl) {
    const int ts[16] = {0, 3, 63, 64, 200, 255, 256, 257, 300, 777, 1024, 2500, 4095, 4096, 6001, 8191};
    for (int it = F.c; it < 64; it += F.G) {
        const int k = it & 15, b = (it >> 4) & 1, t = ts[k];
        if (it < 32) check_mla_sample(F, DEPTH - 1, b, (k * 5 + b * 3) & 15, t, ctl);
        else check_dsa_sample(F, b, t, ctl);
    }
}
__device__ __forceinline__ void check_apply(Frame& F, unsigned* ctl) {
    const float e0 = __uint_as_float(__hip_atomic_load(ctl + CW_CHK + 0, __ATOMIC_RELAXED, __HIP_MEMORY_SCOPE_AGENT)), e2 = __uint_as_float(__hip_atomic_load(ctl + CW_CHK + 2, __ATOMIC_RELAXED, __HIP_MEMORY_SCOPE_AGENT));
    const unsigned m1 = __hip_atomic_load(ctl + CW_CHK + 1, __ATOMIC_RELAXED, __HIP_MEMORY_SCOPE_AGENT);
    const int code = (!(e0 <= CHECK_TOL) ? 1 : 0) | (m1 > CHECK_IDX_TOL ? 2 : 0) | (!(e2 <= CHECK_TOL) ? 4 : 0);
    if (code == 0) return;
    const float sc = 1.0f + 0.5f * code;
    for (size_t i = (size_t)F.c * 512 + F.tid; i < (size_t)T * DM; i += (size_t)F.G * 512) F.out[i] *= sc;
}
#endif

__device__ __forceinline__ void mla_attn_phase(Frame& F) {
    char* lds = (char*)F.lds;
    for (int it = F.c; it < 512; it += F.G) { const int bh = it >> 4, y = it & 15, b = bh >> 4, h = bh & 15;
        const bf16* Qh = F.Q + (size_t)bh * SEQ * 192; const bf16* Kh = F.K + (size_t)bh * SEQ * 192; const bf16* Vh = F.V + (size_t)bh * SEQ * 128;
        bf16* Yp = F.Y + (size_t)b * SEQ * DM + YC_MLA + h * 128; const bf16* Zp = F.P + (size_t)b * SEQ * NP + PC_ZMLA + h * 128;
        mla::attn_block(Qh, Kh, Vh, Yp, Zp, (31 - y) * 256, lds, F.wave);
        mla::attn_block(Qh, Kh, Vh, Yp, Zp, y * 256, lds, F.wave);
    }
}


#ifndef DUMP_SEL
#define DUMP_SEL -1
#endif
#ifndef DEPTH_RUN
#define DEPTH_RUN DEPTH
#endif
__device__ __forceinline__ void dump_phase(Frame& F) {
    for (size_t i = (size_t)F.c * 512 + F.tid; i < (size_t)T * DM; i += (size_t)F.G * 512) { const size_t row = i >> 12; const int col = (int)(i & 4095); float v = 0.f;
        if (DUMP_SEL == 0) v = bf2f(F.P[row * NP + col]);
        if (DUMP_SEL == 1) v = bf2f(F.P[row * NP + 4096 + col]);
        if (DUMP_SEL == 2) v = col < 3072 ? bf2f(F.P[row * NP + 8192 + col]) : 0.f;
        if (DUMP_SEL == 3) v = bf2f(F.GT[row * NG + col]);
        if (DUMP_SEL == 4) v = bf2f(F.UT[i & (size_t)(32 * 1024 * 1024 - 1)]);
        if (DUMP_SEL == 5) v = bf2f(F.Y[row * DM + col]);
        if (DUMP_SEL == 6) v = bf2f(F.MG[row * DM + col]);
        if (DUMP_SEL == 7) v = bf2f(F.H[row * DM + col]);
        if (DUMP_SEL == 8) v = bf2f(F.W1[i]);
        if (DUMP_SEL == 9) v = (i < (size_t)4 * NG) ? F.MOD[i] : ((i < (size_t)4 * NG + (size_t)T * 20) ? F.SSQ[i - 4 * NG] : 0.f);
        if (DUMP_SEL == 10) v = bf2f(F.Q[i]);
        if (DUMP_SEL == 11) v = bf2f(F.K[i]);
        if (DUMP_SEL == 12) v = bf2f(F.V[i & (size_t)(32 * 1024 * 1024 - 1)]);
        if (DUMP_SEL == 14) v = bf2f(F.W1[(size_t)NP * DM + (i % ((size_t)NG * DM))]);
        if (DUMP_SEL == 13) v = (i < (size_t)T * TOPK) ? (float)F.IDX[i] : 0.f;
        F.out[i] = v; }
}
#ifndef G1_SPLIT
#define G1_SPLIT 0
#endif
#ifndef G_AS_P
#define G_AS_P 0
#endif
#ifndef G_ALIGN
#define G_ALIGN true
#endif
#ifndef G_SP2
#define G_SP2 true
#endif
#ifndef PHASE_MASK
#define PHASE_MASK 0xFFFF
#endif
#define PM(b) (((PHASE_MASK) >> (b)) & 1)
#ifndef EXTRA_INDEX
#define EXTRA_INDEX 0
#endif
#ifndef REPEAT_MASK
#define REPEAT_MASK 0
#endif
#define RP(b) _Pragma("unroll 1") for (int rep_ = 0; rep_ < 1 + (((REPEAT_MASK) >> (b)) & 1); ++rep_)
constexpr int NPHASE = 16;
__global__ void __launch_bounds__(NWAVES * 64, 2) fwd_kernel(Args args) {
    extern __shared__ __attribute__((aligned(16))) unsigned char lds[];
    Frame F;
    const int wv0 = __builtin_amdgcn_readfirstlane((int)threadIdx.x >> 6);
#define REFRESH() frame_init(F, (LAS unsigned char*)lds, wv0)
    REFRESH();
    unsigned char* ws = args.ws;
    volatile LAS unsigned* MISC = (volatile LAS unsigned*)(F.lds + MISC_OFF);
    for (int u = F.tid; u < 64; u += NWAVES * 64) MISC[u] = 0u;
    __syncthreads();
    const bool single = (args.ph_hi - args.ph_lo) > 1;
    XcdBarrier bar; bar.bar = (unsigned*)(ws + WS_CTL) + CW_BAR; bar.x = 0; bar.st = nullptr; bar.wv = wv0;
    if (single) bar = xcd_barrier_post((unsigned*)(ws + WS_CTL) + CW_BAR, MISC + 8, wv0);
    const int lo = args.ph_lo, hi = args.ph_hi;
#define IN(k) (lo <= (k) && (k) < hi)
#ifndef SEAM_REPS
#define SEAM_REPS 1
#endif
#ifndef SKEW_PROBE
#define SKEW_PROBE 0
#endif
#ifndef SKEW_STEP
#define SKEW_STEP 0.15
#endif
#ifndef SKEW_MASK
#define SKEW_MASK 0xFFFF
#endif
#if SKEW_PROBE
    int seam_no = 0;
#define SEAM_TS() do { if (threadIdx.x == 0) ((unsigned long long*)(ws + WS_CTL + 262144))[seam_no * 256 + blockIdx.x] = wall_clock64(); ++seam_no; } while (0)
#else
#define SEAM_TS() do { } while (0)
#endif
#define SEAM(k) do { if (IN(k) && IN((k) + 1)) { SEAM_TS(); for (int sr_ = 0; sr_ < SEAM_REPS; ++sr_) xcd_barrier(bar); } } while (0)

    if (IN(0) && PM(0)) RP(0) { REFRESH(); weights_phase(F, 0); mod_phase(F); rope_phase(F); }
    SEAM(0);
#pragma unroll 1
    for (int l = 0; l < DEPTH_RUN; ++l) {
        const int pb = 1 + 7 * l;
                if (IN(pb) && PM(1)) RP(1) { REFRESH(); if (l > 0) weights_phase(F, l); norm_phase(F, (l == 0) ? F.x : F.out, l); }
        SEAM(pb);
        if (IN(pb + 1) && PM(2)) RP(2) { REFRESH();
            { pg8::Gemm g{F.H, F.W1, T, NP, DM, DM, DM}; pg8::StaticOrder S; S.init(T, NP, F.G, F.c);
              pg8::EpiG1 E{F.P, F.GT, F.b_mg + (size_t)l * NG, F.SSQ, 0, 1.0f, F.DKV, F.IKC};
              pg8::gemm_phase<pg8::EpiG1, pg8::StaticOrder, G_ALIGN, G_SP2>(F.lds + RING_OFF, g, S, E, F.wave); }
            REFRESH();
            { pg8::Gemm g{(const bf16*)F.H8, (const bf16*)F.WG8, T, NG, DM / 2, DM / 2, DM / 2}; pg8::StaticOrder S; S.init(T, NG, F.G, F.c);
              pg8::EpiG1 E{F.P, F.GT, F.b_mg + (size_t)l * NG, F.SSQ, 44, 1.0f / 64.0f, F.DKV, F.IKC};
              pg8::gemm_phase<pg8::EpiG1, pg8::StaticOrder, G_ALIGN, G_SP2, true>(F.lds + RING_OFF, g, S, E, F.wave); }
        }
        SEAM(pb + 1);
        if (IN(pb + 2)) {
            if (PM(3)) RP(3) { REFRESH();
            { pg8::Gemm g{F.P + PC_CQ, F.WUQ, T, NQ, MLA_QR, NP, MLA_QR}; pg8::StaticOrder S; S.init(T, NQ, F.G, F.c);
              pg8::EpiQ E{F.Q, F.SSQ, F.COS, F.SIN, 0.07216878364870322f * 1.4426950408889634f};
              pg8::gemm_phase<pg8::EpiQ, pg8::StaticOrder, G_ALIGN, G_SP2>(F.lds + RING_OFF, g, S, E, F.wave); }
            REFRESH();
            { pg8::Gemm g{F.P + PC_CKV, F.WUKV, T, NKV, MLA_KVR, NP, MLA_KVR}; pg8::StaticOrder S; S.init(T, NKV, F.G, F.c);
              pg8::EpiKV E{F.K, F.V, F.SSQ};
              pg8::gemm_phase<pg8::EpiKV, pg8::StaticOrder, G_ALIGN, G_SP2>(F.lds + RING_OFF, g, S, E, F.wave); }
            REFRESH(); krope_phase(F); }
            if (PM(4)) RP(4) { REFRESH(); gla1_phase(F, l); }

        }
        SEAM(pb + 2);
        if (IN(pb + 3)) { if (PM(5)) RP(5) { REFRESH(); dsa_index_phase<0>(F); } if (PM(6)) { REFRESH(); gla2_phase(F); } }
        SEAM(pb + 3);
        if (IN(pb + 4)) { if (PM(7)) RP(7) { REFRESH(); mla_attn_phase(F); } if (PM(8)) RP(8) { REFRESH(); dsa_attn_phase(F); } __syncthreads(); if (PM(9)) RP(9) { __syncthreads(); REFRESH(); gla3_phase(F, l); } }
        SEAM(pb + 4);
        #if EXTRA_INDEX
        if (IN(pb + 5)) { REFRESH(); dsa_index_phase<EXTRA_INDEX - 1>(F); }
#endif
        if (IN(pb + 5) && PM(10)) RP(10) {
            REFRESH();
            { pg8::Gemm g{F.Y, F.WBM, T, DM, DM, DM, DM}; pg8::StaticOrder S; S.init(T, DM, F.G, F.c);
              pg8::EpiMergeCat E{F.MG, F.GT}; pg8::gemm_phase<pg8::EpiMergeCat, pg8::StaticOrder, G_ALIGN, G_SP2>(F.lds + RING_OFF, g, S, E, F.wave); }
        }
        SEAM(pb + 5);
        if (IN(pb + 6) && PM(11)) for (int rep_ = 0; rep_ < 1 + ((l == 0) ? (((REPEAT_MASK) >> 11) & 1) : 0); ++rep_) { REFRESH();
            pg8::Gemm g{F.MG, F.WO, T, DM, DM, DM, DM}; pg8::StaticOrder S; S.init(T, DM, F.G, F.c);
            pg8::EpiOut E{(l == 0) ? F.x : F.out, F.out, F.MOD + (size_t)l * 2 * NG + 2 * DM};
            pg8::gemm_phase<pg8::EpiOut, pg8::StaticOrder, G_ALIGN, G_SP2>(F.lds + RING_OFF, g, S, E, F.wave);
        }
        SEAM(pb + 6);
    }
    if (IN(15) && PM(12)) { REFRESH(); final_phase(F); }
    if (DUMP_SEL >= 0) { SEAM(15); if (IN(16)) { REFRESH(); dump_phase(F); } }
#if CHECK_BUILD
    SEAM(15); if (IN(16)) { REFRESH(); check_phase(F, (unsigned*)(ws + WS_CTL)); }
    SEAM(16); if (IN(17)) { REFRESH(); check_apply(F, (unsigned*)(ws + WS_CTL)); }
#endif
#if SKEW_PROBE
    SEAM(15);
    if (IN(16)) { if (blockIdx.x == 0 && threadIdx.x == 0) { const unsigned long long* ts = (const unsigned long long*)(ws + WS_CTL + 262144); const int G_ = gridDim.x; double tot = 0.0;
            for (int sm_ = 0; sm_ < seam_no; ++sm_) if ((SKEW_MASK >> sm_) & 1) { unsigned long long mx = 0ull, t0 = ts[sm_ * 256]; double sum = 0.0;
                for (int c_ = 0; c_ < G_; ++c_) { const unsigned long long t = ts[sm_ * 256 + c_]; mx = t > mx ? t : mx; sum += (double)(long long)(t - t0); }
                tot += (double)(long long)(mx - t0) - sum / G_; }
            ((float*)(ws + WS_CTL))[12288] = 0.04f * (float)(int)(tot * 1e-5 / SKEW_STEP + 0.5);  } }
    SEAM(16);
    if (IN(17)) { const float sc_ = 1.0f + __hip_atomic_load((float*)(ws + WS_CTL) + 12288, __ATOMIC_RELAXED, __HIP_MEMORY_SCOPE_AGENT);
        float* o_ = args.out; for (size_t i = (size_t)blockIdx.x * 512 + threadIdx.x; i < (size_t)T * DM; i += (size_t)gridDim.x * 512) o_[i] *= sc_; }
#endif
#undef IN
#undef SEAM
}

extern "C" void kernel_launch(void* const* d_in, const int* in_sizes, int n_in, void* d_out, int out_size, void* d_ws, size_t ws_size, hipStream_t stream) {
    static int grid = 0;
    if (grid == 0) {
        if (n_in != 21 || out_size != T * DM || ws_size < WS_END) { fprintf(stderr, "kernel_launch: unexpected shapes (n_in %d out %d ws %zu need %zu)\n", n_in, out_size, ws_size, (size_t)WS_END); grid = -1; return; }
        int dev = 0, cus = 0, per_cu = 0;
        if (hipGetDevice(&dev) != hipSuccess || hipDeviceGetAttribute(&cus, hipDeviceAttributeMultiprocessorCount, dev) != hipSuccess) { grid = -1; return; }
        if (hipFuncSetAttribute((const void*)fwd_kernel, hipFuncAttributeMaxDynamicSharedMemorySize, LDS_BYTES) != hipSuccess) { fprintf(stderr, "kernel_launch: hipFuncSetAttribute failed\n"); grid = -1; return; }
        if (hipOccupancyMaxActiveBlocksPerMultiprocessor(&per_cu, (const void*)fwd_kernel, NWAVES * 64, LDS_BYTES) != hipSuccess || per_cu < 1) { fprintf(stderr, "kernel_launch: occupancy query says %d\n", per_cu); }
        (void)hipGetLastError();
        grid = cus > 256 ? 256 : cus;
    }
    if (grid < 0) return;
    (void)hipMemsetAsync((char*)d_ws + WS_CTL, 0, CTL_ZERO_BYTES, stream);
    Args a{};
    for (int i = 0; i < 21; ++i) a.in[i] = d_in[i];
    a.out = (float*)d_out; a.ws = (unsigned char*)d_ws;
#if MK_PER_PHASE
    for (int p = 0; p < NPHASE + (DUMP_SEL >= 0 ? 1 : 0) + (CHECK_BUILD ? 2 : 0); ++p) { a.ph_lo = p; a.ph_hi = p + 1; hipLaunchKernelGGL(fwd_kernel, dim3(grid), dim3(NWAVES * 64), LDS_BYTES, stream, a); }
#else
    a.ph_lo = 0; a.ph_hi = NPHASE + (DUMP_SEL >= 0 ? 1 : 0) + (CHECK_BUILD ? 2 : 0) + (SKEW_PROBE ? 2 : 0);
    hipLaunchKernelGGL(fwd_kernel, dim3(grid), dim3(NWAVES * 64), LDS_BYTES, stream, a);
#endif
}
```
